# Optimizing an MI355X kernel written in HIP

```python
import jax, jax.numpy as jnp
from jax import lax
import numpy as np

D_MODEL = 2048
BATCH = 4
SEQ = 4096
DEPTH = 1

N_META = 16
HEAD_DIM = 64
RWKV_HEADS = 16
RWKV_WIDTH = RWKV_HEADS * HEAD_DIM
FOX_HEADS = 16
FOX_WIDTH = FOX_HEADS * HEAD_DIM
DECAY_LORA = 96
AAA_LORA = 96
GATE_LORA = 256
D_FF = -(-8 * D_MODEL // (3 * 256)) * 256
Q_BLOCK = 128
RMS_EPS = 1e-6
GN_EPS = 64e-5
ATTN_SCALE = HEAD_DIM ** -0.5

RWKV_SPLITS = (RWKV_WIDTH, 2 * RWKV_WIDTH, 3 * RWKV_WIDTH,
               3 * RWKV_WIDTH + DECAY_LORA, 3 * RWKV_WIDTH + DECAY_LORA + AAA_LORA)
RWKV_COLS = 3 * RWKV_WIDTH + DECAY_LORA + AAA_LORA + GATE_LORA
FOX_SPLITS = (FOX_WIDTH, 2 * FOX_WIDTH, 3 * FOX_WIDTH)
FOX_COLS = 3 * FOX_WIDTH + FOX_HEADS
N_IN = RWKV_COLS + FOX_COLS + 2 * D_MODEL

kernel_name = 'hybrid_rwkv7_fox_meta_gated_block'

F32 = jnp.float32


def _rms(x, g):
    xf = x.astype(F32)
    xf = xf * lax.rsqrt(jnp.mean(xf * xf, axis=-1, keepdims=True) + RMS_EPS)
    return xf.astype(x.dtype) * g


def _wkv7_scan(r, w, k, v, a, b):
    B, L, H, N = r.shape

    def step(S, inp):
        r_t, w_t, k_t, v_t, a_t, b_t = inp
        sa = jnp.einsum('bhvk,bhk->bhv', S, a_t)
        S = (S * w_t[:, :, None, :] + sa[..., None] * b_t[:, :, None, :]
             + v_t[..., None] * k_t[:, :, None, :])
        return S, jnp.einsum('bhvk,bhk->bhv', S, r_t)

    xs = tuple(jnp.swapaxes(t, 0, 1) for t in (r, w, k, v, a, b))
    _, y = lax.scan(step, jnp.zeros((B, H, N, N), F32), xs)
    return jnp.swapaxes(y, 0, 1)


def _rwkv7(z, w0, w2, a0, a2, g2, k_k, k_a, r_k, gn_w, gn_b):
    B, L, _ = z.shape
    r, k, v, wd, ad, gd = jnp.split(z, RWKV_SPLITS, axis=-1)
    w_log = -jax.nn.softplus(-(w0 + jnp.tanh(wd) @ w2).astype(F32)) - 0.5
    decay = jnp.exp(-jnp.exp(w_log))
    a = jax.nn.sigmoid((a0 + ad @ a2).astype(F32))
    g = jax.nn.sigmoid(gd) @ g2
    heads = lambda t: t.reshape(B, L, RWKV_HEADS, HEAD_DIM)
    kk = heads((k * k_k).astype(F32))
    kk = kk / jnp.maximum(jnp.sqrt(jnp.sum(kk * kk, axis=-1, keepdims=True)), 1e-12)
    kf = k.astype(F32) * (1.0 + (a - 1.0) * k_a.astype(F32))
    rh, kh, vh, ah, dh = heads(r.astype(F32)), heads(kf), heads(v.astype(F32)), heads(a), heads(decay)
    y = _wkv7_scan(rh, dh, kh, vh, -kk, kk * ah)
    mu = jnp.mean(y, axis=-1, keepdims=True)
    var = jnp.mean(jnp.square(y - mu), axis=-1, keepdims=True)
    y = (y - mu) * lax.rsqrt(var + GN_EPS)
    y = y * gn_w.astype(F32).reshape(RWKV_HEADS, HEAD_DIM) + gn_b.astype(F32).reshape(RWKV_HEADS, HEAD_DIM)
    y = y + jnp.sum(rh * kh * r_k.astype(F32), axis=-1, keepdims=True) * vh
    return y.reshape(B, L, RWKV_WIDTH).astype(z.dtype) * g


def _fox(z, q_g, k_g, f_bias):
    B, L, _ = z.shape
    q, k, v, fl = jnp.split(z, FOX_SPLITS, axis=-1)
    q = _rms(q.reshape(B, L, FOX_HEADS, HEAD_DIM), q_g)
    k = _rms(k.reshape(B, L, FOX_HEADS, HEAD_DIM), k_g)
    v = v.reshape(B, L, FOX_HEADS, HEAD_DIM)
    log_f = jax.nn.log_sigmoid(fl.astype(F32) + f_bias.astype(F32))
    c = jnp.swapaxes(jnp.cumsum(log_f, axis=1), 1, 2)
    bounds = [(0, N_META)] + [(s, min(s + Q_BLOCK, L)) for s in range(N_META, L, Q_BLOCK)]
    outs = []
    for s, e in bounds:
        sc = jnp.einsum('bqhd,bkhd->bhqk', q[:, s:e], k[:, :e]).astype(F32) * ATTN_SCALE
        sc = sc + c[:, :, s:e, None] - c[:, :, None, :e]
        causal = jnp.arange(s, e)[:, None] >= jnp.arange(e)[None, :]
        p = jax.nn.softmax(jnp.where(causal, sc, -jnp.inf), axis=-1)
        outs.append(jnp.einsum('bhqk,bkhd->bqhd', p.astype(v.dtype), v[:, :e]))
    return jnp.concatenate(outs, axis=1).reshape(B, L, FOX_WIDTH)


def _layer(h, n1, w_in, mu, w0, w2, a0, a2, g2, k_k, k_a, r_k, gn_w, gn_b,
           q_g, k_g, f_bias, w_a, w_b, w_o, n2, w_gu, w_dn):
    xn = _rms(h, n1)
    proj = xn @ w_in
    z_rwkv, z_fox, z_gate = jnp.split(proj, (RWKV_COLS, RWKV_COLS + FOX_COLS), axis=-1)
    z_prev = jnp.pad(z_rwkv, ((0, 0), (1, 0), (0, 0)))[:, :-1]
    z_rwkv = z_rwkv + (z_prev - z_rwkv) * mu
    y_a = _rwkv7(z_rwkv, w0, w2, a0, a2, g2, k_k, k_a, r_k, gn_w, gn_b)
    y_b = _fox(z_fox, q_g, k_g, f_bias)
    gates = jax.nn.sigmoid(z_gate.astype(F32)).astype(h.dtype)
    g_a, g_b = jnp.split(gates, 2, axis=-1)
    merged = g_a * (y_a @ w_a) + g_b * (y_b @ w_b)
    h = h + merged @ w_o
    gate, up = jnp.split(_rms(h, n2) @ w_gu, 2, axis=-1)
    return h + (jax.nn.silu(gate) * up) @ w_dn


def setup_inputs(seed: int = 0) -> dict:
    key = jax.random.key(seed)
    ks = jax.random.split(key, 24)
    nrm = lambda k, shape, scale: jax.random.normal(k, shape, F32) * scale
    Dp = DEPTH
    return {
        'x': nrm(ks[0], (BATCH, SEQ, D_MODEL), 1.0),
        'meta_tokens': nrm(ks[1], (N_META, D_MODEL), 1.0),
        'norm1_g': 1.0 + nrm(ks[2], (Dp, D_MODEL), 0.05),
        'w_in': nrm(ks[3], (Dp, D_MODEL, N_IN), D_MODEL ** -0.5),
        'rwkv_mu': jax.random.uniform(ks[4], (Dp, RWKV_COLS), F32, 0.0, 1.0),
        'rwkv_w0': jax.random.uniform(ks[5], (Dp, RWKV_WIDTH), F32, -5.0, -1.0),
        'rwkv_w2': nrm(ks[6], (Dp, DECAY_LORA, RWKV_WIDTH), 0.5 * DECAY_LORA ** -0.5),
        'rwkv_a0': nrm(ks[7], (Dp, RWKV_WIDTH), 0.1),
        'rwkv_a2': nrm(ks[8], (Dp, AAA_LORA, RWKV_WIDTH), 0.5 * AAA_LORA ** -0.5),
        'rwkv_g2': nrm(ks[9], (Dp, GATE_LORA, RWKV_WIDTH), GATE_LORA ** -0.5),
        'rwkv_k_k': 0.85 + nrm(ks[10], (Dp, RWKV_WIDTH), 0.05),
        'rwkv_k_a': 1.0 + nrm(ks[11], (Dp, RWKV_WIDTH), 0.05),
        'rwkv_r_k': nrm(ks[12], (Dp, RWKV_HEADS, HEAD_DIM), 0.1),
        'rwkv_gn_w': 1.0 + nrm(ks[13], (Dp, RWKV_WIDTH), 0.05),
        'rwkv_gn_b': nrm(ks[14], (Dp, RWKV_WIDTH), 0.01),
        'fox_q_norm_g': 1.0 + nrm(ks[15], (Dp, HEAD_DIM), 0.05),
        'fox_k_norm_g': 1.0 + nrm(ks[16], (Dp, HEAD_DIM), 0.05),
        'fox_f_bias': jax.random.uniform(ks[17], (Dp, FOX_HEADS), F32, 1.0, 4.0),
        'w_branch_a': nrm(ks[18], (Dp, RWKV_WIDTH, D_MODEL), RWKV_WIDTH ** -0.5),
        'w_branch_b': nrm(ks[19], (Dp, FOX_WIDTH, D_MODEL), FOX_WIDTH ** -0.5),
        'w_o': nrm(ks[20], (Dp, D_MODEL, D_MODEL), D_MODEL ** -0.5),
        'norm2_g': 1.0 + nrm(ks[21], (Dp, D_MODEL), 0.05),
        'w_gate_up': nrm(ks[22], (Dp, D_MODEL, 2 * D_FF), D_MODEL ** -0.5),
        'w_down': nrm(ks[23], (Dp, D_FF, D_MODEL), D_FF ** -0.5),
    }


def reference(x, meta_tokens, norm1_g, w_in, rwkv_mu, rwkv_w0, rwkv_w2, rwkv_a0, rwkv_a2,
              rwkv_g2, rwkv_k_k, rwkv_k_a, rwkv_r_k, rwkv_gn_w, rwkv_gn_b, fox_q_norm_g,
              fox_k_norm_g, fox_f_bias, w_branch_a, w_branch_b, w_o, norm2_g, w_gate_up, w_down):
    B = x.shape[0]
    meta = jnp.broadcast_to(meta_tokens.astype(x.dtype)[None], (B, N_META, D_MODEL))
    h = jnp.concatenate([meta, x], axis=1)
    for l in range(DEPTH):
        h = _layer(h, norm1_g[l], w_in[l], rwkv_mu[l], rwkv_w0[l], rwkv_w2[l], rwkv_a0[l],
                   rwkv_a2[l], rwkv_g2[l], rwkv_k_k[l], rwkv_k_a[l], rwkv_r_k[l], rwkv_gn_w[l],
                   rwkv_gn_b[l], fox_q_norm_g[l], fox_k_norm_g[l], fox_f_bias[l], w_branch_a[l],
                   w_branch_b[l], w_o[l], norm2_g[l], w_gate_up[l], w_down[l])
    return h[:, N_META:]
```

```cpp
#include <hip/hip_runtime.h>
#include <hip/hip_cooperative_groups.h>
#include <cstdio>
#include <cstdint>
namespace cg = cooperative_groups;
namespace pg8 {
#define PG8_LAS __attribute__((address_space(3)))
typedef unsigned short bf16_t;
typedef short bf16x8 __attribute__((ext_vector_type(8)));
typedef float f32x4 __attribute__((ext_vector_type(4)));
typedef unsigned u32x4 __attribute__((ext_vector_type(4)));
constexpr int BM = 256, BK = 64, HALF = 128, HTB = HALF * BK * 2  , STAGE_BYTES = 8 * HTB, NXCD = 8, WGM = 8;

__host__ __device__ __forceinline__ int lds_byte(int r, int c) { const int st = (r >> 4) * 2 + (c >> 5), rr = r & 15, cc = c & 31, ob = rr * 64 + cc * 2; return st * 1024 + (ob ^ (((ob >> 9) & 1) << 5)); }
__host__ __device__ __forceinline__ void stage_rc(int b, int& R, int& C) { const int st = b / 1024, sb = b % 1024, swz = sb ^ (((sb >> 9) & 1) << 5); R = (st >> 1) * 16 + swz / 64; C = (st & 1) * 32 + (swz % 64) / 2; }
__host__ __device__ __forceinline__ int perm32(int rho) { const int n = rho >> 4, i = rho & 15; return 8 * (i >> 2) + 4 * n + (i & 3); }

struct Unit { int pm, pn; };
struct Gemm { const bf16_t* A; const bf16_t* Bt; int M, N, K; };

struct StaticOrder {
    int nM, nN, nwg, G, c;
    __host__ __device__ void init(int M, int N, int G_, int c_) { nM = M / BM; nN = N / BM; nwg = nM * nN; G = G_; c = c_; }
    __host__ __device__ bool next(int i, Unit& u) const {
        const long L = (long)i * G + c; if (L >= nwg) return false;
        int wgid = (int)L; { const int q = nwg / NXCD, r = nwg % NXCD, xcd = wgid % NXCD, off = wgid / NXCD; wgid = (xcd < r ? xcd * (q + 1) : r * (q + 1) + (xcd - r) * q) + off; }
        const int nig = WGM * nN, gid = wgid / nig, fm = gid * WGM, gsz = (nM - fm) < WGM ? (nM - fm) : WGM;
        u.pm = fm + ((wgid % nig) % gsz); u.pn = (wgid % nig) / gsz; return true;
    }
    __device__ __forceinline__ void a_ready(const Unit&) const {}
    __device__ __forceinline__ void done(const Unit&) const {}
};

__device__ __forceinline__ unsigned cvt_pk_bf16(float lo, float hi) { unsigned r; asm volatile("v_cvt_pk_bf16_f32 %0, %1, %2" : "=v"(r) : "v"(lo), "v"(hi)); return r; }

template <class Epi, class Sched, bool ALIGN_EPI = false, bool SP2 = false>
__device__ __forceinline__ void gemm_phase(PG8_LAS unsigned char* lds, const Gemm g, const Sched& S, const Epi& E) {
    int tid_ = threadIdx.x; asm volatile("" : "+v"(tid_));
    const int tid = tid_, wid = __builtin_amdgcn_readfirstlane(tid >> 6), lane = tid & 63, wr = wid >> 2, wc = wid & 3, fr = lane & 15, fq = lane >> 4;
    const int K = g.K, nt = K / BK;
    unsigned voffA[2], voffB[2];
#pragma unroll
    for (int i = 0; i < 2; ++i) { int R, C; stage_rc(tid * 16 + i * 8192, R, C); const int Rb = Epi::PERM ? ((R & ~31) + perm32(R & 31)) : R;
        voffA[i] = (unsigned)(R * K + C) * 2u; voffB[i] = (unsigned)(Rb * K + C) * 2u; }
    const size_t kstep = (size_t)(BK * 2);
    const size_t hstep = (size_t)HALF * K * 2;
    const size_t tstep = 2 * hstep;
    const unsigned ldsw = (unsigned)wid * 1024u;
    const int aoff = lds_byte(wr * 64 + fr, fq * 8), boff = lds_byte(wc * 32 + fr, fq * 8);
#define PG8_SA(b, h) (((b) * 2 + (h)) * HTB)
#define PG8_SB(b, h) ((4 + (b) * 2 + (h)) * HTB)
#define PG8_STAGE(bufoff, gbase, voff) do { _Pragma("unroll") for (int _i = 0; _i < 2; ++_i) \
        __builtin_amdgcn_global_load_lds((const unsigned*)((const char*)(gbase) + (voff)[_i]), (PG8_LAS unsigned*)(lds + (bufoff) + ldsw + _i * 8192), 16, 0, 0); } while (0)
#define PG8_LDA(dst, b, h) do { _Pragma("unroll") for (int m = 0; m < 4; ++m) _Pragma("unroll") for (int k = 0; k < 2; ++k) dst[m][k] = *(const PG8_LAS bf16x8*)(lds + PG8_SA(b, h) + aoff + m * 2048 + k * 1024); } while (0)
#define PG8_LDB(dst, b, h) do { _Pragma("unroll") for (int n = 0; n < 2; ++n) _Pragma("unroll") for (int k = 0; k < 2; ++k) dst[n][k] = *(const PG8_LAS bf16x8*)(lds + PG8_SB(b, h) + boff + n * 2048 + k * 1024); } while (0)
#define PG8_MMA(ai, bj, At, Bt) do { __builtin_amdgcn_s_setprio(1); _Pragma("unroll") for (int m = 0; m < 4; ++m) _Pragma("unroll") for (int n = 0; n < 2; ++n) _Pragma("unroll") for (int k = 0; k < 2; ++k) \
        acc[ai][bj][m][n] = __builtin_amdgcn_mfma_f32_16x16x32_bf16(Bt[n][k], At[m][k], acc[ai][bj][m][n], 0, 0, 0); __builtin_amdgcn_s_setprio(0); } while (0)
#define PG8_WAIT_V(n) asm volatile("s_waitcnt vmcnt(" #n ")" ::: "memory")
#define PG8_WAIT_L(n) asm volatile("s_waitcnt lgkmcnt(" #n ")" ::: "memory")
#define PG8_BAR __builtin_amdgcn_s_barrier()
#define PG8_SCHED __builtin_amdgcn_sched_barrier(0)
    Unit cur, nxt; int ui = 0;
    if (!S.next(0, cur)) return;
    f32x4 acc[2][2][4][2];
#pragma unroll
    for (int a = 0; a < 2; ++a)
#pragma unroll
        for (int b = 0; b < 2; ++b)
#pragma unroll
            for (int m = 0; m < 4; ++m)
#pragma unroll
                for (int n = 0; n < 2; ++n) acc[a][b][m][n] = (f32x4){0.f, 0.f, 0.f, 0.f};
    bf16x8 At[4][2], B0[2][2], B1[2][2];
    const char* cA = (const char*)g.A + (size_t)cur.pm * tstep; const char* cB = (const char*)g.Bt + (size_t)cur.pn * tstep;
    S.a_ready(cur);
    if constexpr (SP2) {
        PG8_STAGE(PG8_SB(0, 0), cB, voffB); PG8_STAGE(PG8_SB(0, 1), cB + hstep, voffB); PG8_STAGE(PG8_SA(0, 0), cA, voffA); PG8_STAGE(PG8_SA(0, 1), cA + hstep, voffA);
        if (wr == 1) PG8_BAR;
        PG8_WAIT_V(2); PG8_BAR;
        PG8_STAGE(PG8_SB(1, 0), cB + kstep, voffB); PG8_STAGE(PG8_SA(1, 0), cA + kstep, voffA); PG8_STAGE(PG8_SB(1, 1), cB + hstep + kstep, voffB);
        PG8_WAIT_V(6); PG8_BAR;
    } else {
        PG8_STAGE(PG8_SB(0, 0), cB, voffB); PG8_STAGE(PG8_SA(0, 0), cA, voffA); PG8_STAGE(PG8_SB(0, 1), cB + hstep, voffB); PG8_STAGE(PG8_SA(0, 1), cA + hstep, voffA);
        if (wr == 1) PG8_BAR;
        PG8_WAIT_V(4); PG8_BAR;
        PG8_STAGE(PG8_SB(1, 0), cB + kstep, voffB); PG8_STAGE(PG8_SA(1, 0), cA + kstep, voffA); PG8_STAGE(PG8_SB(1, 1), cB + hstep + kstep, voffB);
        PG8_WAIT_V(6); PG8_BAR;
    }
    for (;;) {
        const bool has_next = S.next(ui + 1, nxt);
        const char* nA = has_next ? (const char*)g.A + (size_t)nxt.pm * tstep : cA; const char* nB = has_next ? (const char*)g.Bt + (size_t)nxt.pn * tstep : cB;
        for (int t = 0; t < nt; t += 2) {
            const bool last = (t == nt - 2);
            const char* a1 = cA + (size_t)(t + 1) * kstep;
            const char* a2 = last ? nA : cA + (size_t)(t + 2) * kstep; const char* b2 = last ? nB : cB + (size_t)(t + 2) * kstep;
            const char* a3 = a2 + kstep; const char* b3 = b2 + kstep;
            if (last && has_next) S.a_ready(nxt);
            if constexpr (SP2) {
            PG8_LDB(B0, 0, 0); PG8_LDB(B1, 0, 1); PG8_SCHED; PG8_LDA(At, 0, 0); PG8_STAGE(PG8_SA(1, 1), a1 + hstep, voffA);
            PG8_WAIT_V(8); PG8_WAIT_L(0); PG8_BAR; PG8_MMA(0, 0, At, B0); PG8_MMA(0, 1, At, B1); PG8_BAR; PG8_SCHED;
            PG8_LDA(At, 0, 1); PG8_STAGE(PG8_SB(0, 0), b2, voffB); PG8_STAGE(PG8_SB(0, 1), b2 + hstep, voffB); PG8_STAGE(PG8_SA(0, 0), a2, voffA);
            PG8_WAIT_V(8); PG8_WAIT_L(0); PG8_BAR; PG8_MMA(1, 0, At, B0); PG8_MMA(1, 1, At, B1); PG8_BAR; PG8_SCHED;
            PG8_LDB(B0, 1, 0); PG8_LDB(B1, 1, 1); PG8_SCHED; PG8_LDA(At, 1, 0); PG8_STAGE(PG8_SA(0, 1), a2 + hstep, voffA);
            PG8_WAIT_V(8); PG8_WAIT_L(0); PG8_BAR; PG8_MMA(0, 0, At, B0); PG8_MMA(0, 1, At, B1); PG8_BAR; PG8_SCHED;
            PG8_LDA(At, 1, 1); PG8_STAGE(PG8_SB(1, 0), b3, voffB); PG8_STAGE(PG8_SB(1, 1), b3 + hstep, voffB); PG8_STAGE(PG8_SA(1, 0), a3, voffA);
            PG8_WAIT_V(8); PG8_WAIT_L(0); PG8_BAR; PG8_MMA(1, 0, At, B0); PG8_MMA(1, 1, At, B1); PG8_BAR; PG8_SCHED;
            } else {
            PG8_LDB(B0, 0, 0); PG8_SCHED; PG8_LDA(At, 0, 0); PG8_STAGE(PG8_SA(1, 1), a1 + hstep, voffA);
            PG8_WAIT_L(8); PG8_BAR; PG8_WAIT_L(0); PG8_MMA(0, 0, At, B0); PG8_BAR; PG8_SCHED;
            PG8_LDB(B1, 0, 1); PG8_STAGE(PG8_SB(0, 0), b2, voffB);
            PG8_BAR; PG8_WAIT_L(0); PG8_MMA(0, 1, At, B1); PG8_BAR;
            PG8_LDA(At, 0, 1); PG8_STAGE(PG8_SA(0, 0), a2, voffA);
            PG8_BAR; PG8_WAIT_L(0); PG8_MMA(1, 0, At, B0); PG8_BAR; PG8_SCHED;
            PG8_STAGE(PG8_SB(0, 1), b2 + hstep, voffB);
            PG8_WAIT_V(6); PG8_BAR; PG8_MMA(1, 1, At, B1); PG8_BAR;
            PG8_LDB(B0, 1, 0); PG8_SCHED; PG8_LDA(At, 1, 0); PG8_STAGE(PG8_SA(0, 1), a2 + hstep, voffA);
            PG8_WAIT_L(8); PG8_BAR; PG8_WAIT_L(0); PG8_MMA(0, 0, At, B0); PG8_BAR; PG8_SCHED;
            PG8_LDB(B1, 1, 1); PG8_STAGE(PG8_SB(1, 0), b3, voffB);
            PG8_BAR; PG8_WAIT_L(0); PG8_MMA(0, 1, At, B1); PG8_BAR;
            PG8_LDA(At, 1, 1); PG8_STAGE(PG8_SA(1, 0), a3, voffA);
            PG8_BAR; PG8_WAIT_L(0); PG8_MMA(1, 0, At, B0); PG8_BAR; PG8_SCHED;
            PG8_STAGE(PG8_SB(1, 1), b3 + hstep, voffB);
            PG8_WAIT_V(6); PG8_BAR; PG8_MMA(1, 1, At, B1); PG8_BAR;
            }
        }
        if constexpr (ALIGN_EPI) { if (wr == 0) PG8_BAR; }
        if constexpr (!Epi::AFTER_DRAIN) { E(acc, cur, wr, wc, fr, fq); S.done(cur); }
        if (!has_next) break;
#pragma unroll
        for (int a = 0; a < 2; ++a)
#pragma unroll
            for (int b = 0; b < 2; ++b)
#pragma unroll
                for (int m = 0; m < 4; ++m)
#pragma unroll
                    for (int n = 0; n < 2; ++n) acc[a][b][m][n] = (f32x4){0.f, 0.f, 0.f, 0.f};
        cur = nxt; cA = nA; cB = nB; ++ui;
        if constexpr (ALIGN_EPI) { if (wr == 1) PG8_BAR; }
    }
    PG8_WAIT_V(0);
    if constexpr (!ALIGN_EPI) { if (wr == 0) PG8_BAR; }
    PG8_BAR;
    if constexpr (Epi::AFTER_DRAIN) { E.fused(acc, cur, wr, wc, fr, fq, lds, wid, lane); S.done(cur); }
#undef PG8_SA
#undef PG8_SB
#undef PG8_STAGE
#undef PG8_LDA
#undef PG8_LDB
#undef PG8_MMA
#undef PG8_WAIT_V
#undef PG8_WAIT_L
#undef PG8_BAR
#undef PG8_SCHED
}
}

#define GAS __attribute__((address_space(1)))
#define LAS __attribute__((address_space(3)))
typedef unsigned short bf16;
typedef unsigned v4u __attribute__((ext_vector_type(4)));
typedef unsigned v2u __attribute__((ext_vector_type(2)));
typedef float f4 __attribute__((ext_vector_type(4)));
typedef float f2 __attribute__((ext_vector_type(2)));
typedef short bf16x8 __attribute__((ext_vector_type(8)));
typedef float f32x16 __attribute__((ext_vector_type(16)));
#define LDS_WAIT() asm volatile("s_waitcnt lgkmcnt(0)" ::: "memory")
__device__ __forceinline__ unsigned f2bf(float f) { unsigned u = __builtin_bit_cast(unsigned, f); return (u + 0x7fffu + ((u >> 16) & 1u)) >> 16; }
__device__ __forceinline__ unsigned pk2(float lo, float hi) { unsigned r; asm("v_cvt_pk_bf16_f32 %0, %1, %2" : "=v"(r) : "v"(lo), "v"(hi)); return r; }
__device__ __forceinline__ float bf2f(unsigned h) { return __uint_as_float(h << 16); }
__device__ __forceinline__ float bflo(unsigned w) { return __uint_as_float(w << 16); }
__device__ __forceinline__ float bfhi(unsigned w) { return __uint_as_float(w & 0xffff0000u); }
__device__ __forceinline__ float sigmoidf_(float x) { return __builtin_amdgcn_rcpf(1.f + __builtin_amdgcn_exp2f(-1.4426950408889634f * x)); }
__device__ __forceinline__ float wave_sum(float v) {
#pragma unroll
    for (int o = 1; o < 64; o <<= 1) v += __shfl_xor(v, o);
    return v;
}

constexpr int NWAVES = 8, NTHR = 512;
constexpr int DM = 2048, TR = 16384, TV = 16400, TP = 16640, SEQ = 4096, NBATCH = 4, NH = 16;
constexpr int N1 = 10752, ZRW = 3584, NLORA = 3072, KLORA = 512, DFF = 5632, NGU = 11264, NIN = 10704;
constexpr int KEROWS = 4160;
constexpr float C2 = 0.125f * 1.4426950408889634f;
constexpr float LOG2E = 1.4426950408889634f;
constexpr size_t MiB = (size_t)1 << 20;
constexpr size_t WS_CTL = 0, CTL_ZERO_BYTES = 192 * 1024, CTL_SSQ = 65536;
constexpr size_t WS_WIN = 1 * MiB, WS_WLORA = 43 * MiB, WS_WA = 46 * MiB, WS_WB = 50 * MiB, WS_WO = 54 * MiB, WS_WGU = 62 * MiB, WS_WDN = 106 * MiB;
constexpr size_t WS_XN = 128 * MiB, WS_U = 128 * MiB, WS_YA = 128 * MiB, WS_LA = 160 * MiB;
constexpr size_t WS_ZR = 193 * MiB, WS_MG = 193 * MiB, WS_XN2 = 257 * MiB;
constexpr size_t WS_Q = 307 * MiB, QKV_STRIDE_B = (size_t)TP * 1024 * 2, WS_K = WS_Q + QKV_STRIDE_B, WS_V = WS_K + QKV_STRIDE_B;
constexpr size_t WS_LW = WS_V + QKV_STRIDE_B;
constexpr size_t WS_LG = WS_LW + (size_t)TP * 1024 * 4;
constexpr size_t WS_LOGF = 502 * MiB;
constexpr size_t WS_KE = WS_LOGF + 5 * MiB / 4;
constexpr size_t WS_T1 = WS_K;
constexpr size_t WS_ACT = 321 * MiB;
constexpr size_t WS_END = WS_KE + (size_t)64 * KEROWS * 32;
static_assert(WS_END <= 512 * MiB && WS_LG + (size_t)TP * 1024 * 2 <= WS_LOGF && WS_T1 + (size_t)TR * 2048 * 4 <= WS_LOGF && WS_ACT + (size_t)TR * DFF * 2 <= WS_LOGF && WS_XN2 + (size_t)TR * 2048 * 2 <= WS_ACT, "ws map");
constexpr int LDS_BYTES = 147456;

namespace pg8 {
#define EPI_PACK8(v0, v1) ((u32x4){cvt_pk_bf16((v0)[0], (v0)[1]), cvt_pk_bf16((v0)[2], (v0)[3]), cvt_pk_bf16((v1)[0], (v1)[1]), cvt_pk_bf16((v1)[2], (v1)[3])})
__device__ __forceinline__ float sigm(float x) { return __builtin_amdgcn_rcpf(1.f + __builtin_amdgcn_exp2f(-1.4426950408889634f * x)); }
struct Epi1 { static constexpr bool PERM = true, AFTER_DRAIN = false;
    bf16_t* ZR; bf16_t* Q; bf16_t* G;
    __device__ __forceinline__ void operator()(const f32x4 (&acc)[2][2][4][2], const Unit& u, int wr, int wc, int fr, int fq) const {
        const int pn = u.pn; bf16_t* base; int ldc, colt; bool sig = false;
        if (pn < 14) { base = ZR; ldc = 3584; colt = pn * 256; }
        else if (pn < 26) { const int t = (pn - 14) >> 2; base = Q + (size_t)t * ((size_t)16640 * 1024); ldc = 1024; colt = ((pn - 14) & 3) * 256; }
        else { if (u.pm >= 64) return; base = G; ldc = 4096; colt = (pn - 26) * 256; sig = true; }
        const int row0 = u.pm * BM + wr * 64 + fr, col0 = colt + wc * 32 + 8 * fq;
#pragma unroll
        for (int ai = 0; ai < 2; ++ai)
#pragma unroll
            for (int m = 0; m < 4; ++m) { bf16_t* rowp = base + (size_t)(row0 + ai * HALF + m * 16) * ldc + col0;
#pragma unroll
                for (int bj = 0; bj < 2; ++bj) { f32x4 v0 = acc[ai][bj][m][0], v1 = acc[ai][bj][m][1];
                    if (sig) {
#pragma unroll
                        for (int e = 0; e < 4; ++e) { v0[e] = sigm(v0[e]); v1[e] = sigm(v1[e]); } }
                    *(u32x4*)(rowp + bj * HALF) = EPI_PACK8(v0, v1); } }
    }
};
struct EpiLora { static constexpr bool PERM = true, AFTER_DRAIN = false;
    const float* w0; const float* a0; float* LW; bf16_t* LA; bf16_t* LG; int mode;
    __device__ __forceinline__ void operator()(const f32x4 (&acc)[2][2][4][2], const Unit& u, int wr, int wc, int fr, int fq) const {
        const int colt = u.pn * 256;
        const int row0 = u.pm * BM + wr * 64 + fr, col0 = colt + wc * 32 + 8 * fq;
        f32x4 bv[2][2];
#pragma unroll
        for (int bj = 0; bj < 2; ++bj)
#pragma unroll
            for (int n = 0; n < 2; ++n) bv[bj][n] = mode == 0 ? *(const f32x4*)(w0 + col0 + bj * HALF + 4 * n) : (mode == 1 ? *(const f32x4*)(a0 + col0 + bj * HALF + 4 * n) : (f32x4){0.f, 0.f, 0.f, 0.f});
#pragma unroll
        for (int ai = 0; ai < 2; ++ai)
#pragma unroll
            for (int m = 0; m < 4; ++m) { const size_t ro = (size_t)(row0 + ai * HALF + m * 16) * 1024 + col0;
#pragma unroll
                for (int bj = 0; bj < 2; ++bj) { f32x4 v0 = acc[ai][bj][m][0] + bv[bj][0], v1 = acc[ai][bj][m][1] + bv[bj][1];
                    if (mode == 0) {
#pragma unroll
                        for (int e = 0; e < 4; ++e) { v0[e] = __builtin_amdgcn_exp2f(-0.60653066f * 1.4426950408889634f * sigm(v0[e])); v1[e] = __builtin_amdgcn_exp2f(-0.60653066f * 1.4426950408889634f * sigm(v1[e])); }
                        *(f32x4*)(LW + ro + bj * HALF) = v0; *(f32x4*)(LW + ro + bj * HALF + 4) = v1;
                    } else if (mode == 1) {
#pragma unroll
                        for (int e = 0; e < 4; ++e) { v0[e] = sigm(v0[e]); v1[e] = sigm(v1[e]); }
                        *(u32x4*)(LA + ro + bj * HALF) = EPI_PACK8(v0, v1);
                    } else { *(u32x4*)(LG + ro + bj * HALF) = EPI_PACK8(v0, v1); } } }
    }
};
__device__ __forceinline__ void unpack8(const u32x4 w, float (&g)[8]) {
#pragma unroll
    for (int e = 0; e < 4; ++e) { g[2 * e] = __uint_as_float(w[e] << 16); g[2 * e + 1] = __uint_as_float(w[e] & 0xffff0000u); }
}
struct EpiB { static constexpr bool PERM = true, AFTER_DRAIN = false;
    const bf16_t* G; bf16_t* T1;
    __device__ __forceinline__ void operator()(const f32x4 (&acc)[2][2][4][2], const Unit& u, int wr, int wc, int fr, int fq) const {
        const int row0 = u.pm * BM + wr * 64 + fr, col0 = u.pn * BM + wc * 32 + 8 * fq;
#pragma unroll
        for (int ai = 0; ai < 2; ++ai)
#pragma unroll
            for (int m = 0; m < 4; ++m) { const size_t r = (size_t)(row0 + ai * HALF + m * 16);
#pragma unroll
                for (int bj = 0; bj < 2; ++bj) { const int c = col0 + bj * HALF; float g[8]; unpack8(*(const u32x4*)(G + r * 4096 + 2048 + c), g);
                    f32x4 v0 = acc[ai][bj][m][0], v1 = acc[ai][bj][m][1];
#pragma unroll
                    for (int e = 0; e < 4; ++e) { v0[e] *= g[e]; v1[e] *= g[4 + e]; }
                    *(u32x4*)(T1 + r * 2048 + c) = EPI_PACK8(v0, v1); } }
    }
};
struct EpiA { static constexpr bool PERM = true, AFTER_DRAIN = false;
    const bf16_t* G; const bf16_t* T1; bf16_t* MG;
    __device__ __forceinline__ void operator()(const f32x4 (&acc)[2][2][4][2], const Unit& u, int wr, int wc, int fr, int fq) const {
        const int row0 = u.pm * BM + wr * 64 + fr, col0 = u.pn * BM + wc * 32 + 8 * fq;
#pragma unroll
        for (int ai = 0; ai < 2; ++ai)
#pragma unroll
            for (int m = 0; m < 4; ++m) { const size_t r = (size_t)(row0 + ai * HALF + m * 16);
#pragma unroll
                for (int bj = 0; bj < 2; ++bj) { const int c = col0 + bj * HALF; float g[8], t[8]; unpack8(*(const u32x4*)(G + r * 4096 + c), g); unpack8(*(const u32x4*)(T1 + r * 2048 + c), t);
                    f32x4 v0 = acc[ai][bj][m][0], v1 = acc[ai][bj][m][1];
#pragma unroll
                    for (int e = 0; e < 4; ++e) { v0[e] = t[e] + v0[e] * g[e]; v1[e] = t[4 + e] + v1[e] * g[4 + e]; }
                    *(u32x4*)(MG + r * 2048 + c) = EPI_PACK8(v0, v1); } }
    }
};
struct EpiO { static constexpr bool PERM = true, AFTER_DRAIN = false;
    const float* x; const float* n2; float* H1; bf16_t* XN2; float* ssq;
    __device__ __forceinline__ void operator()(const f32x4 (&acc)[2][2][4][2], const Unit& u, int wr, int wc, int fr, int fq) const {
        const int row0 = u.pm * BM + wr * 64 + fr, col0 = u.pn * BM + wc * 32 + 8 * fq;
        f32x4 nv[2][2];
#pragma unroll
        for (int bj = 0; bj < 2; ++bj)
#pragma unroll
            for (int n = 0; n < 2; ++n) nv[bj][n] = *(const f32x4*)(n2 + col0 + bj * HALF + 4 * n);
#pragma unroll
        for (int ai = 0; ai < 2; ++ai)
#pragma unroll
            for (int m = 0; m < 4; ++m) { const size_t r = (size_t)(row0 + ai * HALF + m * 16); float sq = 0.f;
#pragma unroll
                for (int bj = 0; bj < 2; ++bj) { const int c = col0 + bj * HALF;
                    const f32x4 h0 = acc[ai][bj][m][0] + *(const f32x4*)(x + r * 2048 + c), h1 = acc[ai][bj][m][1] + *(const f32x4*)(x + r * 2048 + c + 4);
                    *(f32x4*)(H1 + r * 2048 + c) = h0; *(f32x4*)(H1 + r * 2048 + c + 4) = h1;
                    sq += (h0[0] * h0[0] + h0[1] * h0[1]) + (h0[2] * h0[2] + h0[3] * h0[3]) + (h1[0] * h1[0] + h1[1] * h1[1]) + (h1[2] * h1[2] + h1[3] * h1[3]);
                    const f32x4 a0 = h0 * nv[bj][0], a1 = h1 * nv[bj][1];
                    *(u32x4*)(XN2 + r * 2048 + c) = EPI_PACK8(a0, a1); }
                sq += __shfl_xor(sq, 16); sq += __shfl_xor(sq, 32);
                if (fq == 0) atomicAdd(ssq + r, sq); }
    }
};
struct EpiGU { static constexpr bool PERM = true, AFTER_DRAIN = false;
    const float* ssq; bf16_t* ACT;
    __device__ __forceinline__ void operator()(const f32x4 (&acc)[2][2][4][2], const Unit& u, int wr, int wc, int fr, int fq) const {
        const int row0 = u.pm * BM + wr * 64 + fr, col0 = u.pn * HALF + wc * 32 + 8 * fq;
#pragma unroll
        for (int ai = 0; ai < 2; ++ai)
#pragma unroll
            for (int m = 0; m < 4; ++m) { const size_t r = (size_t)(row0 + ai * HALF + m * 16);
                const float rstd = 1.0f / sqrtf(ssq[r] * (1.0f / 2048.0f) + 1e-6f);
                f32x4 o0, o1;
#pragma unroll
                for (int e = 0; e < 4; ++e) { const float g0 = acc[ai][0][m][0][e] * rstd, u0 = acc[ai][1][m][0][e] * rstd, g1 = acc[ai][0][m][1][e] * rstd, u1 = acc[ai][1][m][1][e] * rstd;
                    o0[e] = g0 * sigm(g0) * u0; o1[e] = g1 * sigm(g1) * u1; }
                *(u32x4*)(ACT + r * 5632 + col0) = EPI_PACK8(o0, o1); }
    }
};
struct EpiDN { static constexpr bool PERM = true, AFTER_DRAIN = false;
    float* out;
    __device__ __forceinline__ void operator()(const f32x4 (&acc)[2][2][4][2], const Unit& u, int wr, int wc, int fr, int fq) const {
        const int row0 = u.pm * BM + wr * 64 + fr, col0 = u.pn * BM + wc * 32 + 8 * fq;
#pragma unroll
        for (int ai = 0; ai < 2; ++ai)
#pragma unroll
            for (int m = 0; m < 4; ++m) { const size_t r = (size_t)(row0 + ai * HALF + m * 16);
#pragma unroll
                for (int bj = 0; bj < 2; ++bj) { float* p = out + r * 2048 + col0 + bj * HALF;
                    const f32x4 h0 = *(const f32x4*)p + acc[ai][bj][m][0], h1 = *(const f32x4*)(p + 4) + acc[ai][bj][m][1];
                    *(f32x4*)p = h0; *(f32x4*)(p + 4) = h1; } }
    }
};
}

__device__ __forceinline__ void transpose_item(const float* W, int N, int K, bf16* WT, int src_col0, int dst_row0, int ncols, int kb, int nb, LAS float* scr, int lane) {
    const int k0 = 64 * kb, n0 = 32 * nb, kr = lane >> 3, c4 = lane & 7; const bool nv = (n0 + 4 * c4) < ncols;
    const float* src = W + (size_t)(k0 + kr) * N + src_col0 + n0 + 4 * c4;
    f4 v[8];
#pragma unroll
    for (int i = 0; i < 8; ++i) v[i] = nv ? *(const f4*)(src + (size_t)(8 * i) * N) : (f4){0.f, 0.f, 0.f, 0.f};
#pragma unroll
    for (int i = 0; i < 8; ++i) { LAS float* d = scr + (8 * i + kr) * 33 + 4 * c4; d[0] = v[i].x; d[1] = v[i].y; d[2] = v[i].z; d[3] = v[i].w; }
    LDS_WAIT(); asm volatile("" ::: "memory");
    const int c = lane & 7;
#pragma unroll
    for (int j = 0; j < 4; ++j) { const int n = (lane >> 3) + 8 * j; const LAS float* s = scr + (8 * c) * 33 + n;
        v4u o; o.x = pk2(s[0 * 33], s[1 * 33]); o.y = pk2(s[2 * 33], s[3 * 33]); o.z = pk2(s[4 * 33], s[5 * 33]); o.w = pk2(s[6 * 33], s[7 * 33]);
        if (n0 + n < ncols) *(v4u*)(WT + (size_t)(dst_row0 + n0 + n) * K + k0 + 8 * c) = o; }
    LDS_WAIT(); asm volatile("" ::: "memory");
}

struct Ptrs {
    const float *x, *meta, *n1, *w_in, *mu, *w0, *w2, *a0, *a2, *g2, *k_k, *k_a, *r_k, *gn_w, *gn_b, *q_g, *k_g, *f_bias, *w_a, *w_b, *w_o, *n2, *w_gu, *w_dn;
    float* out; unsigned char* ws;
};

template <bool LATE> __device__ __forceinline__ void p0_prologue(const Ptrs& P, LAS unsigned char* lds, int tid, int bi, int nb) {
    const int lane = tid & 63, wave = tid >> 6;
    LAS float* scr = (LAS float*)(lds + wave * 16384);
    const int gw = bi * NWAVES + wave, NGW = nb * NWAVES;
    bf16* WIN = (bf16*)(P.ws + WS_WIN); bf16* WA = (bf16*)(P.ws + WS_WA); bf16* WB = (bf16*)(P.ws + WS_WB); bf16* WO = (bf16*)(P.ws + WS_WO);
    bf16* WGU = (bf16*)(P.ws + WS_WGU); bf16* WDN = (bf16*)(P.ws + WS_WDN); bf16* WL = (bf16*)(P.ws + WS_WLORA); bf16* XN = (bf16*)(P.ws + WS_XN);
    constexpr int I0 = 32 * 110, I1 = 32 * 1, I2 = 32 * 96, I3 = 32 * 128, I4 = 16 * 64, I5 = 16 * 64, I6 = 32 * 64, I7 = 88 * 128, I8 = 88 * 64;
    constexpr int NITEMS = I0 + I1 + I2 + I3 + I4 + I5 + I6 + I7 + I8;
    constexpr int NEARLY = I0 + I1 + I2 + I3;
    for (int it = (LATE ? NEARLY : 0) + gw; it < (LATE ? NITEMS : NEARLY); it += NGW) {
        int r = it;
        if (r < I0) { transpose_item(P.w_in, NIN, 2048, WIN, 0, 0, 3520, r / 110, r % 110, scr, lane); continue; } r -= I0;
        if (r < I1) { transpose_item(P.w_in, NIN, 2048, WIN, 6592, 3520, 16, r, 0, scr, lane); continue; } r -= I1;
        if (r < I2) { transpose_item(P.w_in, NIN, 2048, WIN, 3520, 3584, 3072, r / 96, r % 96, scr, lane); continue; } r -= I2;
        if (r < I3) { transpose_item(P.w_in, NIN, 2048, WIN, 6608, 6656, 4096, r / 128, r % 128, scr, lane); continue; } r -= I3;
        if (r < I4) { transpose_item(P.w_a, 2048, 1024, WA, 0, 0, 2048, r / 64, r % 64, scr, lane); continue; } r -= I4;
        if (r < I5) { transpose_item(P.w_b, 2048, 1024, WB, 0, 0, 2048, r / 64, r % 64, scr, lane); continue; } r -= I5;
        if (r < I6) { transpose_item(P.w_o, 2048, 2048, WO, 0, 0, 2048, r / 64, r % 64, scr, lane); continue; } r -= I6;
        if (r < I7) { const int seg = r / 128, rem = r % 128, q = seg >> 1, bj = seg & 1;
            transpose_item(P.w_gu, NGU, 2048, WGU, bj * DFF + 128 * q, 256 * q + 128 * bj, 128, rem / 4, rem % 4, scr, lane); continue; } r -= I7;
        transpose_item(P.w_dn, 2048, DFF, WDN, 0, 0, 2048, r / 64, r % 64, scr, lane);
    }
    if (LATE) return;
    for (int t = gw; t < TP; t += NGW) {
        bf16* orow = XN + (size_t)t * DM;
        if (t >= TV) {
#pragma unroll
            for (int j = 0; j < 4; ++j) *(v4u*)(orow + 8 * (lane + 64 * j)) = (v4u){0u, 0u, 0u, 0u};
            continue; }
        const float* src = (t < TR) ? P.x + (size_t)t * DM : P.meta + (size_t)(t - TR) * DM;
        f4 v[8]; float ss = 0.f;
#pragma unroll
        for (int j = 0; j < 8; ++j) { v[j] = *(const f4*)(src + 4 * (lane + 64 * j)); ss += (v[j].x * v[j].x + v[j].y * v[j].y) + (v[j].z * v[j].z + v[j].w * v[j].w); }
        const float rstd = 1.0f / sqrtf(wave_sum(ss) * (1.0f / DM) + 1e-6f);
#pragma unroll
        for (int j = 0; j < 8; ++j) { const f4 g = *(const f4*)(P.n1 + 4 * (lane + 64 * j));
            *(v2u*)(orow + 4 * (lane + 64 * j)) = (v2u){pk2(v[j].x * rstd * g.x, v[j].y * rstd * g.y), pk2(v[j].z * rstd * g.z, v[j].w * rstd * g.w)}; }
    }
    const int gt = blockIdx.x * NTHR + tid, NGT = gridDim.x * NTHR;
    for (int idx = gt; idx < 16384; idx += NGT) { const int n = idx & 1023, c = idx >> 10; float v[8];
#pragma unroll
        for (int e = 0; e < 8; ++e) { const int k = 8 * c + e; v[e] = k < 96 ? P.w2[(size_t)k * 1024 + n] : 0.f; }
        *(v4u*)(WL + (size_t)n * 128 + 8 * c) = (v4u){pk2(v[0], v[1]), pk2(v[2], v[3]), pk2(v[4], v[5]), pk2(v[6], v[7])}; }
    for (int idx = gt; idx < 16384; idx += NGT) { const int n = idx & 1023, c = idx >> 10; float v[8];
#pragma unroll
        for (int e = 0; e < 8; ++e) { const int k = 8 * c + e; v[e] = k < 96 ? P.a2[(size_t)k * 1024 + n] : 0.f; }
        *(v4u*)(WL + 131072 + (size_t)n * 128 + 8 * c) = (v4u){pk2(v[0], v[1]), pk2(v[2], v[3]), pk2(v[4], v[5]), pk2(v[6], v[7])}; }
    for (int idx = gt; idx < 32768; idx += NGT) { const int n = idx & 1023, c = idx >> 10; float v[8];
#pragma unroll
        for (int e = 0; e < 8; ++e) { const int k = 8 * c + e; v[e] = P.g2[(size_t)k * 1024 + n]; }
        *(v4u*)(WL + 262144 + (size_t)n * 256 + 8 * c) = (v4u){pk2(v[0], v[1]), pk2(v[2], v[3]), pk2(v[4], v[5]), pk2(v[6], v[7])}; }
    for (int idx = gt; idx < 48 * 256; idx += NGT) *(v4u*)(WIN + (size_t)(3536 + idx / 256) * 2048 + 8 * (idx % 256)) = (v4u){0u, 0u, 0u, 0u};
}

__device__ __forceinline__ void p2a_prep(const Ptrs& P, int tid) {
    const int lane = tid & 63, wave = tid >> 6;
    const int gw = blockIdx.x * NWAVES + wave, NGW = gridDim.x * NWAVES;
    const bf16* ZR = (const bf16*)(P.ws + WS_ZR); bf16* U = (bf16*)(P.ws + WS_U); bf16* Q = (bf16*)(P.ws + WS_Q); bf16* K = (bf16*)(P.ws + WS_K);
    float* LOGF = (float*)(P.ws + WS_LOGF);
    for (int t = gw; t < TP; t += NGW) {
        bf16* u1 = U + (size_t)t * 128; bf16* u2 = U + (size_t)TP * 128 + (size_t)t * 128; bf16* u3 = U + (size_t)TP * 256 + (size_t)t * 256;
        if (t >= TV) { if (lane < 16) { *(v4u*)(u1 + 8 * lane) = (v4u){0u, 0u, 0u, 0u}; *(v4u*)(u2 + 8 * lane) = (v4u){0u, 0u, 0u, 0u}; } if (lane < 32) *(v4u*)(u3 + 8 * lane) = (v4u){0u, 0u, 0u, 0u}; continue; }
        const int tp = (t < TR) ? ((t & (SEQ - 1)) ? t - 1 : TV - 1) : (t > TR ? t - 1 : -1);
        const bf16* z = ZR + (size_t)t * ZRW; const bf16* zp = ZR + (size_t)(tp < 0 ? 0 : tp) * ZRW;
        for (int c = lane; c < 448; c += 64) {
            const float zc = bf2f(z[3072 + c]), zq = tp < 0 ? 0.f : bf2f(zp[3072 + c]);
            const float zs = zc + (zq - zc) * P.mu[3072 + c];
            if (c < 96) { const float e = __builtin_amdgcn_exp2f(2.f * LOG2E * zs); u1[c] = (bf16)f2bf(1.f - 2.f * __builtin_amdgcn_rcpf(e + 1.f)); }
            else if (c < 192) u2[c - 96] = (bf16)f2bf(zs);
            else u3[c - 192] = (bf16)f2bf(sigmoidf_(zs));
        }
        if (lane < 32) { u1[96 + lane] = 0; u2[96 + lane] = 0; }
        if (lane < 16) { const float xx = bf2f(z[3520 + lane]) + P.f_bias[lane];
            LOGF[(size_t)t * 16 + lane] = fminf(xx, 0.f) - log1pf(__expf(-fabsf(xx))); }
#pragma unroll
        for (int which = 0; which < 2; ++which) {
            bf16* row = (which ? K : Q) + (size_t)t * 1024 + 16 * lane; const float* g = (which ? P.k_g : P.q_g) + 16 * (lane & 3);
            const v4u w0 = *(const v4u*)row, w1 = *(const v4u*)(row + 8); float v[16];
#pragma unroll
            for (int e = 0; e < 4; ++e) { v[2 * e] = bflo(w0[e]); v[2 * e + 1] = bfhi(w0[e]); v[8 + 2 * e] = bflo(w1[e]); v[8 + 2 * e + 1] = bfhi(w1[e]); }
            float ss = 0.f;
#pragma unroll
            for (int e = 0; e < 16; ++e) ss += v[e] * v[e];
            ss += __shfl_xor(ss, 1); ss += __shfl_xor(ss, 2);
            const float rs = (1.0f / sqrtf(ss * (1.0f / 64.0f) + 1e-6f)) * (which ? 1.0f : C2);
#pragma unroll
            for (int e = 0; e < 16; ++e) v[e] = v[e] * rs * g[e];
            *(v4u*)row = (v4u){pk2(v[0], v[1]), pk2(v[2], v[3]), pk2(v[4], v[5]), pk2(v[6], v[7])};
            *(v4u*)(row + 8) = (v4u){pk2(v[8], v[9]), pk2(v[10], v[11]), pk2(v[12], v[13]), pk2(v[14], v[15])};
        }
    }
}

__device__ __forceinline__ v4u split3(float x) { const unsigned h = f2bf(x); const float r1 = x - bf2f(h); const unsigned m = f2bf(r1); const float r2 = r1 - bf2f(m); const unsigned l = f2bf(r2);
    return (v4u){h | (m << 16), l, 0u, 0u}; }
__device__ __forceinline__ void p2b_cumsum(const Ptrs& P, int bh, LAS unsigned char* lds, int tid) {
    const int b = bh >> 4, h = bh & 15;
    const float* LOGF = (const float*)(P.ws + WS_LOGF); bf16* KE = (bf16*)(P.ws + WS_KE) + (size_t)bh * KEROWS * 16;
    LAS float* sc = (LAS float*)lds;
    float v[8]; float s = 0.f;
#pragma unroll
    for (int j = 0; j < 8; ++j) { s += LOGF[((size_t)b * SEQ + 8 * tid + j) * 16 + h]; v[j] = s; }
    sc[tid] = s; __syncthreads();
    for (int o = 1; o < NTHR; o <<= 1) { const float add = tid >= o ? sc[tid - o] : 0.f; __syncthreads(); sc[tid] += add; __syncthreads(); }
    const float off = sc[tid] - s;
#pragma unroll
    for (int j = 0; j < 8; ++j) { bf16* e = KE + (size_t)(64 + 8 * tid + j) * 16; *(v4u*)e = split3(-(off + v[j]) * LOG2E); *(v4u*)(e + 8) = (v4u){0u, 0u, 0u, 0u}; }
    if (tid < 64) { float kb = -30000.f;
        if (tid < 16) { float c15 = 0.f, cj = 0.f; for (int m = 0; m < 16; ++m) { const float lf = LOGF[(size_t)(TR + m) * 16 + h]; c15 += lf; if (m <= tid) cj += lf; } kb = (c15 - cj) * LOG2E; }
        bf16* e = KE + (size_t)tid * 16; *(v4u*)e = split3(kb); *(v4u*)(e + 8) = (v4u){0u, 0u, 0u, 0u}; }
    __syncthreads();
}

template <int CTRL> __device__ __forceinline__ float dppf(float v) { return __uint_as_float((unsigned)__builtin_amdgcn_update_dpp(0, (int)__float_as_uint(v), CTRL, 0xF, 0xF, true)); }
__device__ __forceinline__ float red8(float v) { v += dppf<0xB1>(v); v += dppf<0x4E>(v); v += dppf<0x141>(v); return v; }
__device__ __forceinline__ float red16(float v) { v += dppf<0xB1>(v); v += dppf<0x4E>(v); v += dppf<0x141>(v); v += dppf<0x140>(v); return v; }
constexpr int SC_T = 32, SC_ARR = SC_T * 64, SC_BUF = 6 * SC_ARR;
__device__ __forceinline__ void unpk8(const v4u w, float (&o)[8]) {
#pragma unroll
    for (int e = 0; e < 4; ++e) { o[2 * e] = bflo(w[e]); o[2 * e + 1] = bfhi(w[e]); }
}
#define SC_BAR() do { asm volatile("s_waitcnt lgkmcnt(0)" ::: "memory"); __builtin_amdgcn_s_barrier(); asm volatile("" ::: "memory"); } while (0)
constexpr int CS_XA = 0, CS_XB = 4608, CS_XK = 9216, CS_XR = 13824;
constexpr int CS_TB = 18432, CS_TK = 23552, CS_TV = 28672;
constexpr int CS_DEC = 33792, CS_WT = 41984, CS_GL = 42240;
constexpr int CS_GA = 46336, CS_GB = 48896, CS_GK = 51456;
constexpr int CS_SS = 54016, CS_RH = 63232, CS_UT = 72448, CS_YS = 77568;
constexpr int CS_FLG = 43008;
constexpr int CS_GSV = 137216;
constexpr int CS_RKS = 136960;
constexpr int CS_PRM = 134912;
constexpr int CS_OP2 = 101120;
constexpr int CS_LP = 85760, CS_LT = 98560;
__device__ __forceinline__ f32x16 mfma32(bf16x8 a, bf16x8 b, f32x16 c) { return __builtin_amdgcn_mfma_f32_32x32x16_bf16(a, b, c, 0, 0, 0); }
__device__ __forceinline__ int crow(int r, int hi) { return (r & 3) + 8 * (r >> 2) + 4 * hi; }
__device__ __forceinline__ void p3_scanc(const Ptrs& P, int bh, LAS unsigned char* lds, int tid) {
    const int lane = tid & 63, wid = __builtin_amdgcn_readfirstlane(tid >> 6), b = bh >> 4, h = bh & 15, n = lane & 31, hi = lane >> 5;
    const bf16* ZR = (const bf16*)(P.ws + WS_ZR); const float* LW = (const float*)(P.ws + WS_LW); const bf16* LA = (const bf16*)(P.ws + WS_LA); const bf16* LG = (const bf16*)(P.ws + WS_LG);
    bf16* YA = (bf16*)(P.ws + WS_YA);
    constexpr int NSTEP = 16 + SEQ, NCH = (NSTEP + 31) / 32;
    constexpr int OPB = 33792;
    const bool prep = wid >= 4;
    const int t2 = tid & 255, sl = t2 >> 3, cgp = t2 & 7, c0 = h * 64 + 8 * cgp, pw = (wid & 3), q8 = lane >> 3;
    { const int kind = tid >> 6, ch = tid & 63; const float* srcp = kind == 0 ? P.mu : kind == 1 ? P.mu + 1024 : kind == 2 ? P.mu + 2048 : kind == 3 ? P.k_k : kind == 4 ? P.k_a : kind == 5 ? P.r_k : kind == 6 ? P.gn_w : P.gn_b;
      ((LAS float*)(lds + CS_PRM))[kind * 64 + ch] = srcp[h * 64 + ch]; }
    if (tid == 0) *(LAS unsigned*)(lds + CS_FLG) = 0u;
#define CS_PRM8(kind, arr) float arr[8]; { const f4 p0_ = *(const LAS f4*)(lds + CS_PRM + (kind) * 256 + cgp * 32), p1_ = *(const LAS f4*)(lds + CS_PRM + (kind) * 256 + cgp * 32 + 16); \
        arr[0] = p0_.x; arr[1] = p0_.y; arr[2] = p0_.z; arr[3] = p0_.w; arr[4] = p1_.x; arr[5] = p1_.y; arr[6] = p1_.z; arr[7] = p1_.w; }
    for (int i = tid; i < 9216 / 4; i += NTHR) ((LAS unsigned*)(lds + CS_SS))[i] = 0u;
    SC_BAR();
    f32x16 ST = {};
    v4u q_zr, q_zk, q_zv, q_pr, q_pk, q_pv, q_la, q_g; f4 q_d0, q_d1;
#define CS_FETCH(chunk) do { const int s_ = (chunk) * 32 + sl; const v4u z0_ = (v4u){0u, 0u, 0u, 0u}; \
        q_zr = z0_; q_zk = z0_; q_zv = z0_; q_pr = z0_; q_pk = z0_; q_pv = z0_; q_la = z0_; q_g = z0_; q_d0 = (f4){1.f, 1.f, 1.f, 1.f}; q_d1 = q_d0; \
        if (s_ < NSTEP) { const int row_ = s_ < 16 ? TR + s_ : b * SEQ + s_ - 16; const int prow_ = s_ == 0 ? -1 : (s_ <= 16 ? TR + s_ - 1 : row_ - 1); \
            const bf16* z_ = ZR + (size_t)row_ * ZRW + c0; q_zr = *(const v4u*)z_; q_zk = *(const v4u*)(z_ + 1024); q_zv = *(const v4u*)(z_ + 2048); \
            if (prow_ >= 0) { const bf16* zp_ = ZR + (size_t)prow_ * ZRW + c0; q_pr = *(const v4u*)zp_; q_pk = *(const v4u*)(zp_ + 1024); q_pv = *(const v4u*)(zp_ + 2048); } \
            q_d0 = *(const f4*)(LW + (size_t)row_ * 1024 + c0); q_d1 = *(const f4*)(LW + (size_t)row_ * 1024 + c0 + 4); q_la = *(const v4u*)(LA + (size_t)row_ * 1024 + c0); \
            if (s_ >= 16) q_g = *(const v4u*)(LG + (size_t)row_ * 1024 + c0); } } while (0)
#define CS_W16(base, o, val) (*(LAS unsigned short*)(ob_ + (base) + (o)) = (unsigned short)(val))
#define CS_ALPHA_A(bufsel) do { LAS unsigned char* ob_ = lds + ((bufsel) ? CS_OP2 : 0); \
        *(LAS f4*)(lds + CS_DEC + sl * 256 + cgp * 32) = q_d0; *(LAS f4*)(lds + CS_DEC + sl * 256 + cgp * 32 + 16) = q_d1; \
        asm volatile("s_waitcnt lgkmcnt(0)" ::: "memory"); if (lane == 0) __hip_atomic_fetch_add((LAS unsigned*)(lds + CS_FLG), 1u, __ATOMIC_RELAXED, __HIP_MEMORY_SCOPE_WORKGROUP);     \
        float r_[8], k_[8], v_[8], a_[8], pr_[8], pk_[8], pv_[8]; CS_PRM8(0, mu_r) CS_PRM8(1, mu_k) CS_PRM8(2, mu_v) CS_PRM8(3, kkw) CS_PRM8(4, kaw) CS_PRM8(5, rkw) \
        unpk8(q_zr, r_); unpk8(q_zk, k_); unpk8(q_zv, v_); unpk8(q_pr, pr_); unpk8(q_pk, pk_); unpk8(q_pv, pv_); unpk8(q_la, a_); \
        *(LAS v4u*)(lds + CS_GSV + (bufsel) * 4096 + sl * 128 + cgp * 16) = q_g; \
        float kkv_[8], kf_[8], ss_ = 0.f, rk_ = 0.f; \
        _Pragma("unroll") for (int j = 0; j < 8; ++j) { r_[j] = r_[j] + (pr_[j] - r_[j]) * mu_r[j]; const float kk_ = k_[j] + (pk_[j] - k_[j]) * mu_k[j]; v_[j] = v_[j] + (pv_[j] - v_[j]) * mu_v[j]; \
            kkv_[j] = kk_ * kkw[j]; ss_ += kkv_[j] * kkv_[j]; kf_[j] = kk_ * (1.f + (a_[j] - 1.f) * kaw[j]); rk_ += r_[j] * kf_[j] * rkw[j]; } \
        ss_ = red8(ss_); rk_ = red8(rk_); \
        const float inv_ = __builtin_amdgcn_rcpf(fmaxf(__builtin_amdgcn_sqrtf(ss_), 1e-12f)); \
        float kn_[8], bv_[8]; \
        _Pragma("unroll") for (int j = 0; j < 8; ++j) { kn_[j] = kkv_[j] * inv_; bv_[j] = kn_[j] * a_[j]; } \
        const int ro_ = sl * 144 + cgp * 16; \
        *(LAS v4u*)(ob_ + CS_XR + ro_) = (v4u){pk2(r_[0], r_[1]), pk2(r_[2], r_[3]), pk2(r_[4], r_[5]), pk2(r_[6], r_[7])}; \
        *(LAS v4u*)(ob_ + CS_XK + ro_) = (v4u){pk2(kf_[0], kf_[1]), pk2(kf_[2], kf_[3]), pk2(kf_[4], kf_[5]), pk2(kf_[6], kf_[7])}; \
        *(LAS v4u*)(ob_ + CS_XA + ro_) = (v4u){pk2(kn_[0], kn_[1]), pk2(kn_[2], kn_[3]), pk2(kn_[4], kn_[5]), pk2(kn_[6], kn_[7])}; \
        *(LAS v4u*)(ob_ + CS_XB + ro_) = (v4u){pk2(bv_[0], bv_[1]), pk2(bv_[2], bv_[3]), pk2(bv_[4], bv_[5]), pk2(bv_[6], bv_[7])}; \
        { const v4u pv_2 = (v4u){pk2(v_[0], v_[1]), pk2(v_[2], v_[3]), pk2(v_[4], v_[5]), pk2(v_[6], v_[7])}; const int to_ = (8 * cgp) * 80 + sl * 2; \
          _Pragma("unroll") for (int e_ = 0; e_ < 4; ++e_) { CS_W16(CS_TV, to_ + (2 * e_) * 80, pv_2[e_] & 0xffffu); CS_W16(CS_TV, to_ + (2 * e_ + 1) * 80, pv_2[e_] >> 16); } } \
        if (cgp == 0) ((LAS float*)(lds + CS_RKS))[(bufsel) * 32 + sl] = rk_; \
        } while (0)
#define CS_ALPHA_B(bufsel) do { LAS unsigned char* ob_ = lds + ((bufsel) ? CS_OP2 : 0); \
        const int ro_ = sl * 144 + cgp * 16; \
        float xa_[8], xb_[8], xk_[8], xr_[8], wt_[8], wm_[8]; \
        { const f4 w0_ = *(const LAS f4*)(lds + CS_DEC + sl * 256 + cgp * 32), w1_ = *(const LAS f4*)(lds + CS_DEC + sl * 256 + cgp * 32 + 16); \
          const int slm_ = sl > 0 ? sl - 1 : 0; const f4 m0_ = *(const LAS f4*)(lds + CS_DEC + slm_ * 256 + cgp * 32), m1_ = *(const LAS f4*)(lds + CS_DEC + slm_ * 256 + cgp * 32 + 16); \
          wt_[0] = w0_.x; wt_[1] = w0_.y; wt_[2] = w0_.z; wt_[3] = w0_.w; wt_[4] = w1_.x; wt_[5] = w1_.y; wt_[6] = w1_.z; wt_[7] = w1_.w; \
          wm_[0] = m0_.x; wm_[1] = m0_.y; wm_[2] = m0_.z; wm_[3] = m0_.w; wm_[4] = m1_.x; wm_[5] = m1_.y; wm_[6] = m1_.z; wm_[7] = m1_.w; \
          if (sl == 0) { _Pragma("unroll") for (int j = 0; j < 8; ++j) wm_[j] = 1.f; } } \
        unpk8(*(const LAS v4u*)(ob_ + CS_XA + ro_), xa_); unpk8(*(const LAS v4u*)(ob_ + CS_XB + ro_), xb_); unpk8(*(const LAS v4u*)(ob_ + CS_XK + ro_), xk_); unpk8(*(const LAS v4u*)(ob_ + CS_XR + ro_), xr_); \
        _Pragma("unroll") for (int j = 0; j < 8; ++j) { const float W_ = wt_[j], iw_ = __builtin_amdgcn_rcpf(W_); \
            xa_[j] = -xa_[j] * wm_[j]; xb_[j] = xb_[j] * iw_; xk_[j] = xk_[j] * iw_; xr_[j] = xr_[j] * W_; } \
        const v4u pa_ = (v4u){pk2(xa_[0], xa_[1]), pk2(xa_[2], xa_[3]), pk2(xa_[4], xa_[5]), pk2(xa_[6], xa_[7])}, pb_ = (v4u){pk2(xb_[0], xb_[1]), pk2(xb_[2], xb_[3]), pk2(xb_[4], xb_[5]), pk2(xb_[6], xb_[7])}; \
        const v4u pk_2 = (v4u){pk2(xk_[0], xk_[1]), pk2(xk_[2], xk_[3]), pk2(xk_[4], xk_[5]), pk2(xk_[6], xk_[7])}, pr_2 = (v4u){pk2(xr_[0], xr_[1]), pk2(xr_[2], xr_[3]), pk2(xr_[4], xr_[5]), pk2(xr_[6], xr_[7])}; \
        *(LAS v4u*)(ob_ + CS_XA + ro_) = pa_; *(LAS v4u*)(ob_ + CS_XB + ro_) = pb_; *(LAS v4u*)(ob_ + CS_XK + ro_) = pk_2; *(LAS v4u*)(ob_ + CS_XR + ro_) = pr_2; \
        const int to_ = (8 * cgp) * 80 + sl * 2; \
        _Pragma("unroll") for (int e_ = 0; e_ < 4; ++e_) { CS_W16(CS_TB, to_ + (2 * e_) * 80, pb_[e_] & 0xffffu); CS_W16(CS_TB, to_ + (2 * e_ + 1) * 80, pb_[e_] >> 16); \
            CS_W16(CS_TK, to_ + (2 * e_) * 80, pk_2[e_] & 0xffffu); CS_W16(CS_TK, to_ + (2 * e_ + 1) * 80, pk_2[e_] >> 16); } \
        if (sl == 31) { *(LAS f4*)(lds + CS_WT + (bufsel) * 256 + cgp * 32) = (f4){wt_[0], wt_[1], wt_[2], wt_[3]}; *(LAS f4*)(lds + CS_WT + (bufsel) * 256 + cgp * 32 + 16) = (f4){wt_[4], wt_[5], wt_[6], wt_[7]}; } } while (0)
#define CS_POST(chunk) do { const int s_ = (chunk) * 32 + sl; const f4 y0_ = *(const LAS f4*)(lds + CS_YS + sl * 256 + cgp * 32), y1_ = *(const LAS f4*)(lds + CS_YS + sl * 256 + cgp * 32 + 16); \
        float y_[8] = {y0_.x, y0_.y, y0_.z, y0_.w, y1_.x, y1_.y, y1_.z, y1_.w}, g_[8], o_[8], vv_[8]; unpk8(*(const LAS v4u*)(lds + CS_GSV + ((chunk) & 1) * 4096 + sl * 128 + cgp * 16), g_); CS_PRM8(6, gnw) CS_PRM8(7, gnb) \
        { const LAS unsigned char* tv_ = lds + (((chunk) & 1) ? CS_OP2 : 0) + CS_TV + (8 * cgp) * 80 + sl * 2; _Pragma("unroll") for (int j = 0; j < 8; ++j) vv_[j] = bf2f(*(const LAS unsigned short*)(tv_ + j * 80)); } \
        const float rkp_ = ((const LAS float*)(lds + CS_RKS))[((chunk) & 1) * 32 + sl]; \
        float sum_ = 0.f; _Pragma("unroll") for (int j = 0; j < 8; ++j) sum_ += y_[j]; \
        const float mean_ = red8(sum_) * (1.f / 64.f); float m2_ = 0.f; \
        _Pragma("unroll") for (int j = 0; j < 8; ++j) { y_[j] -= mean_; m2_ += y_[j] * y_[j]; } \
        const float rstd_ = __builtin_amdgcn_rsqf(red8(m2_) * (1.f / 64.f) + 64e-5f); \
        _Pragma("unroll") for (int j = 0; j < 8; ++j) o_[j] = (y_[j] * rstd_ * gnw[j] + gnb[j] + rkp_ * vv_[j]) * g_[j]; \
        if (s_ >= 16 && s_ < NSTEP) *(v4u*)(YA + (size_t)(b * SEQ + s_ - 16) * 1024 + c0) = (v4u){pk2(o_[0], o_[1]), pk2(o_[2], o_[3]), pk2(o_[4], o_[5]), pk2(o_[6], o_[7])}; } while (0)
#define CS_KEEP_ROT() do { } while (0)
#define CS_CUMPROD(want) do { while (__hip_atomic_load((LAS unsigned*)(lds + CS_FLG), __ATOMIC_RELAXED, __HIP_MEMORY_SCOPE_WORKGROUP) < (want)) __builtin_amdgcn_s_sleep(1); \
        asm volatile("" ::: "memory"); LAS float* dcol_ = (LAS float*)(lds + CS_DEC) + lane; float d_[32]; \
        _Pragma("unroll") for (int t_ = 0; t_ < 32; ++t_) d_[t_] = dcol_[t_ * 64]; \
        _Pragma("unroll") for (int t_ = 1; t_ < 32; ++t_) d_[t_] *= d_[t_ - 1]; \
        _Pragma("unroll") for (int t_ = 1; t_ < 32; ++t_) dcol_[t_ * 64] = d_[t_]; } while (0)
    if (prep) { CS_FETCH(0); CS_ALPHA_A(0); CS_FETCH(1); }
    SC_BAR();
    if (wid == 1) CS_CUMPROD(4u);
    SC_BAR();
    if (prep) { CS_ALPHA_B(0); CS_KEEP_ROT(); }
    SC_BAR();
    for (int c = 0; c < NCH; ++c) {
        const LAS unsigned char* ob = lds + ((c & 1) ? CS_OP2 : 0);
        if (!prep) {
            const LAS unsigned char* As = ob + (wid < 2 ? CS_XA : CS_XR) + n * 144 + hi * 16; const LAS unsigned char* Bs = ob + ((wid & 1) ? CS_XK : CS_XB) + n * 144 + hi * 16;
            f32x16 g = {};
#pragma unroll
            for (int ks = 0; ks < 4; ++ks) g = mfma32(*(const LAS bf16x8*)(As + ks * 32), *(const LAS bf16x8*)(Bs + ks * 32), g);
            if (wid == 0) {
#pragma unroll
                for (int r = 0; r < 16; ++r) if (n >= crow(r, hi)) g[r] = 0.f;
                for (int i = 0; i < 5; ++i) {
                    LAS unsigned short* lp = (LAS unsigned short*)(lds + CS_LP + i * 2560);
#pragma unroll
                    for (int r = 0; r < 16; ++r) lp[crow(r, hi) * 40 + n] = (unsigned short)(pk2(g[r], 0.f) & 0xffffu);
                    if (i == 4) break;
                    const bf16x8 b0 = __builtin_bit_cast(bf16x8, (v4u){pk2(g[0], g[1]), pk2(g[2], g[3]), pk2(g[4], g[5]), pk2(g[6], g[7])});
                    const bf16x8 b1 = __builtin_bit_cast(bf16x8, (v4u){pk2(g[8], g[9]), pk2(g[10], g[11]), pk2(g[12], g[13]), pk2(g[14], g[15])});
                    asm volatile("s_waitcnt lgkmcnt(0)" ::: "memory");
                    const LAS unsigned char* Ap = lds + CS_LP + i * 2560 + n * 80 + hi * 8;
                    const v2u a00 = *(const LAS v2u*)Ap, a01 = *(const LAS v2u*)(Ap + 16), a10 = *(const LAS v2u*)(Ap + 32), a11 = *(const LAS v2u*)(Ap + 48);
                    asm volatile("s_waitcnt lgkmcnt(0)" ::: "memory");
                    f32x16 g2 = {}; g2 = mfma32(__builtin_bit_cast(bf16x8, (v4u){a00[0], a00[1], a01[0], a01[1]}), b0, g2); g2 = mfma32(__builtin_bit_cast(bf16x8, (v4u){a10[0], a10[1], a11[0], a11[1]}), b1, g2);
                    asm volatile("s_nop 15\n\ts_nop 7" : "+v"(g2)); g = g2;
                }
            } else {
                LAS unsigned short* G = (LAS unsigned short*)(lds + (wid == 1 ? CS_GA : (wid == 2 ? CS_GB : CS_GK)));
#pragma unroll
                for (int r = 0; r < 16; ++r) { const int t = crow(r, hi); const bool keep = wid == 1 ? (n < t) : (n <= t); G[t * 40 + n] = (unsigned short)(pk2(keep ? g[r] : 0.f, 0.f) & 0xffffu); }
            }
            if (wid == 1 && c + 1 < NCH) CS_CUMPROD(4u * (unsigned)(c + 2));
        } else {
            if (c >= 1) CS_POST(c - 1);
            if (c + 1 < NCH) { CS_ALPHA_A((c + 1) & 1); if (c + 2 < NCH) CS_FETCH(c + 2); }
        }
        SC_BAR();
        if (!prep) {
            const int vb = wid & 1;
            const LAS unsigned char* As = ob + (wid < 2 ? CS_XA : CS_XR) + n * 144 + hi * 16; const LAS unsigned char* Bs = lds + CS_SS + (32 * vb + n) * 144 + hi * 16;
            f32x16 acc = {};
#pragma unroll
            for (int ks = 0; ks < 4; ++ks) acc = mfma32(*(const LAS bf16x8*)(As + ks * 32), *(const LAS bf16x8*)(Bs + ks * 32), acc);
            if (wid < 2) {
                const LAS unsigned char* Ga = lds + CS_GA + n * 80 + hi * 16; const LAS unsigned char* Tv = ob + CS_TV + (32 * vb + n) * 80 + hi * 16;
#pragma unroll
                for (int js = 0; js < 2; ++js) acc = mfma32(*(const LAS bf16x8*)(Ga + js * 32), *(const LAS bf16x8*)(Tv + js * 32), acc);
                LAS unsigned char* xt = lds + CS_UT + (32 * vb + n) * 80; asm volatile("s_nop 15\n\ts_nop 7" : "+v"(acc));
#pragma unroll 1
                for (int i = 0; i < 5; ++i) {
                    const LAS unsigned char* Ap = lds + CS_LP + i * 2560 + n * 80 + hi * 8;
                    const v2u a00 = *(const LAS v2u*)Ap, a01 = *(const LAS v2u*)(Ap + 16), a10 = *(const LAS v2u*)(Ap + 32), a11 = *(const LAS v2u*)(Ap + 48);
                    const bf16x8 b0 = __builtin_bit_cast(bf16x8, (v4u){pk2(acc[0], acc[1]), pk2(acc[2], acc[3]), pk2(acc[4], acc[5]), pk2(acc[6], acc[7])});
                    const bf16x8 b1 = __builtin_bit_cast(bf16x8, (v4u){pk2(acc[8], acc[9]), pk2(acc[10], acc[11]), pk2(acc[12], acc[13]), pk2(acc[14], acc[15])});
                    asm volatile("s_waitcnt lgkmcnt(0)" ::: "memory");
                    acc = mfma32(__builtin_bit_cast(bf16x8, (v4u){a00[0], a00[1], a01[0], a01[1]}), b0, acc); acc = mfma32(__builtin_bit_cast(bf16x8, (v4u){a10[0], a10[1], a11[0], a11[1]}), b1, acc);
                    asm volatile("s_nop 15\n\ts_nop 7" : "+v"(acc));
                }
#pragma unroll
                for (int r4 = 0; r4 < 4; ++r4) *(LAS v2u*)(xt + (8 * r4 + 4 * hi) * 2) = (v2u){pk2(acc[4 * r4], acc[4 * r4 + 1]), pk2(acc[4 * r4 + 2], acc[4 * r4 + 3])};
            } else { LAS float* ys = (LAS float*)(lds + CS_YS) + 32 * vb + n; asm volatile("s_nop 15\n\ts_nop 7" : "+v"(acc));
#pragma unroll
                for (int r = 0; r < 16; ++r) ys[crow(r, hi) * 64] = acc[r]; }
        } else if (c + 1 < NCH) { CS_ALPHA_B((c + 1) & 1); CS_KEEP_ROT(); }
        else { CS_KEEP_ROT(); }
        SC_BAR();
        if (!prep) {
            const int vb = wid & 1, kb = wid >> 1;
            const LAS unsigned char* Ut = lds + CS_UT + (32 * vb + n) * 80 + hi * 16; const LAS unsigned char* Tv = ob + CS_TV + (32 * vb + n) * 80 + hi * 16;
            if (wid >= 2) {
                f32x16 acc; { const LAS float* ys0 = (const LAS float*)(lds + CS_YS) + 32 * vb + n;
#pragma unroll
                  for (int r = 0; r < 16; ++r) acc[r] = ys0[crow(r, hi) * 64]; }
                const LAS unsigned char* Gb = lds + CS_GB + n * 80 + hi * 16; const LAS unsigned char* Gk = lds + CS_GK + n * 80 + hi * 16;
#pragma unroll
                for (int js = 0; js < 2; ++js) { acc = mfma32(*(const LAS bf16x8*)(Gb + js * 32), *(const LAS bf16x8*)(Ut + js * 32), acc); acc = mfma32(*(const LAS bf16x8*)(Gk + js * 32), *(const LAS bf16x8*)(Tv + js * 32), acc); }
                LAS float* ys = (LAS float*)(lds + CS_YS) + 32 * vb + n;
#pragma unroll
                for (int r = 0; r < 16; ++r) ys[crow(r, hi) * 64] = acc[r];
            }
            const LAS unsigned char* Tb = ob + CS_TB + (32 * kb + n) * 80 + hi * 16; const LAS unsigned char* Tk = ob + CS_TK + (32 * kb + n) * 80 + hi * 16;
#pragma unroll
            for (int js = 0; js < 2; ++js) { ST = mfma32(*(const LAS bf16x8*)(Tb + js * 32), *(const LAS bf16x8*)(Ut + js * 32), ST); ST = mfma32(*(const LAS bf16x8*)(Tk + js * 32), *(const LAS bf16x8*)(Tv + js * 32), ST); }
            const LAS float* wt = (const LAS float*)(lds + CS_WT + (c & 1) * 256) + 32 * kb + 4 * hi; LAS unsigned char* ss = lds + CS_SS + (32 * vb + n) * 144 + (32 * kb + 4 * hi) * 2;
#pragma unroll
            for (int r4 = 0; r4 < 4; ++r4) { const f4 w = *(const LAS f4*)(wt + 8 * r4);
                ST[4 * r4] *= w.x; ST[4 * r4 + 1] *= w.y; ST[4 * r4 + 2] *= w.z; ST[4 * r4 + 3] *= w.w;
                *(LAS v2u*)(ss + 16 * r4) = (v2u){pk2(ST[4 * r4], ST[4 * r4 + 1]), pk2(ST[4 * r4 + 2], ST[4 * r4 + 3])}; }
        }
        SC_BAR();
    }
    if (prep) CS_POST(NCH - 1);
#undef CS_FETCH
#undef CS_ALPHA_A
#undef CS_ALPHA_B
#undef CS_W16
#undef CS_POST
#undef CS_KEEP_ROT
#undef CS_PRM8
#undef CS_CUMPROD
    __syncthreads();
}

constexpr int AT_KROW = 176, AT_VROW = 144, AT_KBYTES = 64 * AT_KROW, AT_BUF = AT_KBYTES + 64 * AT_VROW;
__device__ __forceinline__ void attn_unit(const Ptrs& P, int bh, int qb, LAS unsigned char* lds, int tid) {
    const int lane = tid & 63, wid = tid >> 6, n = lane & 31, hi = lane >> 5, b = bh >> 4, h = bh & 15;
    bf16* Qb = (bf16*)(P.ws + WS_Q); const bf16* Kb = (const bf16*)(P.ws + WS_K); const bf16* Vb = (const bf16*)(P.ws + WS_V);
    const bf16* KE = (const bf16*)(P.ws + WS_KE) + (size_t)bh * KEROWS * 16;
    const int NTL = 4 * (qb + 1) + 1; const size_t rowb = (size_t)b * SEQ; const int qrow = 256 * qb + 32 * wid + n, qw0 = 256 * qb + 32 * wid;
    bf16x8 qf[5];
    { const bf16* qp = Qb + (rowb + qrow) * 1024 + h * 64 + hi * 8;
#pragma unroll
      for (int d0 = 0; d0 < 4; ++d0) qf[d0] = *(const bf16x8*)(qp + d0 * 16);
      const short one = hi == 0 ? (short)0x3F80 : (short)0; qf[4] = (bf16x8){one, one, one, 0, 0, 0, 0, 0}; }
    const int sj = tid >> 3, sc = tid & 7;
    const int slot = ((sj >> 5) * 32) + (((sj >> 4) & 1) * 16) + (((sj >> 2) & 1) * 8) + (((sj >> 3) & 1) * 4) + (sj & 3);
    const int vgrp = (slot >> 3) ^ sc, vpos = vgrp * 16 + (slot & 7) * 2;
    const int ej = tid >> 1, eh = tid & 1;
    v4u kreg, vreg, ereg = (v4u){0u, 0u, 0u, 0u};
#define AT_LOAD(t) do { const bool val_ = (t) > 0 || sj < 16; const size_t row_ = (t) == 0 ? (size_t)(TR + (sj & 15)) : rowb + 64 * ((t) - 1) + sj; \
        kreg = *(const v4u*)(Kb + row_ * 1024 + h * 64 + sc * 8); vreg = *(const v4u*)(Vb + row_ * 1024 + h * 64 + sc * 8); \
        if (!val_) { kreg = (v4u){0u, 0u, 0u, 0u}; vreg = (v4u){0u, 0u, 0u, 0u}; } \
        if (tid < 128) ereg = *(const v4u*)(KE + (size_t)(64 * (t) + ej) * 16 + eh * 8); } while (0)
#define AT_STORE(bufo) do { LAS unsigned char* kt_ = lds + (bufo); LAS unsigned char* vt_ = kt_ + AT_KBYTES; \
        *(LAS v4u*)(kt_ + sj * AT_KROW + sc * 16) = kreg; if (tid < 128) *(LAS v4u*)(kt_ + ej * AT_KROW + 128 + eh * 16) = ereg; \
        _Pragma("unroll") for (int i_ = 0; i_ < 8; ++i_) { const unsigned w_ = vreg[i_ >> 1]; *(LAS unsigned short*)(vt_ + (8 * sc + i_) * AT_VROW + vpos) = (unsigned short)((i_ & 1) ? (w_ >> 16) : (w_ & 0xffffu)); } } while (0)
    AT_LOAD(0); AT_STORE(0); __syncthreads();
    f32x16 o0 = {}, o1 = {}; float m = -INFINITY, l = 0.f;
    for (int t = 0; t < NTL; ++t) {
        if (t + 1 < NTL) AT_LOAD(t + 1);
        const int bufo = (t & 1) * AT_BUF; const int key0 = 64 * (t - 1);
        const bool skip = t >= 1 && key0 > qw0 + 31;
        if (!skip) {
            const LAS unsigned char* Kt = lds + bufo; const LAS unsigned char* Vt = Kt + AT_KBYTES;
            f32x16 s0 = {}, s1 = {};
#pragma unroll
            for (int d0 = 0; d0 < 5; ++d0) { const int off = d0 < 4 ? d0 * 32 + hi * 16 : 128 + hi * 16;
                const bf16x8 k0 = *(const LAS bf16x8*)(Kt + n * AT_KROW + off), k1 = *(const LAS bf16x8*)(Kt + (32 + n) * AT_KROW + off);
                s0 = __builtin_amdgcn_mfma_f32_32x32x16_bf16(k0, qf[d0], s0, 0, 0, 0); s1 = __builtin_amdgcn_mfma_f32_32x32x16_bf16(k1, qf[d0], s1, 0, 0, 0); }
            if (t >= 1 && key0 + 63 > qw0) {
#pragma unroll
                for (int r = 0; r < 16; ++r) { const int key = key0 + crow(r, hi); if (key > qrow) s0[r] = -INFINITY; if (key + 32 > qrow) s1[r] = -INFINITY; } }
            float mx = fmaxf(s0[0], s1[0]);
#pragma unroll
            for (int r = 1; r < 16; ++r) mx = fmaxf(mx, fmaxf(s0[r], s1[r]));
            mx = fmaxf(mx, __shfl_xor(mx, 32));
            const float mn = fmaxf(m, mx), f = __builtin_amdgcn_exp2f(m - mn); m = mn; l *= f;
#pragma unroll
            for (int r = 0; r < 16; ++r) { o0[r] *= f; o1[r] *= f; }
            float ls = 0.f;
#pragma unroll
            for (int r = 0; r < 16; ++r) { s0[r] = __builtin_amdgcn_exp2f(s0[r] - mn); s1[r] = __builtin_amdgcn_exp2f(s1[r] - mn); ls += s0[r] + s1[r]; }
            l += ls;
            v4u pa[4];
#pragma unroll
            for (int e = 0; e < 4; ++e) { pa[0][e] = pk2(s0[2 * e], s0[2 * e + 1]); pa[1][e] = pk2(s0[8 + 2 * e], s0[8 + 2 * e + 1]); pa[2][e] = pk2(s1[2 * e], s1[2 * e + 1]); pa[3][e] = pk2(s1[8 + 2 * e], s1[8 + 2 * e + 1]); }
#pragma unroll
            for (int sl = 0; sl < 4; ++sl) { const int grp = sl * 2 + hi; const bf16x8 pb = __builtin_bit_cast(bf16x8, pa[sl]);
                const bf16x8 v0 = *(const LAS bf16x8*)(Vt + n * AT_VROW + ((grp ^ ((n >> 3) & 7)) * 16));
                const bf16x8 v1 = *(const LAS bf16x8*)(Vt + (32 + n) * AT_VROW + ((grp ^ (((32 + n) >> 3) & 7)) * 16));
                o0 = __builtin_amdgcn_mfma_f32_32x32x16_bf16(v0, pb, o0, 0, 0, 0); o1 = __builtin_amdgcn_mfma_f32_32x32x16_bf16(v1, pb, o1, 0, 0, 0); }
        }
        if (t + 1 < NTL) AT_STORE(((t + 1) & 1) * AT_BUF);
        __syncthreads();
    }
#undef AT_LOAD
#undef AT_STORE
    l += __shfl_xor(l, 32); const float inv = 1.0f / l;
    bf16* op = Qb + (rowb + qrow) * 1024 + h * 64;
#pragma unroll
    for (int r4 = 0; r4 < 4; ++r4) {
        __hip_atomic_store((unsigned long long*)(op + 8 * r4 + 4 * hi), (unsigned long long)pk2(o0[4 * r4] * inv, o0[4 * r4 + 1] * inv) | ((unsigned long long)pk2(o0[4 * r4 + 2] * inv, o0[4 * r4 + 3] * inv) << 32), __ATOMIC_RELAXED, __HIP_MEMORY_SCOPE_AGENT);
        __hip_atomic_store((unsigned long long*)(op + 32 + 8 * r4 + 4 * hi), (unsigned long long)pk2(o1[4 * r4] * inv, o1[4 * r4 + 1] * inv) | ((unsigned long long)pk2(o1[4 * r4 + 2] * inv, o1[4 * r4 + 3] * inv) << 32), __ATOMIC_RELAXED, __HIP_MEMORY_SCOPE_AGENT); }
}

#define XB_TMO      128
#define XB_XCNT(j)  (256  + 64 * (j))
#define XB_XSUB(j)  (1280 + 64 * (j))
#define XB_XGEN(j)  (2304 + 64 * (j))
#define XB_TOP      3328
#define XB_TOPGEN   3392
#define XCD_BAR_WORDS 3456
#define XB_SPIN_CAP (1u << 18)

__device__ __forceinline__ unsigned xb_ld(unsigned* p)              { return __hip_atomic_load(p, __ATOMIC_RELAXED, __HIP_MEMORY_SCOPE_AGENT); }
__device__ __forceinline__ unsigned xb_add(unsigned* p, unsigned v) { return __hip_atomic_fetch_add(p, v, __ATOMIC_RELAXED, __HIP_MEMORY_SCOPE_AGENT); }
__device__ __forceinline__ unsigned xb_xcc_id() { return (unsigned)__builtin_amdgcn_s_getreg((3 << 11) | 20) & 0xFu; }
#define XB_SPIN(cond, bar) do { unsigned _sp = 0; while (cond) { __builtin_amdgcn_s_sleep(1); \
    if ((++_sp & 255u) == 0u) { if (xb_ld(&(bar)[XB_TMO])) break; if (_sp > XB_SPIN_CAP) { atomicAdd(&(bar)[XB_TMO], 1u); break; } } } } while (0)

struct XcdBarrier {
    unsigned* bar; unsigned x;
    volatile LAS unsigned* st;
};

__device__ __forceinline__ XcdBarrier xcd_barrier_post(unsigned* bar, volatile LAS unsigned* st) {
    XcdBarrier b; b.bar = bar; b.x = xb_xcc_id(); b.st = st;
    if (threadIdx.x == 0) (void)xb_add(&bar[XB_XCNT(b.x)], 1u);
    return b;
}
__device__ __forceinline__ void xcd_barrier_complete(unsigned* bar, unsigned x, unsigned& nloc, unsigned& nx) {
    const unsigned G = gridDim.x * gridDim.y * gridDim.z;
    unsigned sum, cnt, mine, sp = 0u;
    for (;;) {
        sum = 0u; cnt = 0u; mine = 0u;
#pragma unroll
        for (unsigned j = 0; j < 16; ++j) { const unsigned c = xb_ld(&bar[XB_XCNT(j)]); sum += c; cnt += (c > 0u) ? 1u : 0u; mine = (j == x) ? c : mine; }
        if (sum == G) break;
        __builtin_amdgcn_s_sleep(1);
        if ((++sp & 255u) == 0u) { if (xb_ld(&bar[XB_TMO])) break; if (sp > XB_SPIN_CAP) { atomicAdd(&bar[XB_TMO], 1u); break; } }
    }
    nloc = mine > 0u ? mine : 1u; nx = cnt > 0u ? cnt : 1u;
}

__device__ __forceinline__ void xcd_barrier(const XcdBarrier& b) {
    asm volatile("s_waitcnt vmcnt(0)" ::: "memory");
    __syncthreads();
    if (threadIdx.x == 0) {
        unsigned* bar = b.bar;
        __builtin_amdgcn_s_waitcnt(0);
        unsigned nloc = b.st[0], nx = b.st[1];
        if (nloc == 0u) { xcd_barrier_complete(bar, b.x, nloc, nx); b.st[0] = nloc; b.st[1] = nx; }
        const unsigned old = xb_add(&bar[XB_XSUB(b.x)], 1u);
        const unsigned gen = old / nloc;
        if (old + 1u == (gen + 1u) * nloc) {
            __builtin_amdgcn_fence(__ATOMIC_RELEASE, "agent");
            asm volatile("s_waitcnt vmcnt(0)" ::: "memory");
            const unsigned og = xb_add(&bar[XB_TOP], 1u);
            const unsigned tg = og / nx;
            if (og + 1u == (tg + 1u) * nx) xb_add(&bar[XB_TOPGEN], 1u);
            else XB_SPIN(xb_ld(&bar[XB_TOPGEN]) == tg, bar);
            __builtin_amdgcn_fence(__ATOMIC_ACQUIRE, "agent");
            xb_add(&bar[XB_XGEN(b.x)], 1u);
            asm volatile("s_waitcnt vmcnt(0)" ::: "memory");
        } else {
            XB_SPIN(xb_ld(&bar[XB_XGEN(b.x)]) == gen, bar);
            __builtin_amdgcn_fence(__ATOMIC_ACQUIRE, "agent");
            asm volatile("s_waitcnt vmcnt(0)" ::: "memory");
        }
    }
    __syncthreads();
}

struct Args { const float* in[24]; float* out; unsigned char* ws; };
__global__ void __launch_bounds__(NTHR, 2) fwd_megakernel(Args args) {
    extern __shared__ __attribute__((aligned(16))) unsigned char lds_raw[];
    cg::grid_group grid = cg::this_grid();
    LAS unsigned char* lds = (LAS unsigned char*)lds_raw;
    const int tid = threadIdx.x, G = gridDim.x;
    Ptrs P;
    P.x = args.in[0]; P.meta = args.in[1]; P.n1 = args.in[2]; P.w_in = args.in[3]; P.mu = args.in[4]; P.w0 = args.in[5]; P.w2 = args.in[6]; P.a0 = args.in[7]; P.a2 = args.in[8];
    P.g2 = args.in[9]; P.k_k = args.in[10]; P.k_a = args.in[11]; P.r_k = args.in[12]; P.gn_w = args.in[13]; P.gn_b = args.in[14]; P.q_g = args.in[15]; P.k_g = args.in[16];
    P.f_bias = args.in[17]; P.w_a = args.in[18]; P.w_b = args.in[19]; P.w_o = args.in[20]; P.n2 = args.in[21]; P.w_gu = args.in[22]; P.w_dn = args.in[23];
    P.out = args.out; P.ws = args.ws;
    unsigned char* ws = args.ws;
    typedef pg8::bf16_t pb;
    volatile LAS unsigned* bst = (volatile LAS unsigned*)(lds + LDS_BYTES - 64);
    if (tid < 2) bst[tid] = 0u;
    __syncthreads();
    const XcdBarrier xbar = xcd_barrier_post((unsigned*)(ws + WS_CTL) + 1024, bst);
    p0_prologue<false>(P, lds, tid, (int)blockIdx.x, G);
    xcd_barrier(xbar);
    if (G == 0x7fffffff) grid.sync();
    { pg8::Gemm g{(const pb*)(ws + WS_XN), (const pb*)(ws + WS_WIN), TP, N1, DM}; pg8::StaticOrder S; S.init(TP, N1, G, (int)blockIdx.x);
      pg8::Epi1 E{(pb*)(ws + WS_ZR), (pb*)(ws + WS_Q), (pb*)args.out};
      pg8::gemm_phase<pg8::Epi1, pg8::StaticOrder, true, true>(lds, g, S, E); }
    xcd_barrier(xbar);
    p2a_prep(P, tid);
    xcd_barrier(xbar);
#pragma unroll 1
    for (int j = 0; j < 3; ++j) {
      pg8::Gemm g{(const pb*)(ws + WS_U) + (size_t)TP * 128 * j, (const pb*)(ws + WS_WLORA) + 131072 * j, TP, 1024, j == 2 ? 256 : 128}; pg8::StaticOrder S; S.init(TP, 1024, G, (int)((blockIdx.x + 64u * j) % (unsigned)G));
      pg8::EpiLora E{P.w0, P.a0, (float*)(ws + WS_LW), (pb*)(ws + WS_LA), (pb*)(ws + WS_LG), j};
      pg8::gemm_phase<pg8::EpiLora, pg8::StaticOrder, true, true>(lds, g, S, E);
      __syncthreads(); }
    if (G == 256) { if (blockIdx.x >= 192) p2b_cumsum(P, (int)blockIdx.x - 192, lds, tid); }
    else for (int bh = blockIdx.x; bh < 64; bh += G) p2b_cumsum(P, bh, lds, tid);
    xcd_barrier(xbar);
    for (int bh = blockIdx.x; bh < 64; bh += G) p3_scanc(P, bh, lds, tid);
    unsigned* ctr = (unsigned*)(ws + WS_CTL); unsigned* adone = ctr + 8192; unsigned* efail = ctr + 8256;
    { LAS unsigned* slot = (LAS unsigned*)(lds + 2 * AT_BUF); unsigned nprev = 0u;
      for (;;) {
          if (tid == 0) { if (nprev) __hip_atomic_fetch_add(adone, nprev, __ATOMIC_RELAXED, __HIP_MEMORY_SCOPE_AGENT); *slot = atomicAdd(ctr, 1u); }
          __syncthreads();
          const unsigned u = *slot;
          __syncthreads();
          if (u >= 1024u) break;
          attn_unit(P, (int)(u & 63u), 15 - (int)(u >> 6), lds, tid);
          asm volatile("s_waitcnt vmcnt(0)" ::: "memory"); __syncthreads();
          nprev = 1u;
      } }
    if (G <= 64) p0_prologue<true>(P, lds, tid, (int)blockIdx.x, G);
    else if (blockIdx.x >= 64) p0_prologue<true>(P, lds, tid, (int)blockIdx.x - 64, G - 64);
    if (G == 256 && blockIdx.x >= 64) {
        LAS unsigned* okw = (LAS unsigned*)(lds + 2 * AT_BUF);
        __syncthreads();
        if (tid == 0) { unsigned ok = 0u;
            for (int it = 0; it < 4000; ++it) { if (__hip_atomic_load(adone, __ATOMIC_RELAXED, __HIP_MEMORY_SCOPE_AGENT) >= 1024u) { ok = 1u; break; } __builtin_amdgcn_s_sleep(16); }
            if (!ok) __hip_atomic_fetch_add(efail, 1u, __ATOMIC_RELAXED, __HIP_MEMORY_SCOPE_AGENT);
            *okw = ok; }
        __syncthreads();
        const unsigned ok = *okw;
        __syncthreads();
        if (ok) {
            __builtin_amdgcn_fence(__ATOMIC_ACQUIRE, "agent");
            pg8::Gemm g{(const pb*)(ws + WS_Q), (const pb*)(ws + WS_WB), TR, DM, 1024}; pg8::StaticOrder S; S.init(TR, DM, 192, (int)blockIdx.x - 64);
            pg8::EpiB E{(const pb*)args.out, (pb*)(ws + WS_K)};
            pg8::gemm_phase<pg8::EpiB, pg8::StaticOrder, true, true>(lds, g, S, E);
        }
    }
    xcd_barrier(xbar);
    if (G != 256 || __hip_atomic_load(efail, __ATOMIC_RELAXED, __HIP_MEMORY_SCOPE_AGENT) != 0u) {
      pg8::Gemm g{(const pb*)(ws + WS_Q), (const pb*)(ws + WS_WB), TR, DM, 1024}; pg8::StaticOrder S; S.init(TR, DM, G, (int)blockIdx.x);
      pg8::EpiB E{(const pb*)args.out, (pb*)(ws + WS_K)};
      pg8::gemm_phase<pg8::EpiB, pg8::StaticOrder, true, true>(lds, g, S, E);
      xcd_barrier(xbar); }
    { pg8::Gemm g{(const pb*)(ws + WS_YA), (const pb*)(ws + WS_WA), TR, DM, 1024}; pg8::StaticOrder S; S.init(TR, DM, G, (int)blockIdx.x);
      pg8::EpiA E{(const pb*)args.out, (const pb*)(ws + WS_K), (pb*)(ws + WS_MG)};
      pg8::gemm_phase<pg8::EpiA, pg8::StaticOrder, true, true>(lds, g, S, E); }
    xcd_barrier(xbar);
    { pg8::Gemm g{(const pb*)(ws + WS_MG), (const pb*)(ws + WS_WO), TR, DM, DM}; pg8::StaticOrder S; S.init(TR, DM, G, (int)blockIdx.x);
      pg8::EpiO E{P.x, P.n2, args.out, (pb*)(ws + WS_XN2), (float*)(ws + WS_CTL + CTL_SSQ)};
      pg8::gemm_phase<pg8::EpiO, pg8::StaticOrder, true, true>(lds, g, S, E); }
    xcd_barrier(xbar);
    { pg8::Gemm g{(const pb*)(ws + WS_XN2), (const pb*)(ws + WS_WGU), TR, NGU, DM}; pg8::StaticOrder S; S.init(TR, NGU, G, (int)blockIdx.x);
      pg8::EpiGU E{(const float*)(ws + WS_CTL + CTL_SSQ), (pb*)(ws + WS_ACT)};
      pg8::gemm_phase<pg8::EpiGU, pg8::StaticOrder, true, true>(lds, g, S, E); }
    xcd_barrier(xbar);
    { pg8::Gemm g{(const pb*)(ws + WS_ACT), (const pb*)(ws + WS_WDN), TR, DM, DFF}; pg8::StaticOrder S; S.init(TR, DM, G, (int)blockIdx.x);
      pg8::EpiDN E{args.out};
      pg8::gemm_phase<pg8::EpiDN, pg8::StaticOrder, true, true>(lds, g, S, E); }
}

extern "C" void kernel_launch(void* const* d_in, const int* in_sizes, int n_in, void* d_out, int out_size, void* d_ws, size_t ws_size, hipStream_t stream) {
    static int grid = 0;
    if (grid == 0) {
        if (n_in != 24 || out_size != TR * DM || ws_size < WS_END) { fprintf(stderr, "kernel_launch: unexpected shapes (n_in %d, out %d, ws %zu < %zu)\n", n_in, out_size, ws_size, (size_t)WS_END); grid = -1; return; }
        int dev = 0, cus = 0, per_cu = 0;
        hipGetDevice(&dev); hipDeviceGetAttribute(&cus, hipDeviceAttributeMultiprocessorCount, dev);
        if (hipFuncSetAttribute((const void*)fwd_megakernel, hipFuncAttributeMaxDynamicSharedMemorySize, LDS_BYTES) != hipSuccess) { fprintf(stderr, "kernel_launch: hipFuncSetAttribute failed\n"); grid = -1; return; }
        if (hipOccupancyMaxActiveBlocksPerMultiprocessor(&per_cu, (const void*)fwd_megakernel, NTHR, LDS_BYTES) != hipSuccess || per_cu < 1) { fprintf(stderr, "kernel_launch: occupancy query says %d\n", per_cu); per_cu = 1; }
        (void)hipGetLastError();
        grid = cus;
    }
    if (grid < 0) return;
    (void)hipMemsetAsync((char*)d_ws + WS_CTL, 0, CTL_ZERO_BYTES, stream);
    Args a{};
    for (int i = 0; i < 24; ++i) a.in[i] = (const float*)d_in[i];
    a.out = (float*)d_out; a.ws = (unsigned char*)d_ws;
    void* kargs[] = {&a};
    hipError_t e = hipLaunchCooperativeKernel((const void*)fwd_megakernel, dim3(grid), dim3(NTHR), kargs, LDS_BYTES, stream);
    if (e != hipSuccess) fprintf(stderr, "kernel_launch: cooperative launch failed: %s (grid %d)\n", hipGetErrorString(e), grid);
}
```

```cpp
#include <hip/hip_runtime.h>
#include <hip/hip_cooperative_groups.h>
#include <cstdio>
#include <cstdint>
namespace cg = cooperative_groups;
namespace pg8 {
#define PG8_LAS __attribute__((address_space(3)))
typedef unsigned short bf16_t;
typedef short bf16x8 __attribute__((ext_vector_type(8)));
typedef float f32x4 __attribute__((ext_vector_type(4)));
typedef unsigned u32x4 __attribute__((ext_vector_type(4)));
constexpr int BM = 256, BK = 64, HALF = 128, HTB = HALF * BK * 2  , STAGE_BYTES = 8 * HTB, NXCD = 8, WGM = 8;

__host__ __device__ __forceinline__ int lds_byte(int r, int c) { const int st = (r >> 4) * 2 + (c >> 5), rr = r & 15, cc = c & 31, ob = rr * 64 + cc * 2; return st * 1024 + (ob ^ (((ob >> 9) & 1) << 5)); }
__host__ __device__ __forceinline__ void stage_rc(int b, int& R, int& C) { const int st = b / 1024, sb = b % 1024, swz = sb ^ (((sb >> 9) & 1) << 5); R = (st >> 1) * 16 + swz / 64; C = (st & 1) * 32 + (swz % 64) / 2; }
__host__ __device__ __forceinline__ int perm32(int rho) { const int n = rho >> 4, i = rho & 15; return 8 * (i >> 2) + 4 * n + (i & 3); }

struct Unit { int pm, pn; };
struct Gemm { const bf16_t* A; const bf16_t* Bt; int M, N, K; };

struct StaticOrder {
    int nM, nN, nwg, G, c;
    __host__ __device__ void init(int M, int N, int G_, int c_) { nM = M / BM; nN = N / BM; nwg = nM * nN; G = G_; c = c_; }
    __host__ __device__ bool next(int i, Unit& u) const {
        const long L = (long)i * G + c; if (L >= nwg) return false;
        int wgid = (int)L; { const int q = nwg / NXCD, r = nwg % NXCD, xcd = wgid % NXCD, off = wgid / NXCD; wgid = (xcd < r ? xcd * (q + 1) : r * (q + 1) + (xcd - r) * q) + off; }
        const int nig = WGM * nN, gid = wgid / nig, fm = gid * WGM, gsz = (nM - fm) < WGM ? (nM - fm) : WGM;
        u.pm = fm + ((wgid % nig) % gsz); u.pn = (wgid % nig) / gsz; return true;
    }
    __device__ __forceinline__ void a_ready(const Unit&) const {}
    __device__ __forceinline__ void done(const Unit&) const {}
};

__device__ __forceinline__ unsigned cvt_pk_bf16(float lo, float hi) { unsigned r; asm volatile("v_cvt_pk_bf16_f32 %0, %1, %2" : "=v"(r) : "v"(lo), "v"(hi)); return r; }

template <class Epi, class Sched, bool ALIGN_EPI = false, bool SP2 = false>
__device__ __forceinline__ void gemm_phase(PG8_LAS unsigned char* lds, const Gemm g, const Sched& S, const Epi& E) {
    int tid_ = threadIdx.x; asm volatile("" : "+v"(tid_));
    const int tid = tid_, wid = __builtin_amdgcn_readfirstlane(tid >> 6), lane = tid & 63, wr = wid >> 2, wc = wid & 3, fr = lane & 15, fq = lane >> 4;
    const int K = g.K, nt = K / BK;
    unsigned voffA[2], voffB[2];
#pragma unroll
    for (int i = 0; i < 2; ++i) { int R, C; stage_rc(tid * 16 + i * 8192, R, C); const int Rb = Epi::PERM ? ((R & ~31) + perm32(R & 31)) : R;
        voffA[i] = (unsigned)(R * K + C) * 2u; voffB[i] = (unsigned)(Rb * K + C) * 2u; }
    const size_t kstep = (size_t)(BK * 2);
    const size_t hstep = (size_t)HALF * K * 2;
    const size_t tstep = 2 * hstep;
    const unsigned ldsw = (unsigned)wid * 1024u;
    const int aoff = lds_byte(wr * 64 + fr, fq * 8), boff = lds_byte(wc * 32 + fr, fq * 8);
#define PG8_SA(b, h) (((b) * 2 + (h)) * HTB)
#define PG8_SB(b, h) ((4 + (b) * 2 + (h)) * HTB)
#define PG8_STAGE(bufoff, gbase, voff) do { _Pragma("unroll") for (int _i = 0; _i < 2; ++_i) \
        __builtin_amdgcn_global_load_lds((const unsigned*)((const char*)(gbase) + (voff)[_i]), (PG8_LAS unsigned*)(lds + (bufoff) + ldsw + _i * 8192), 16, 0, 0); } while (0)
#define PG8_LDA(dst, b, h) do { _Pragma("unroll") for (int m = 0; m < 4; ++m) _Pragma("unroll") for (int k = 0; k < 2; ++k) dst[m][k] = *(const PG8_LAS bf16x8*)(lds + PG8_SA(b, h) + aoff + m * 2048 + k * 1024); } while (0)
#define PG8_LDB(dst, b, h) do { _Pragma("unroll") for (int n = 0; n < 2; ++n) _Pragma("unroll") for (int k = 0; k < 2; ++k) dst[n][k] = *(const PG8_LAS bf16x8*)(lds + PG8_SB(b, h) + boff + n * 2048 + k * 1024); } while (0)
#define PG8_MMA(ai, bj, At, Bt) do { __builtin_amdgcn_s_setprio(1); _Pragma("unroll") for (int m = 0; m < 4; ++m) _Pragma("unroll") for (int n = 0; n < 2; ++n) _Pragma("unroll") for (int k = 0; k < 2; ++k) \
        acc[ai][bj][m][n] = __builtin_amdgcn_mfma_f32_16x16x32_bf16(Bt[n][k], At[m][k], acc[ai][bj][m][n], 0, 0, 0); __builtin_amdgcn_s_setprio(0); } while (0)
#define PG8_WAIT_V(n) asm volatile("s_waitcnt vmcnt(" #n ")" ::: "memory")
#define PG8_WAIT_L(n) asm volatile("s_waitcnt lgkmcnt(" #n ")" ::: "memory")
#define PG8_BAR __builtin_amdgcn_s_barrier()
#define PG8_SCHED __builtin_amdgcn_sched_barrier(0)
    Unit cur, nxt; int ui = 0;
    if (!S.next(0, cur)) return;
    f32x4 acc[2][2][4][2];
#pragma unroll
    for (int a = 0; a < 2; ++a)
#pragma unroll
        for (int b = 0; b < 2; ++b)
#pragma unroll
            for (int m = 0; m < 4; ++m)
#pragma unroll
                for (int n = 0; n < 2; ++n) acc[a][b][m][n] = (f32x4){0.f, 0.f, 0.f, 0.f};
    bf16x8 At[4][2], B0[2][2], B1[2][2];
    const char* cA = (const char*)g.A + (size_t)cur.pm * tstep; const char* cB = (const char*)g.Bt + (size_t)cur.pn * tstep;
    S.a_ready(cur);
    if constexpr (SP2) {
        PG8_STAGE(PG8_SB(0, 0), cB, voffB); PG8_STAGE(PG8_SB(0, 1), cB + hstep, voffB); PG8_STAGE(PG8_SA(0, 0), cA, voffA); PG8_STAGE(PG8_SA(0, 1), cA + hstep, voffA);
        if (wr == 1) PG8_BAR;
        PG8_WAIT_V(2); PG8_BAR;
        PG8_STAGE(PG8_SB(1, 0), cB + kstep, voffB); PG8_STAGE(PG8_SA(1, 0), cA + kstep, voffA); PG8_STAGE(PG8_SB(1, 1), cB + hstep + kstep, voffB);
        PG8_WAIT_V(6); PG8_BAR;
    } else {
        PG8_STAGE(PG8_SB(0, 0), cB, voffB); PG8_STAGE(PG8_SA(0, 0), cA, voffA); PG8_STAGE(PG8_SB(0, 1), cB + hstep, voffB); PG8_STAGE(PG8_SA(0, 1), cA + hstep, voffA);
        if (wr == 1) PG8_BAR;
        PG8_WAIT_V(4); PG8_BAR;
        PG8_STAGE(PG8_SB(1, 0), cB + kstep, voffB); PG8_STAGE(PG8_SA(1, 0), cA + kstep, voffA); PG8_STAGE(PG8_SB(1, 1), cB + hstep + kstep, voffB);
        PG8_WAIT_V(6); PG8_BAR;
    }
    for (;;) {
        const bool has_next = S.next(ui + 1, nxt);
        const char* nA = has_next ? (const char*)g.A + (size_t)nxt.pm * tstep : cA; const char* nB = has_next ? (const char*)g.Bt + (size_t)nxt.pn * tstep : cB;
        for (int t = 0; t < nt; t += 2) {
            const bool last = (t == nt - 2);
            const char* a1 = cA + (size_t)(t + 1) * kstep;
            const char* a2 = last ? nA : cA + (size_t)(t + 2) * kstep; const char* b2 = last ? nB : cB + (size_t)(t + 2) * kstep;
            const char* a3 = a2 + kstep; const char* b3 = b2 + kstep;
            if (last && has_next) S.a_ready(nxt);
            if constexpr (SP2) {
            PG8_LDB(B0, 0, 0); PG8_LDB(B1, 0, 1); PG8_SCHED; PG8_LDA(At, 0, 0); PG8_STAGE(PG8_SA(1, 1), a1 + hstep, voffA);
            PG8_WAIT_V(8); PG8_WAIT_L(0); PG8_BAR; PG8_MMA(0, 0, At, B0); PG8_MMA(0, 1, At, B1); PG8_BAR; PG8_SCHED;
            PG8_LDA(At, 0, 1); PG8_STAGE(PG8_SB(0, 0), b2, voffB); PG8_STAGE(PG8_SB(0, 1), b2 + hstep, voffB); PG8_STAGE(PG8_SA(0, 0), a2, voffA);
            PG8_WAIT_V(8); PG8_WAIT_L(0); PG8_BAR; PG8_MMA(1, 0, At, B0); PG8_MMA(1, 1, At, B1); PG8_BAR; PG8_SCHED;
            PG8_LDB(B0, 1, 0); PG8_LDB(B1, 1, 1); PG8_SCHED; PG8_LDA(At, 1, 0); PG8_STAGE(PG8_SA(0, 1), a2 + hstep, voffA);
            PG8_WAIT_V(8); PG8_WAIT_L(0); PG8_BAR; PG8_MMA(0, 0, At, B0); PG8_MMA(0, 1, At, B1); PG8_BAR; PG8_SCHED;
            PG8_LDA(At, 1, 1); PG8_STAGE(PG8_SB(1, 0), b3, voffB); PG8_STAGE(PG8_SB(1, 1), b3 + hstep, voffB); PG8_STAGE(PG8_SA(1, 0), a3, voffA);
            PG8_WAIT_V(8); PG8_WAIT_L(0); PG8_BAR; PG8_MMA(1, 0, At, B0); PG8_MMA(1, 1, At, B1); PG8_BAR; PG8_SCHED;
            } else {
            PG8_LDB(B0, 0, 0); PG8_SCHED; PG8_LDA(At, 0, 0); PG8_STAGE(PG8_SA(1, 1), a1 + hstep, voffA);
            PG8_WAIT_L(8); PG8_BAR; PG8_WAIT_L(0); PG8_MMA(0, 0, At, B0); PG8_BAR; PG8_SCHED;
            PG8_LDB(B1, 0, 1); PG8_STAGE(PG8_SB(0, 0), b2, voffB);
            PG8_BAR; PG8_WAIT_L(0); PG8_MMA(0, 1, At, B1); PG8_BAR;
            PG8_LDA(At, 0, 1); PG8_STAGE(PG8_SA(0, 0), a2, voffA);
            PG8_BAR; PG8_WAIT_L(0); PG8_MMA(1, 0, At, B0); PG8_BAR; PG8_SCHED;
            PG8_STAGE(PG8_SB(0, 1), b2 + hstep, voffB);
            PG8_WAIT_V(6); PG8_BAR; PG8_MMA(1, 1, At, B1); PG8_BAR;
            PG8_LDB(B0, 1, 0); PG8_SCHED; PG8_LDA(At, 1, 0); PG8_STAGE(PG8_SA(0, 1), a2 + hstep, voffA);
            PG8_WAIT_L(8); PG8_BAR; PG8_WAIT_L(0); PG8_MMA(0, 0, At, B0); PG8_BAR; PG8_SCHED;
            PG8_LDB(B1, 1, 1); PG8_STAGE(PG8_SB(1, 0), b3, voffB);
            PG8_BAR; PG8_WAIT_L(0); PG8_MMA(0, 1, At, B1); PG8_BAR;
            PG8_LDA(At, 1, 1); PG8_STAGE(PG8_SA(1, 0), a3, voffA);
            PG8_BAR; PG8_WAIT_L(0); PG8_MMA(1, 0, At, B0); PG8_BAR; PG8_SCHED;
            PG8_STAGE(PG8_SB(1, 1), b3 + hstep, voffB);
            PG8_WAIT_V(6); PG8_BAR; PG8_MMA(1, 1, At, B1); PG8_BAR;
            }
        }
        if constexpr (ALIGN_EPI) { if (wr == 0) PG8_BAR; }
        if constexpr (!Epi::AFTER_DRAIN) { E(acc, cur, wr, wc, fr, fq); S.done(cur); }
        if (!has_next) break;
#pragma unroll
        for (int a = 0; a < 2; ++a)
#pragma unroll
            for (int b = 0; b < 2; ++b)
#pragma unroll
                for (int m = 0; m < 4; ++m)
#pragma unroll
                    for (int n = 0; n < 2; ++n) acc[a][b][m][n] = (f32x4){0.f, 0.f, 0.f, 0.f};
        cur = nxt; cA = nA; cB = nB; ++ui;
        if constexpr (ALIGN_EPI) { if (wr == 1) PG8_BAR; }
    }
    PG8_WAIT_V(0);
    if constexpr (!ALIGN_EPI) { if (wr == 0) PG8_BAR; }
    PG8_BAR;
    if constexpr (Epi::AFTER_DRAIN) { E.fused(acc, cur, wr, wc, fr, fq, lds, wid, lane); S.done(cur); }
#undef PG8_SA
#undef PG8_SB
#undef PG8_STAGE
#undef PG8_LDA
#undef PG8_LDB
#undef PG8_MMA
#undef PG8_WAIT_V
#undef PG8_WAIT_L
#undef PG8_BAR
#undef PG8_SCHED
}
}

#define GAS __attribute__((address_space(1)))
#define LAS __attribute__((address_space(3)))
typedef unsigned short bf16;
typedef unsigned v4u __attribute__((ext_vector_type(4)));
typedef unsigned v2u __attribute__((ext_vector_type(2)));
typedef float f4 __attribute__((ext_vector_type(4)));
typedef float f2 __attribute__((ext_vector_type(2)));
typedef short bf16x8 __attribute__((ext_vector_type(8)));
typedef float f32x16 __attribute__((ext_vector_type(16)));
#define LDS_WAIT() asm volatile("s_waitcnt lgkmcnt(0)" ::: "memory")
__device__ __forceinline__ unsigned f2bf(float f) { unsigned u = __builtin_bit_cast(unsigned, f); return (u + 0x7fffu + ((u >> 16) & 1u)) >> 16; }
__device__ __forceinline__ unsigned pk2(float lo, float hi) { unsigned r; asm("v_cvt_pk_bf16_f32 %0, %1, %2" : "=v"(r) : "v"(lo), "v"(hi)); return r; }
__device__ __forceinline__ float bf2f(unsigned h) { return __uint_as_float(h << 16); }
__device__ __forceinline__ float bflo(unsigned w) { return __uint_as_float(w << 16); }
__device__ __forceinline__ float bfhi(unsigned w) { return __uint_as_float(w & 0xffff0000u); }
__device__ __forceinline__ float sigmoidf_(float x) { return __builtin_amdgcn_rcpf(1.f + __builtin_amdgcn_exp2f(-1.4426950408889634f * x)); }
__device__ __forceinline__ float wave_sum(float v) {
#pragma unroll
    for (int o = 1; o < 64; o <<= 1) v += __shfl_xor(v, o);
    return v;
}

constexpr int NWAVES = 8, NTHR = 512;
constexpr int DM = 2048, TR = 16384, TV = 16400, TP = 16640, SEQ = 4096, NBATCH = 4, NH = 16;
constexpr int N1 = 10752, ZRW = 3584, NLORA = 3072, KLORA = 512, DFF = 5632, NGU = 11264, NIN = 10704;
constexpr int KEROWS = 4160;
constexpr float C2 = 0.125f * 1.4426950408889634f;
constexpr float LOG2E = 1.4426950408889634f;
constexpr size_t MiB = (size_t)1 << 20;
constexpr size_t WS_CTL = 0, CTL_ZERO_BYTES = 192 * 1024, CTL_SSQ = 65536;
constexpr size_t WS_WIN = 1 * MiB, WS_WLORA = 43 * MiB, WS_WA = 46 * MiB, WS_WB = 50 * MiB, WS_WO = 54 * MiB, WS_WGU = 62 * MiB, WS_WDN = 106 * MiB;
constexpr size_t WS_XN = 128 * MiB, WS_U = 128 * MiB, WS_YA = 128 * MiB, WS_LA = 160 * MiB;
constexpr size_t WS_ZR = 193 * MiB, WS_MG = 193 * MiB, WS_XN2 = 257 * MiB;
constexpr size_t WS_Q = 307 * MiB, QKV_STRIDE_B = (size_t)TP * 1024 * 2, WS_K = WS_Q + QKV_STRIDE_B, WS_V = WS_K + QKV_STRIDE_B;
constexpr size_t WS_LW = WS_V + QKV_STRIDE_B;
constexpr size_t WS_LG = WS_LW + (size_t)TP * 1024 * 4;
constexpr size_t WS_LOGF = 502 * MiB;
constexpr size_t WS_KE = WS_LOGF + 5 * MiB / 4;
constexpr size_t WS_T1 = WS_K;
constexpr size_t WS_ACT = 321 * MiB;
constexpr size_t WS_END = WS_KE + (size_t)64 * KEROWS * 32;
static_assert(WS_END <= 512 * MiB && WS_LG + (size_t)TP * 1024 * 2 <= WS_LOGF && WS_T1 + (size_t)TR * 2048 * 4 <= WS_LOGF && WS_ACT + (size_t)TR * DFF * 2 <= WS_LOGF && WS_XN2 + (size_t)TR * 2048 * 2 <= WS_ACT, "ws map");
constexpr int LDS_BYTES = 147456;

namespace pg8 {
#define EPI_PACK8(v0, v1) ((u32x4){cvt_pk_bf16((v0)[0], (v0)[1]), cvt_pk_bf16((v0)[2], (v0)[3]), cvt_pk_bf16((v1)[0], (v1)[1]), cvt_pk_bf16((v1)[2], (v1)[3])})
__device__ __forceinline__ float sigm(float x) { return __builtin_amdgcn_rcpf(1.f + __builtin_amdgcn_exp2f(-1.4426950408889634f * x)); }
struct Epi1 { static constexpr bool PERM = true, AFTER_DRAIN = false;
    bf16_t* ZR; bf16_t* Q; bf16_t* G;
    __device__ __forceinline__ void operator()(const f32x4 (&acc)[2][2][4][2], const Unit& u, int wr, int wc, int fr, int fq) const {
        const int pn = u.pn; bf16_t* base; int ldc, colt; bool sig = false;
        if (pn < 14) { base = ZR; ldc = 3584; colt = pn * 256; }
        else if (pn < 26) { const int t = (pn - 14) >> 2; base = Q + (size_t)t * ((size_t)16640 * 1024); ldc = 1024; colt = ((pn - 14) & 3) * 256; }
        else { if (u.pm >= 64) return; base = G; ldc = 4096; colt = (pn - 26) * 256; sig = true; }
        const int row0 = u.pm * BM + wr * 64 + fr, col0 = colt + wc * 32 + 8 * fq;
#pragma unroll
        for (int ai = 0; ai < 2; ++ai)
#pragma unroll
            for (int m = 0; m < 4; ++m) { bf16_t* rowp = base + (size_t)(row0 + ai * HALF + m * 16) * ldc + col0;
#pragma unroll
                for (int bj = 0; bj < 2; ++bj) { f32x4 v0 = acc[ai][bj][m][0], v1 = acc[ai][bj][m][1];
                    if (sig) {
#pragma unroll
                        for (int e = 0; e < 4; ++e) { v0[e] = sigm(v0[e]); v1[e] = sigm(v1[e]); } }
                    *(u32x4*)(rowp + bj * HALF) = EPI_PACK8(v0, v1); } }
    }
};
struct EpiLora { static constexpr bool PERM = true, AFTER_DRAIN = false;
    const float* w0; const float* a0; float* LW; bf16_t* LA; bf16_t* LG; int mode;
    __device__ __forceinline__ void operator()(const f32x4 (&acc)[2][2][4][2], const Unit& u, int wr, int wc, int fr, int fq) const {
        const int colt = u.pn * 256;
        const int row0 = u.pm * BM + wr * 64 + fr, col0 = colt + wc * 32 + 8 * fq;
        f32x4 bv[2][2];
#pragma unroll
        for (int bj = 0; bj < 2; ++bj)
#pragma unroll
            for (int n = 0; n < 2; ++n) bv[bj][n] = mode == 0 ? *(const f32x4*)(w0 + col0 + bj * HALF + 4 * n) : (mode == 1 ? *(const f32x4*)(a0 + col0 + bj * HALF + 4 * n) : (f32x4){0.f, 0.f, 0.f, 0.f});
#pragma unroll
        for (int ai = 0; ai < 2; ++ai)
#pragma unroll
            for (int m = 0; m < 4; ++m) { const size_t ro = (size_t)(row0 + ai * HALF + m * 16) * 1024 + col0;
#pragma unroll
                for (int bj = 0; bj < 2; ++bj) { f32x4 v0 = acc[ai][bj][m][0] + bv[bj][0], v1 = acc[ai][bj][m][1] + bv[bj][1];
                    if (mode == 0) {
#pragma unroll
                        for (int e = 0; e < 4; ++e) { v0[e] = __builtin_amdgcn_exp2f(-0.60653066f * 1.4426950408889634f * sigm(v0[e])); v1[e] = __builtin_amdgcn_exp2f(-0.60653066f * 1.4426950408889634f * sigm(v1[e])); }
                        *(f32x4*)(LW + ro + bj * HALF) = v0; *(f32x4*)(LW + ro + bj * HALF + 4) = v1;
                    } else if (mode == 1) {
#pragma unroll
                        for (int e = 0; e < 4; ++e) { v0[e] = sigm(v0[e]); v1[e] = sigm(v1[e]); }
                        *(u32x4*)(LA + ro + bj * HALF) = EPI_PACK8(v0, v1);
                    } else { *(u32x4*)(LG + ro + bj * HALF) = EPI_PACK8(v0, v1); } } }
    }
};
__device__ __forceinline__ void unpack8(const u32x4 w, float (&g)[8]) {
#pragma unroll
    for (int e = 0; e < 4; ++e) { g[2 * e] = __uint_as_float(w[e] << 16); g[2 * e + 1] = __uint_as_float(w[e] & 0xffff0000u); }
}
struct EpiB { static constexpr bool PERM = true, AFTER_DRAIN = false;
    const bf16_t* G; bf16_t* T1;
    __device__ __forceinline__ void operator()(const f32x4 (&acc)[2][2][4][2], const Unit& u, int wr, int wc, int fr, int fq) const {
        const int row0 = u.pm * BM + wr * 64 + fr, col0 = u.pn * BM + wc * 32 + 8 * fq;
#pragma unroll
        for (int ai = 0; ai < 2; ++ai)
#pragma unroll
            for (int m = 0; m < 4; ++m) { const size_t r = (size_t)(row0 + ai * HALF + m * 16);
#pragma unroll
                for (int bj = 0; bj < 2; ++bj) { const int c = col0 + bj * HALF; float g[8]; unpack8(*(const u32x4*)(G + r * 4096 + 2048 + c), g);
                    f32x4 v0 = acc[ai][bj][m][0], v1 = acc[ai][bj][m][1];
#pragma unroll
                    for (int e = 0; e < 4; ++e) { v0[e] *= g[e]; v1[e] *= g[4 + e]; }
                    *(u32x4*)(T1 + r * 2048 + c) = EPI_PACK8(v0, v1); } }
    }
};
struct EpiA { static constexpr bool PERM = true, AFTER_DRAIN = false;
    const bf16_t* G; const bf16_t* T1; bf16_t* MG;
    __device__ __forceinline__ void operator()(const f32x4 (&acc)[2][2][4][2], const Unit& u, int wr, int wc, int fr, int fq) const {
        const int row0 = u.pm * BM + wr * 64 + fr, col0 = u.pn * BM + wc * 32 + 8 * fq;
#pragma unroll
        for (int ai = 0; ai < 2; ++ai)
#pragma unroll
            for (int m = 0; m < 4; ++m) { const size_t r = (size_t)(row0 + ai * HALF + m * 16);
#pragma unroll
                for (int bj = 0; bj < 2; ++bj) { const int c = col0 + bj * HALF; float g[8], t[8]; unpack8(*(const u32x4*)(G + r * 4096 + c), g); unpack8(*(const u32x4*)(T1 + r * 2048 + c), t);
                    f32x4 v0 = acc[ai][bj][m][0], v1 = acc[ai][bj][m][1];
#pragma unroll
                    for (int e = 0; e < 4; ++e) { v0[e] = t[e] + v0[e] * g[e]; v1[e] = t[4 + e] + v1[e] * g[4 + e]; }
                    *(u32x4*)(MG + r * 2048 + c) = EPI_PACK8(v0, v1); } }
    }
};
struct EpiO { static constexpr bool PERM = true, AFTER_DRAIN = false;
    const float* x; const float* n2; float* H1; bf16_t* XN2; float* ssq;
    __device__ __forceinline__ void operator()(const f32x4 (&acc)[2][2][4][2], const Unit& u, int wr, int wc, int fr, int fq) const {
        const int row0 = u.pm * BM + wr * 64 + fr, col0 = u.pn * BM + wc * 32 + 8 * fq;
        f32x4 nv[2][2];
#pragma unroll
        for (int bj = 0; bj < 2; ++bj)
#pragma unroll
            for (int n = 0; n < 2; ++n) nv[bj][n] = *(const f32x4*)(n2 + col0 + bj * HALF + 4 * n);
#pragma unroll
        for (int ai = 0; ai < 2; ++ai)
#pragma unroll
            for (int m = 0; m < 4; ++m) { const size_t r = (size_t)(row0 + ai * HALF + m * 16); float sq = 0.f;
#pragma unroll
                for (int bj = 0; bj < 2; ++bj) { const int c = col0 + bj * HALF;
                    const f32x4 h0 = acc[ai][bj][m][0] + *(const f32x4*)(x + r * 2048 + c), h1 = acc[ai][bj][m][1] + *(const f32x4*)(x + r * 2048 + c + 4);
                    *(f32x4*)(H1 + r * 2048 + c) = h0; *(f32x4*)(H1 + r * 2048 + c + 4) = h1;
                    sq += (h0[0] * h0[0] + h0[1] * h0[1]) + (h0[2] * h0[2] + h0[3] * h0[3]) + (h1[0] * h1[0] + h1[1] * h1[1]) + (h1[2] * h1[2] + h1[3] * h1[3]);
                    const f32x4 a0 = h0 * nv[bj][0], a1 = h1 * nv[bj][1];
                    *(u32x4*)(XN2 + r * 2048 + c) = EPI_PACK8(a0, a1); }
                sq += __shfl_xor(sq, 16); sq += __shfl_xor(sq, 32);
                if (fq == 0) atomicAdd(ssq + r, sq); }
    }
};
struct EpiGU { static constexpr bool PERM = true, AFTER_DRAIN = false;
    const float* ssq; bf16_t* ACT;
    __device__ __forceinline__ void operator()(const f32x4 (&acc)[2][2][4][2], const Unit& u, int wr, int wc, int fr, int fq) const {
        const int row0 = u.pm * BM + wr * 64 + fr, col0 = u.pn * HALF + wc * 32 + 8 * fq;
#pragma unroll
        for (int ai = 0; ai < 2; ++ai)
#pragma unroll
            for (int m = 0; m < 4; ++m) { const size_t r = (size_t)(row0 + ai * HALF + m * 16);
                const float rstd = 1.0f / sqrtf(ssq[r] * (1.0f / 2048.0f) + 1e-6f);
                f32x4 o0, o1;
#pragma unroll
                for (int e = 0; e < 4; ++e) { const float g0 = acc[ai][0][m][0][e] * rstd, u0 = acc[ai][1][m][0][e] * rstd, g1 = acc[ai][0][m][1][e] * rstd, u1 = acc[ai][1][m][1][e] * rstd;
                    o0[e] = g0 * sigm(g0) * u0; o1[e] = g1 * sigm(g1) * u1; }
                *(u32x4*)(ACT + r * 5632 + col0) = EPI_PACK8(o0, o1); }
    }
};
struct EpiDN { static constexpr bool PERM = true, AFTER_DRAIN = false;
    float* out;
    __device__ __forceinline__ void operator()(const f32x4 (&acc)[2][2][4][2], const Unit& u, int wr, int wc, int fr, int fq) const {
        const int row0 = u.pm * BM + wr * 64 + fr, col0 = u.pn * BM + wc * 32 + 8 * fq;
#pragma unroll
        for (int ai = 0; ai < 2; ++ai)
#pragma unroll
            for (int m = 0; m < 4; ++m) { const size_t r = (size_t)(row0 + ai * HALF + m * 16);
#pragma unroll
                for (int bj = 0; bj < 2; ++bj) { float* p = out + r * 2048 + col0 + bj * HALF;
                    const f32x4 h0 = *(const f32x4*)p + acc[ai][bj][m][0], h1 = *(const f32x4*)(p + 4) + acc[ai][bj][m][1];
                    *(f32x4*)p = h0; *(f32x4*)(p + 4) = h1; } }
    }
};
}

__device__ __forceinline__ void transpose_item(const float* W, int N, int K, bf16* WT, int src_col0, int dst_row0, int ncols, int kb, int nb, LAS float* scr, int lane) {
    const int k0 = 64 * kb, n0 = 32 * nb, kr = lane >> 3, c4 = lane & 7; const bool nv = (n0 + 4 * c4) < ncols;
    const float* src = W + (size_t)(k0 + kr) * N + src_col0 + n0 + 4 * c4;
    f4 v[8];
#pragma unroll
    for (int i = 0; i < 8; ++i) v[i] = nv ? *(const f4*)(src + (size_t)(8 * i) * N) : (f4){0.f, 0.f, 0.f, 0.f};
#pragma unroll
    for (int i = 0; i < 8; ++i) { LAS float* d = scr + (8 * i + kr) * 33 + 4 * c4; d[0] = v[i].x; d[1] = v[i].y; d[2] = v[i].z; d[3] = v[i].w; }
    LDS_WAIT(); asm volatile("" ::: "memory");
    const int c = lane & 7;
#pragma unroll
    for (int j = 0; j < 4; ++j) { const int n = (lane >> 3) + 8 * j; const LAS float* s = scr + (8 * c) * 33 + n;
        v4u o; o.x = pk2(s[0 * 33], s[1 * 33]); o.y = pk2(s[2 * 33], s[3 * 33]); o.z = pk2(s[4 * 33], s[5 * 33]); o.w = pk2(s[6 * 33], s[7 * 33]);
        if (n0 + n < ncols) *(v4u*)(WT + (size_t)(dst_row0 + n0 + n) * K + k0 + 8 * c) = o; }
    LDS_WAIT(); asm volatile("" ::: "memory");
}

struct Ptrs {
    const float *x, *meta, *n1, *w_in, *mu, *w0, *w2, *a0, *a2, *g2, *k_k, *k_a, *r_k, *gn_w, *gn_b, *q_g, *k_g, *f_bias, *w_a, *w_b, *w_o, *n2, *w_gu, *w_dn;
    float* out; unsigned char* ws;
};

template <bool LATE> __device__ __forceinline__ void p0_prologue(const Ptrs& P, LAS unsigned char* lds, int tid, int bi, int nb) {
    const int lane = tid & 63, wave = tid >> 6;
    LAS float* scr = (LAS float*)(lds + wave * 16384);
    const int gw = bi * NWAVES + wave, NGW = nb * NWAVES;
    bf16* WIN = (bf16*)(P.ws + WS_WIN); bf16* WA = (bf16*)(P.ws + WS_WA); bf16* WB = (bf16*)(P.ws + WS_WB); bf16* WO = (bf16*)(P.ws + WS_WO);
    bf16* WGU = (bf16*)(P.ws + WS_WGU); bf16* WDN = (bf16*)(P.ws + WS_WDN); bf16* WL = (bf16*)(P.ws + WS_WLORA); bf16* XN = (bf16*)(P.ws + WS_XN);
    constexpr int I0 = 32 * 110, I1 = 32 * 1, I2 = 32 * 96, I3 = 32 * 128, I4 = 16 * 64, I5 = 16 * 64, I6 = 32 * 64, I7 = 88 * 128, I8 = 88 * 64;
    constexpr int NITEMS = I0 + I1 + I2 + I3 + I4 + I5 + I6 + I7 + I8;
    constexpr int NEARLY = I0 + I1 + I2 + I3;
    for (int it = (LATE ? NEARLY : 0) + gw; it < (LATE ? NITEMS : NEARLY); it += NGW) {
        int r = it;
        if (r < I0) { transpose_item(P.w_in, NIN, 2048, WIN, 0, 0, 3520, r / 110, r % 110, scr, lane); continue; } r -= I0;
        if (r < I1) { transpose_item(P.w_in, NIN, 2048, WIN, 6592, 3520, 16, r, 0, scr, lane); continue; } r -= I1;
        if (r < I2) { transpose_item(P.w_in, NIN, 2048, WIN, 3520, 3584, 3072, r / 96, r % 96, scr, lane); continue; } r -= I2;
        if (r < I3) { transpose_item(P.w_in, NIN, 2048, WIN, 6608, 6656, 4096, r / 128, r % 128, scr, lane); continue; } r -= I3;
        if (r < I4) { transpose_item(P.w_a, 2048, 1024, WA, 0, 0, 2048, r / 64, r % 64, scr, lane); continue; } r -= I4;
        if (r < I5) { transpose_item(P.w_b, 2048, 1024, WB, 0, 0, 2048, r / 64, r % 64, scr, lane); continue; } r -= I5;
        if (r < I6) { transpose_item(P.w_o, 2048, 2048, WO, 0, 0, 2048, r / 64, r % 64, scr, lane); continue; } r -= I6;
        if (r < I7) { const int seg = r / 128, rem = r % 128, q = seg >> 1, bj = seg & 1;
            transpose_item(P.w_gu, NGU, 2048, WGU, bj * DFF + 128 * q, 256 * q + 128 * bj, 128, rem / 4, rem % 4, scr, lane); continue; } r -= I7;
        transpose_item(P.w_dn, 2048, DFF, WDN, 0, 0, 2048, r / 64, r % 64, scr, lane);
    }
    if (LATE) return;
    for (int t = gw; t < TP; t += NGW) {
        bf16* orow = XN + (size_t)t * DM;
        if (t >= TV) {
#pragma unroll
            for (int j = 0; j < 4; ++j) *(v4u*)(orow + 8 * (lane + 64 * j)) = (v4u){0u, 0u, 0u, 0u};
            continue; }
        const float* src = (t < TR) ? P.x + (size_t)t * DM : P.meta + (size_t)(t - TR) * DM;
        f4 v[8]; float ss = 0.f;
#pragma unroll
        for (int j = 0; j < 8; ++j) { v[j] = *(const f4*)(src + 4 * (lane + 64 * j)); ss += (v[j].x * v[j].x + v[j].y * v[j].y) + (v[j].z * v[j].z + v[j].w * v[j].w); }
        const float rstd = 1.0f / sqrtf(wave_sum(ss) * (1.0f / DM) + 1e-6f);
#pragma unroll
        for (int j = 0; j < 8; ++j) { const f4 g = *(const f4*)(P.n1 + 4 * (lane + 64 * j));
            *(v2u*)(orow + 4 * (lane + 64 * j)) = (v2u){pk2(v[j].x * rstd * g.x, v[j].y * rstd * g.y), pk2(v[j].z * rstd * g.z, v[j].w * rstd * g.w)}; }
    }
    const int gt = blockIdx.x * NTHR + tid, NGT = gridDim.x * NTHR;
    for (int idx = gt; idx < 16384; idx += NGT) { const int n = idx & 1023, c = idx >> 10; float v[8];
#pragma unroll
        for (int e = 0; e < 8; ++e) { const int k = 8 * c + e; v[e] = k < 96 ? P.w2[(size_t)k * 1024 + n] : 0.f; }
        *(v4u*)(WL + (size_t)n * 128 + 8 * c) = (v4u){pk2(v[0], v[1]), pk2(v[2], v[3]), pk2(v[4], v[5]), pk2(v[6], v[7])}; }
    for (int idx = gt; idx < 16384; idx += NGT) { const int n = idx & 1023, c = idx >> 10; float v[8];
#pragma unroll
        for (int e = 0; e < 8; ++e) { const int k = 8 * c + e; v[e] = k < 96 ? P.a2[(size_t)k * 1024 + n] : 0.f; }
        *(v4u*)(WL + 131072 + (size_t)n * 128 + 8 * c) = (v4u){pk2(v[0], v[1]), pk2(v[2], v[3]), pk2(v[4], v[5]), pk2(v[6], v[7])}; }
    for (int idx = gt; idx < 32768; idx += NGT) { const int n = idx & 1023, c = idx >> 10; float v[8];
#pragma unroll
        for (int e = 0; e < 8; ++e) { const int k = 8 * c + e; v[e] = P.g2[(size_t)k * 1024 + n]; }
        *(v4u*)(WL + 262144 + (size_t)n * 256 + 8 * c) = (v4u){pk2(v[0], v[1]), pk2(v[2], v[3]), pk2(v[4], v[5]), pk2(v[6], v[7])}; }
    for (int idx = gt; idx < 48 * 256; idx += NGT) *(v4u*)(WIN + (size_t)(3536 + idx / 256) * 2048 + 8 * (idx % 256)) = (v4u){0u, 0u, 0u, 0u};
}

__device__ __forceinline__ void p2a_prep(const Ptrs& P, int tid) {
    const int lane = tid & 63, wave = tid >> 6;
    const int gw = blockIdx.x * NWAVES + wave, NGW = gridDim.x * NWAVES;
    const bf16* ZR = (const bf16*)(P.ws + WS_ZR); bf16* U = (bf16*)(P.ws + WS_U); bf16* Q = (bf16*)(P.ws + WS_Q); bf16* K = (bf16*)(P.ws + WS_K);
    float* LOGF = (float*)(P.ws + WS_LOGF);
    for (int t = gw; t < TP; t += NGW) {
        bf16* u1 = U + (size_t)t * 128; bf16* u2 = U + (size_t)TP * 128 + (size_t)t * 128; bf16* u3 = U + (size_t)TP * 256 + (size_t)t * 256;
        if (t >= TV) { if (lane < 16) { *(v4u*)(u1 + 8 * lane) = (v4u){0u, 0u, 0u, 0u}; *(v4u*)(u2 + 8 * lane) = (v4u){0u, 0u, 0u, 0u}; } if (lane < 32) *(v4u*)(u3 + 8 * lane) = (v4u){0u, 0u, 0u, 0u}; continue; }
        const int tp = (t < TR) ? ((t & (SEQ - 1)) ? t - 1 : TV - 1) : (t > TR ? t - 1 : -1);
        const bf16* z = ZR + (size_t)t * ZRW; const bf16* zp = ZR + (size_t)(tp < 0 ? 0 : tp) * ZRW;
        if (lane < 56) {
            const int c8 = 8 * lane; float zc[8], zq[8], o[8];
            { const v4u a = *(const v4u*)(z + 3072 + c8); const v4u b_ = tp < 0 ? (v4u){0u, 0u, 0u, 0u} : *(const v4u*)(zp + 3072 + c8);
#pragma unroll
              for (int e = 0; e < 4; ++e) { zc[2 * e] = bflo(a[e]); zc[2 * e + 1] = bfhi(a[e]); zq[2 * e] = bflo(b_[e]); zq[2 * e + 1] = bfhi(b_[e]); } }
            const f4 m0 = *(const f4*)(P.mu + 3072 + c8), m1 = *(const f4*)(P.mu + 3072 + c8 + 4); const float mu8[8] = {m0.x, m0.y, m0.z, m0.w, m1.x, m1.y, m1.z, m1.w};
#pragma unroll
            for (int e = 0; e < 8; ++e) { const float zs = zc[e] + (zq[e] - zc[e]) * mu8[e];
                if (c8 < 96) { const float ex = __builtin_amdgcn_exp2f(2.f * LOG2E * zs); o[e] = 1.f - 2.f * __builtin_amdgcn_rcpf(ex + 1.f); }
                else if (c8 < 192) o[e] = zs;
                else o[e] = sigmoidf_(zs); }
            bf16* dst = c8 < 96 ? u1 + c8 : (c8 < 192 ? u2 + (c8 - 96) : u3 + (c8 - 192));
            *(v4u*)dst = (v4u){pk2(o[0], o[1]), pk2(o[2], o[3]), pk2(o[4], o[5]), pk2(o[6], o[7])};
        } else { bf16* dst = (lane < 60 ? u1 : u2) + 96 + 8 * (lane & 3); *(v4u*)dst = (v4u){0u, 0u, 0u, 0u}; }
        if (lane < 16) { const float xx = bf2f(z[3520 + lane]) + P.f_bias[lane];
            LOGF[(size_t)t * 16 + lane] = fminf(xx, 0.f) - log1pf(__expf(-fabsf(xx))); }
#pragma unroll
        for (int which = 0; which < 2; ++which) {
            bf16* row = (which ? K : Q) + (size_t)t * 1024 + 16 * lane; const float* g = (which ? P.k_g : P.q_g) + 16 * (lane & 3);
            const v4u w0 = *(const v4u*)row, w1 = *(const v4u*)(row + 8); float v[16];
#pragma unroll
            for (int e = 0; e < 4; ++e) { v[2 * e] = bflo(w0[e]); v[2 * e + 1] = bfhi(w0[e]); v[8 + 2 * e] = bflo(w1[e]); v[8 + 2 * e + 1] = bfhi(w1[e]); }
            float ss = 0.f;
#pragma unroll
            for (int e = 0; e < 16; ++e) ss += v[e] * v[e];
            ss += __shfl_xor(ss, 1); ss += __shfl_xor(ss, 2);
            const float rs = (1.0f / sqrtf(ss * (1.0f / 64.0f) + 1e-6f)) * (which ? 1.0f : C2);
#pragma unroll
            for (int e = 0; e < 16; ++e) v[e] = v[e] * rs * g[e];
            *(v4u*)row = (v4u){pk2(v[0], v[1]), pk2(v[2], v[3]), pk2(v[4], v[5]), pk2(v[6], v[7])};
            *(v4u*)(row + 8) = (v4u){pk2(v[8], v[9]), pk2(v[10], v[11]), pk2(v[12], v[13]), pk2(v[14], v[15])};
        }
    }
}

__device__ __forceinline__ v4u split3(float x) { const unsigned h = f2bf(x); const float r1 = x - bf2f(h); const unsigned m = f2bf(r1); const float r2 = r1 - bf2f(m); const unsigned l = f2bf(r2);
    return (v4u){h | (m << 16), l, 0u, 0u}; }
__device__ __forceinline__ void p2b_cumsum(const Ptrs& P, int bh, LAS unsigned char* lds, int tid) {
    const int b = bh >> 4, h = bh & 15;
    const float* LOGF = (const float*)(P.ws + WS_LOGF); bf16* KE = (bf16*)(P.ws + WS_KE) + (size_t)bh * KEROWS * 16;
    LAS float* sc = (LAS float*)lds;
    float v[8]; float s = 0.f;
#pragma unroll
    for (int j = 0; j < 8; ++j) { s += LOGF[((size_t)b * SEQ + 8 * tid + j) * 16 + h]; v[j] = s; }
    sc[tid] = s; __syncthreads();
    for (int o = 1; o < NTHR; o <<= 1) { const float add = tid >= o ? sc[tid - o] : 0.f; __syncthreads(); sc[tid] += add; __syncthreads(); }
    const float off = sc[tid] - s;
#pragma unroll
    for (int j = 0; j < 8; ++j) { bf16* e = KE + (size_t)(64 + 8 * tid + j) * 16; *(v4u*)e = split3(-(off + v[j]) * LOG2E); *(v4u*)(e + 8) = (v4u){0u, 0u, 0u, 0u}; }
    if (tid < 64) { float kb = -30000.f;
        if (tid < 16) { float c15 = 0.f, cj = 0.f; for (int m = 0; m < 16; ++m) { const float lf = LOGF[(size_t)(TR + m) * 16 + h]; c15 += lf; if (m <= tid) cj += lf; } kb = (c15 - cj) * LOG2E; }
        bf16* e = KE + (size_t)tid * 16; *(v4u*)e = split3(kb); *(v4u*)(e + 8) = (v4u){0u, 0u, 0u, 0u}; }
    __syncthreads();
}

template <int CTRL> __device__ __forceinline__ float dppf(float v) { return __uint_as_float((unsigned)__builtin_amdgcn_update_dpp(0, (int)__float_as_uint(v), CTRL, 0xF, 0xF, true)); }
__device__ __forceinline__ float red8(float v) { v += dppf<0xB1>(v); v += dppf<0x4E>(v); v += dppf<0x141>(v); return v; }
__device__ __forceinline__ float red16(float v) { v += dppf<0xB1>(v); v += dppf<0x4E>(v); v += dppf<0x141>(v); v += dppf<0x140>(v); return v; }
constexpr int SC_T = 32, SC_ARR = SC_T * 64, SC_BUF = 6 * SC_ARR;
__device__ __forceinline__ void unpk8(const v4u w, float (&o)[8]) {
#pragma unroll
    for (int e = 0; e < 4; ++e) { o[2 * e] = bflo(w[e]); o[2 * e + 1] = bfhi(w[e]); }
}
#define SC_BAR() do { asm volatile("s_waitcnt lgkmcnt(0)" ::: "memory"); __builtin_amdgcn_s_barrier(); asm volatile("" ::: "memory"); } while (0)
constexpr int CS_XA = 0, CS_XB = 4608, CS_XK = 9216, CS_XR = 13824;
constexpr int CS_TB = 18432, CS_TK = 23552, CS_TV = 28672;
constexpr int CS_DEC = 33792, CS_WT = 41984, CS_GL = 42240;
constexpr int CS_GA = 46336, CS_GB = 48896, CS_GK = 51456;
constexpr int CS_SS = 54016, CS_RH = 63232, CS_UT = 72448, CS_YS = 77568;
constexpr int CS_FLG = 43008;
constexpr int CS_GSV = 137216;
constexpr int CS_RKS = 136960;
constexpr int CS_PRM = 134912;
constexpr int CS_OP2 = 101120;
constexpr int CS_LP = 85760, CS_LT = 98560;
__device__ __forceinline__ f32x16 mfma32(bf16x8 a, bf16x8 b, f32x16 c) { return __builtin_amdgcn_mfma_f32_32x32x16_bf16(a, b, c, 0, 0, 0); }
__device__ __forceinline__ int crow(int r, int hi) { return (r & 3) + 8 * (r >> 2) + 4 * hi; }
__device__ __forceinline__ void p3_scanc(const Ptrs& P, int bh, LAS unsigned char* lds, int tid) {
    const int lane = tid & 63, wid = __builtin_amdgcn_readfirstlane(tid >> 6), b = bh >> 4, h = bh & 15, n = lane & 31, hi = lane >> 5;
    const bf16* ZR = (const bf16*)(P.ws + WS_ZR); const float* LW = (const float*)(P.ws + WS_LW); const bf16* LA = (const bf16*)(P.ws + WS_LA); const bf16* LG = (const bf16*)(P.ws + WS_LG);
    bf16* YA = (bf16*)(P.ws + WS_YA);
    constexpr int NSTEP = 16 + SEQ, NCH = (NSTEP + 31) / 32;
    constexpr int OPB = 33792;
    const bool prep = wid >= 4;
    const int t2 = tid & 255, sl = t2 >> 3, cgp = t2 & 7, c0 = h * 64 + 8 * cgp, pw = (wid & 3), q8 = lane >> 3;
    { const int kind = tid >> 6, ch = tid & 63; const float* srcp = kind == 0 ? P.mu : kind == 1 ? P.mu + 1024 : kind == 2 ? P.mu + 2048 : kind == 3 ? P.k_k : kind == 4 ? P.k_a : kind == 5 ? P.r_k : kind == 6 ? P.gn_w : P.gn_b;
      ((LAS float*)(lds + CS_PRM))[kind * 64 + ch] = srcp[h * 64 + ch]; }
    if (tid == 0) *(LAS unsigned*)(lds + CS_FLG) = 0u;
#define CS_PRM8(kind, arr) float arr[8]; { const f4 p0_ = *(const LAS f4*)(lds + CS_PRM + (kind) * 256 + cgp * 32), p1_ = *(const LAS f4*)(lds + CS_PRM + (kind) * 256 + cgp * 32 + 16); \
        arr[0] = p0_.x; arr[1] = p0_.y; arr[2] = p0_.z; arr[3] = p0_.w; arr[4] = p1_.x; arr[5] = p1_.y; arr[6] = p1_.z; arr[7] = p1_.w; }
    for (int i = tid; i < 9216 / 4; i += NTHR) ((LAS unsigned*)(lds + CS_SS))[i] = 0u;
    SC_BAR();
    f32x16 ST = {};
    v4u q_zr, q_zk, q_zv, q_pr, q_pk, q_pv, q_la, q_g; f4 q_d0, q_d1;
#define CS_FETCH(chunk) do { const int s_ = (chunk) * 32 + sl; const v4u z0_ = (v4u){0u, 0u, 0u, 0u}; \
        q_zr = z0_; q_zk = z0_; q_zv = z0_; q_pr = z0_; q_pk = z0_; q_pv = z0_; q_la = z0_; q_g = z0_; q_d0 = (f4){1.f, 1.f, 1.f, 1.f}; q_d1 = q_d0; \
        if (s_ < NSTEP) { const int row_ = s_ < 16 ? TR + s_ : b * SEQ + s_ - 16; const int prow_ = s_ == 0 ? -1 : (s_ <= 16 ? TR + s_ - 1 : row_ - 1); \
            const bf16* z_ = ZR + (size_t)row_ * ZRW + c0; q_zr = *(const v4u*)z_; q_zk = *(const v4u*)(z_ + 1024); q_zv = *(const v4u*)(z_ + 2048); \
            if (prow_ >= 0) { const bf16* zp_ = ZR + (size_t)prow_ * ZRW + c0; q_pr = *(const v4u*)zp_; q_pk = *(const v4u*)(zp_ + 1024); q_pv = *(const v4u*)(zp_ + 2048); } \
            q_d0 = *(const f4*)(LW + (size_t)row_ * 1024 + c0); q_d1 = *(const f4*)(LW + (size_t)row_ * 1024 + c0 + 4); q_la = *(const v4u*)(LA + (size_t)row_ * 1024 + c0); \
            if (s_ >= 16) q_g = *(const v4u*)(LG + (size_t)row_ * 1024 + c0); } } while (0)
#define CS_W16(base, o, val) (*(LAS unsigned short*)(ob_ + (base) + (o)) = (unsigned short)(val))
#define CS_ALPHA_A(bufsel) do { LAS unsigned char* ob_ = lds + ((bufsel) ? CS_OP2 : 0); \
        *(LAS f4*)(lds + CS_DEC + sl * 256 + cgp * 32) = q_d0; *(LAS f4*)(lds + CS_DEC + sl * 256 + cgp * 32 + 16) = q_d1; \
        asm volatile("s_waitcnt lgkmcnt(0)" ::: "memory"); if (lane == 0) __hip_atomic_fetch_add((LAS unsigned*)(lds + CS_FLG), 1u, __ATOMIC_RELAXED, __HIP_MEMORY_SCOPE_WORKGROUP);     \
        float r_[8], k_[8], v_[8], a_[8], pr_[8], pk_[8], pv_[8]; CS_PRM8(0, mu_r) CS_PRM8(1, mu_k) CS_PRM8(2, mu_v) CS_PRM8(3, kkw) CS_PRM8(4, kaw) CS_PRM8(5, rkw) \
        unpk8(q_zr, r_); unpk8(q_zk, k_); unpk8(q_zv, v_); unpk8(q_pr, pr_); unpk8(q_pk, pk_); unpk8(q_pv, pv_); unpk8(q_la, a_); \
        *(LAS v4u*)(lds + CS_GSV + (bufsel) * 4096 + sl * 128 + cgp * 16) = q_g; \
        float kkv_[8], kf_[8], ss_ = 0.f, rk_ = 0.f; \
        _Pragma("unroll") for (int j = 0; j < 8; ++j) { r_[j] = r_[j] + (pr_[j] - r_[j]) * mu_r[j]; const float kk_ = k_[j] + (pk_[j] - k_[j]) * mu_k[j]; v_[j] = v_[j] + (pv_[j] - v_[j]) * mu_v[j]; \
            kkv_[j] = kk_ * kkw[j]; ss_ += kkv_[j] * kkv_[j]; kf_[j] = kk_ * (1.f + (a_[j] - 1.f) * kaw[j]); rk_ += r_[j] * kf_[j] * rkw[j]; } \
        ss_ = red8(ss_); rk_ = red8(rk_); \
        const float inv_ = __builtin_amdgcn_rcpf(fmaxf(__builtin_amdgcn_sqrtf(ss_), 1e-12f)); \
        float kn_[8], bv_[8]; \
        _Pragma("unroll") for (int j = 0; j < 8; ++j) { kn_[j] = kkv_[j] * inv_; bv_[j] = kn_[j] * a_[j]; } \
        const int ro_ = sl * 144 + cgp * 16; \
        *(LAS v4u*)(ob_ + CS_XR + ro_) = (v4u){pk2(r_[0], r_[1]), pk2(r_[2], r_[3]), pk2(r_[4], r_[5]), pk2(r_[6], r_[7])}; \
        *(LAS v4u*)(ob_ + CS_XK + ro_) = (v4u){pk2(kf_[0], kf_[1]), pk2(kf_[2], kf_[3]), pk2(kf_[4], kf_[5]), pk2(kf_[6], kf_[7])}; \
        *(LAS v4u*)(ob_ + CS_XA + ro_) = (v4u){pk2(kn_[0], kn_[1]), pk2(kn_[2], kn_[3]), pk2(kn_[4], kn_[5]), pk2(kn_[6], kn_[7])}; \
        *(LAS v4u*)(ob_ + CS_XB + ro_) = (v4u){pk2(bv_[0], bv_[1]), pk2(bv_[2], bv_[3]), pk2(bv_[4], bv_[5]), pk2(bv_[6], bv_[7])}; \
        { const v4u pv_2 = (v4u){pk2(v_[0], v_[1]), pk2(v_[2], v_[3]), pk2(v_[4], v_[5]), pk2(v_[6], v_[7])}; const int to_ = (8 * cgp) * 80 + sl * 2; \
          _Pragma("unroll") for (int e_ = 0; e_ < 4; ++e_) { CS_W16(CS_TV, to_ + (2 * e_) * 80, pv_2[e_] & 0xffffu); CS_W16(CS_TV, to_ + (2 * e_ + 1) * 80, pv_2[e_] >> 16); } } \
        if (cgp == 0) ((LAS float*)(lds + CS_RKS))[(bufsel) * 32 + sl] = rk_; \
        } while (0)
#define CS_ALPHA_B(bufsel) do { LAS unsigned char* ob_ = lds + ((bufsel) ? CS_OP2 : 0); \
        const int ro_ = sl * 144 + cgp * 16; \
        float xa_[8], xb_[8], xk_[8], xr_[8], wt_[8], wm_[8]; \
        { const f4 w0_ = *(const LAS f4*)(lds + CS_DEC + sl * 256 + cgp * 32), w1_ = *(const LAS f4*)(lds + CS_DEC + sl * 256 + cgp * 32 + 16); \
          const int slm_ = sl > 0 ? sl - 1 : 0; const f4 m0_ = *(const LAS f4*)(lds + CS_DEC + slm_ * 256 + cgp * 32), m1_ = *(const LAS f4*)(lds + CS_DEC + slm_ * 256 + cgp * 32 + 16); \
          wt_[0] = w0_.x; wt_[1] = w0_.y; wt_[2] = w0_.z; wt_[3] = w0_.w; wt_[4] = w1_.x; wt_[5] = w1_.y; wt_[6] = w1_.z; wt_[7] = w1_.w; \
          wm_[0] = m0_.x; wm_[1] = m0_.y; wm_[2] = m0_.z; wm_[3] = m0_.w; wm_[4] = m1_.x; wm_[5] = m1_.y; wm_[6] = m1_.z; wm_[7] = m1_.w; \
          if (sl == 0) { _Pragma("unroll") for (int j = 0; j < 8; ++j) wm_[j] = 1.f; } } \
        unpk8(*(const LAS v4u*)(ob_ + CS_XA + ro_), xa_); unpk8(*(const LAS v4u*)(ob_ + CS_XB + ro_), xb_); unpk8(*(const LAS v4u*)(ob_ + CS_XK + ro_), xk_); unpk8(*(const LAS v4u*)(ob_ + CS_XR + ro_), xr_); \
        _Pragma("unroll") for (int j = 0; j < 8; ++j) { const float W_ = wt_[j], iw_ = __builtin_amdgcn_rcpf(W_); \
            xa_[j] = -xa_[j] * wm_[j]; xb_[j] = xb_[j] * iw_; xk_[j] = xk_[j] * iw_; xr_[j] = xr_[j] * W_; } \
        const v4u pa_ = (v4u){pk2(xa_[0], xa_[1]), pk2(xa_[2], xa_[3]), pk2(xa_[4], xa_[5]), pk2(xa_[6], xa_[7])}, pb_ = (v4u){pk2(xb_[0], xb_[1]), pk2(xb_[2], xb_[3]), pk2(xb_[4], xb_[5]), pk2(xb_[6], xb_[7])}; \
        const v4u pk_2 = (v4u){pk2(xk_[0], xk_[1]), pk2(xk_[2], xk_[3]), pk2(xk_[4], xk_[5]), pk2(xk_[6], xk_[7])}, pr_2 = (v4u){pk2(xr_[0], xr_[1]), pk2(xr_[2], xr_[3]), pk2(xr_[4], xr_[5]), pk2(xr_[6], xr_[7])}; \
        *(LAS v4u*)(ob_ + CS_XA + ro_) = pa_; *(LAS v4u*)(ob_ + CS_XB + ro_) = pb_; *(LAS v4u*)(ob_ + CS_XK + ro_) = pk_2; *(LAS v4u*)(ob_ + CS_XR + ro_) = pr_2; \
        const int to_ = (8 * cgp) * 80 + sl * 2; \
        _Pragma("unroll") for (int e_ = 0; e_ < 4; ++e_) { CS_W16(CS_TB, to_ + (2 * e_) * 80, pb_[e_] & 0xffffu); CS_W16(CS_TB, to_ + (2 * e_ + 1) * 80, pb_[e_] >> 16); \
            CS_W16(CS_TK, to_ + (2 * e_) * 80, pk_2[e_] & 0xffffu); CS_W16(CS_TK, to_ + (2 * e_ + 1) * 80, pk_2[e_] >> 16); } \
        if (sl == 31) { *(LAS f4*)(lds + CS_WT + (bufsel) * 256 + cgp * 32) = (f4){wt_[0], wt_[1], wt_[2], wt_[3]}; *(LAS f4*)(lds + CS_WT + (bufsel) * 256 + cgp * 32 + 16) = (f4){wt_[4], wt_[5], wt_[6], wt_[7]}; } } while (0)
#define CS_POST(chunk) do { const int s_ = (chunk) * 32 + sl; const f4 y0_ = *(const LAS f4*)(lds + CS_YS + sl * 256 + cgp * 32), y1_ = *(const LAS f4*)(lds + CS_YS + sl * 256 + cgp * 32 + 16); \
        float y_[8] = {y0_.x, y0_.y, y0_.z, y0_.w, y1_.x, y1_.y, y1_.z, y1_.w}, g_[8], o_[8], vv_[8]; unpk8(*(const LAS v4u*)(lds + CS_GSV + ((chunk) & 1) * 4096 + sl * 128 + cgp * 16), g_); CS_PRM8(6, gnw) CS_PRM8(7, gnb) \
        { const LAS unsigned char* tv_ = lds + (((chunk) & 1) ? CS_OP2 : 0) + CS_TV + (8 * cgp) * 80 + sl * 2; _Pragma("unroll") for (int j = 0; j < 8; ++j) vv_[j] = bf2f(*(const LAS unsigned short*)(tv_ + j * 80)); } \
        const float rkp_ = ((const LAS float*)(lds + CS_RKS))[((chunk) & 1) * 32 + sl]; \
        float sum_ = 0.f; _Pragma("unroll") for (int j = 0; j < 8; ++j) sum_ += y_[j]; \
        const float mean_ = red8(sum_) * (1.f / 64.f); float m2_ = 0.f; \
        _Pragma("unroll") for (int j = 0; j < 8; ++j) { y_[j] -= mean_; m2_ += y_[j] * y_[j]; } \
        const float rstd_ = __builtin_amdgcn_rsqf(red8(m2_) * (1.f / 64.f) + 64e-5f); \
        _Pragma("unroll") for (int j = 0; j < 8; ++j) o_[j] = (y_[j] * rstd_ * gnw[j] + gnb[j] + rkp_ * vv_[j]) * g_[j]; \
        if (s_ >= 16 && s_ < NSTEP) *(v4u*)(YA + (size_t)(b * SEQ + s_ - 16) * 1024 + c0) = (v4u){pk2(o_[0], o_[1]), pk2(o_[2], o_[3]), pk2(o_[4], o_[5]), pk2(o_[6], o_[7])}; } while (0)
#define CS_KEEP_ROT() do { } while (0)
#define CS_CUMPROD(want) do { while (__hip_atomic_load((LAS unsigned*)(lds + CS_FLG), __ATOMIC_RELAXED, __HIP_MEMORY_SCOPE_WORKGROUP) < (want)) __builtin_amdgcn_s_sleep(1); \
        asm volatile("" ::: "memory"); LAS float* dcol_ = (LAS float*)(lds + CS_DEC) + lane; float d_[32]; \
        _Pragma("unroll") for (int t_ = 0; t_ < 32; ++t_) d_[t_] = dcol_[t_ * 64]; \
        _Pragma("unroll") for (int t_ = 1; t_ < 32; ++t_) d_[t_] *= d_[t_ - 1]; \
        _Pragma("unroll") for (int t_ = 1; t_ < 32; ++t_) dcol_[t_ * 64] = d_[t_]; } while (0)
    if (prep) { CS_FETCH(0); CS_ALPHA_A(0); CS_FETCH(1); }
    SC_BAR();
    if (wid == 1) CS_CUMPROD(4u);
    SC_BAR();
    if (prep) { CS_ALPHA_B(0); CS_KEEP_ROT(); }
    SC_BAR();
    for (int c = 0; c < NCH; ++c) {
        const LAS unsigned char* ob = lds + ((c & 1) ? CS_OP2 : 0);
        if (!prep) {
            const LAS unsigned char* As = ob + (wid < 2 ? CS_XA : CS_XR) + n * 144 + hi * 16; const LAS unsigned char* Bs = ob + ((wid & 1) ? CS_XK : CS_XB) + n * 144 + hi * 16;
            f32x16 g = {};
#pragma unroll
            for (int ks = 0; ks < 4; ++ks) g = mfma32(*(const LAS bf16x8*)(As + ks * 32), *(const LAS bf16x8*)(Bs + ks * 32), g);
            if (wid == 0) {
#pragma unroll
                for (int r = 0; r < 16; ++r) if (n >= crow(r, hi)) g[r] = 0.f;
                for (int i = 0; i < 5; ++i) {
                    LAS unsigned short* lp = (LAS unsigned short*)(lds + CS_LP + i * 2560);
#pragma unroll
                    for (int r = 0; r < 16; ++r) lp[crow(r, hi) * 40 + n] = (unsigned short)(pk2(g[r], 0.f) & 0xffffu);
                    if (i == 4) break;
                    const bf16x8 b0 = __builtin_bit_cast(bf16x8, (v4u){pk2(g[0], g[1]), pk2(g[2], g[3]), pk2(g[4], g[5]), pk2(g[6], g[7])});
                    const bf16x8 b1 = __builtin_bit_cast(bf16x8, (v4u){pk2(g[8], g[9]), pk2(g[10], g[11]), pk2(g[12], g[13]), pk2(g[14], g[15])});
                    asm volatile("s_waitcnt lgkmcnt(0)" ::: "memory");
                    const LAS unsigned char* Ap = lds + CS_LP + i * 2560 + n * 80 + hi * 8;
                    const v2u a00 = *(const LAS v2u*)Ap, a01 = *(const LAS v2u*)(Ap + 16), a10 = *(const LAS v2u*)(Ap + 32), a11 = *(const LAS v2u*)(Ap + 48);
                    asm volatile("s_waitcnt lgkmcnt(0)" ::: "memory");
                    f32x16 g2 = {}; g2 = mfma32(__builtin_bit_cast(bf16x8, (v4u){a00[0], a00[1], a01[0], a01[1]}), b0, g2); g2 = mfma32(__builtin_bit_cast(bf16x8, (v4u){a10[0], a10[1], a11[0], a11[1]}), b1, g2);
                    asm volatile("s_nop 15\n\ts_nop 7" : "+v"(g2)); g = g2;
                }
            } else {
                LAS unsigned short* G = (LAS unsigned short*)(lds + (wid == 1 ? CS_GA : (wid == 2 ? CS_GB : CS_GK)));
#pragma unroll
                for (int r = 0; r < 16; ++r) { const int t = crow(r, hi); const bool keep = wid == 1 ? (n < t) : (n <= t); G[t * 40 + n] = (unsigned short)(pk2(keep ? g[r] : 0.f, 0.f) & 0xffffu); }
            }
            if (wid == 1 && c + 1 < NCH) CS_CUMPROD(4u * (unsigned)(c + 2));
        } else {
            if (c >= 1) CS_POST(c - 1);
            if (c + 1 < NCH) { CS_ALPHA_A((c + 1) & 1); if (c + 2 < NCH) CS_FETCH(c + 2); }
        }
        SC_BAR();
        if (!prep) {
            const int vb = wid & 1;
            const LAS unsigned char* As = ob + (wid < 2 ? CS_XA : CS_XR) + n * 144 + hi * 16; const LAS unsigned char* Bs = lds + CS_SS + (32 * vb + n) * 144 + hi * 16;
            f32x16 acc = {};
#pragma unroll
            for (int ks = 0; ks < 4; ++ks) acc = mfma32(*(const LAS bf16x8*)(As + ks * 32), *(const LAS bf16x8*)(Bs + ks * 32), acc);
            if (wid < 2) {
                const LAS unsigned char* Ga = lds + CS_GA + n * 80 + hi * 16; const LAS unsigned char* Tv = ob + CS_TV + (32 * vb + n) * 80 + hi * 16;
#pragma unroll
                for (int js = 0; js < 2; ++js) acc = mfma32(*(const LAS bf16x8*)(Ga + js * 32), *(const LAS bf16x8*)(Tv + js * 32), acc);
                LAS unsigned char* xt = lds + CS_UT + (32 * vb + n) * 80; asm volatile("s_nop 15\n\ts_nop 7" : "+v"(acc));
#pragma unroll 1
                for (int i = 0; i < 5; ++i) {
                    const LAS unsigned char* Ap = lds + CS_LP + i * 2560 + n * 80 + hi * 8;
                    const v2u a00 = *(const LAS v2u*)Ap, a01 = *(const LAS v2u*)(Ap + 16), a10 = *(const LAS v2u*)(Ap + 32), a11 = *(const LAS v2u*)(Ap + 48);
                    const bf16x8 b0 = __builtin_bit_cast(bf16x8, (v4u){pk2(acc[0], acc[1]), pk2(acc[2], acc[3]), pk2(acc[4], acc[5]), pk2(acc[6], acc[7])});
                    const bf16x8 b1 = __builtin_bit_cast(bf16x8, (v4u){pk2(acc[8], acc[9]), pk2(acc[10], acc[11]), pk2(acc[12], acc[13]), pk2(acc[14], acc[15])});
                    asm volatile("s_waitcnt lgkmcnt(0)" ::: "memory");
                    acc = mfma32(__builtin_bit_cast(bf16x8, (v4u){a00[0], a00[1], a01[0], a01[1]}), b0, acc); acc = mfma32(__builtin_bit_cast(bf16x8, (v4u){a10[0], a10[1], a11[0], a11[1]}), b1, acc);
                    asm volatile("s_nop 15\n\ts_nop 7" : "+v"(acc));
                }
#pragma unroll
                for (int r4 = 0; r4 < 4; ++r4) *(LAS v2u*)(xt + (8 * r4 + 4 * hi) * 2) = (v2u){pk2(acc[4 * r4], acc[4 * r4 + 1]), pk2(acc[4 * r4 + 2], acc[4 * r4 + 3])};
            } else { LAS float* ys = (LAS float*)(lds + CS_YS) + 32 * vb + n; asm volatile("s_nop 15\n\ts_nop 7" : "+v"(acc));
#pragma unroll
                for (int r = 0; r < 16; ++r) ys[crow(r, hi) * 64] = acc[r]; }
        } else if (c + 1 < NCH) { CS_ALPHA_B((c + 1) & 1); CS_KEEP_ROT(); }
        else { CS_KEEP_ROT(); }
        SC_BAR();
        if (!prep) {
            const int vb = wid & 1, kb = wid >> 1;
            const LAS unsigned char* Ut = lds + CS_UT + (32 * vb + n) * 80 + hi * 16; const LAS unsigned char* Tv = ob + CS_TV + (32 * vb + n) * 80 + hi * 16;
            if (wid >= 2) {
                f32x16 acc; { const LAS float* ys0 = (const LAS float*)(lds + CS_YS) + 32 * vb + n;
#pragma unroll
                  for (int r = 0; r < 16; ++r) acc[r] = ys0[crow(r, hi) * 64]; }
                const LAS unsigned char* Gb = lds + CS_GB + n * 80 + hi * 16; const LAS unsigned char* Gk = lds + CS_GK + n * 80 + hi * 16;
#pragma unroll
                for (int js = 0; js < 2; ++js) { acc = mfma32(*(const LAS bf16x8*)(Gb + js * 32), *(const LAS bf16x8*)(Ut + js * 32), acc); acc = mfma32(*(const LAS bf16x8*)(Gk + js * 32), *(const LAS bf16x8*)(Tv + js * 32), acc); }
                LAS float* ys = (LAS float*)(lds + CS_YS) + 32 * vb + n;
#pragma unroll
                for (int r = 0; r < 16; ++r) ys[crow(r, hi) * 64] = acc[r];
            }
            const LAS unsigned char* Tb = ob + CS_TB + (32 * kb + n) * 80 + hi * 16; const LAS unsigned char* Tk = ob + CS_TK + (32 * kb + n) * 80 + hi * 16;
#pragma unroll
            for (int js = 0; js < 2; ++js) { ST = mfma32(*(const LAS bf16x8*)(Tb + js * 32), *(const LAS bf16x8*)(Ut + js * 32), ST); ST = mfma32(*(const LAS bf16x8*)(Tk + js * 32), *(const LAS bf16x8*)(Tv + js * 32), ST); }
            const LAS float* wt = (const LAS float*)(lds + CS_WT + (c & 1) * 256) + 32 * kb + 4 * hi; LAS unsigned char* ss = lds + CS_SS + (32 * vb + n) * 144 + (32 * kb + 4 * hi) * 2;
#pragma unroll
            for (int r4 = 0; r4 < 4; ++r4) { const f4 w = *(const LAS f4*)(wt + 8 * r4);
                ST[4 * r4] *= w.x; ST[4 * r4 + 1] *= w.y; ST[4 * r4 + 2] *= w.z; ST[4 * r4 + 3] *= w.w;
                *(LAS v2u*)(ss + 16 * r4) = (v2u){pk2(ST[4 * r4], ST[4 * r4 + 1]), pk2(ST[4 * r4 + 2], ST[4 * r4 + 3])}; }
        }
        SC_BAR();
    }
    if (prep) CS_POST(NCH - 1);
#undef CS_FETCH
#undef CS_ALPHA_A
#undef CS_ALPHA_B
#undef CS_W16
#undef CS_POST
#undef CS_KEEP_ROT
#undef CS_PRM8
#undef CS_CUMPROD
    __syncthreads();
}

constexpr int AT_KROW = 176, AT_VROW = 144, AT_KBYTES = 64 * AT_KROW, AT_BUF = AT_KBYTES + 64 * AT_VROW;
__device__ __forceinline__ void attn_unit(const Ptrs& P, int bh, int qb, LAS unsigned char* lds, int tid) {
    const int lane = tid & 63, wid = tid >> 6, n = lane & 31, hi = lane >> 5, b = bh >> 4, h = bh & 15;
    bf16* Qb = (bf16*)(P.ws + WS_Q); const bf16* Kb = (const bf16*)(P.ws + WS_K); const bf16* Vb = (const bf16*)(P.ws + WS_V);
    const bf16* KE = (const bf16*)(P.ws + WS_KE) + (size_t)bh * KEROWS * 16;
    const int NTL = 4 * (qb + 1) + 1; const size_t rowb = (size_t)b * SEQ; const int qrow = 256 * qb + 32 * wid + n, qw0 = 256 * qb + 32 * wid;
    bf16x8 qf[5];
    { const bf16* qp = Qb + (rowb + qrow) * 1024 + h * 64 + hi * 8;
#pragma unroll
      for (int d0 = 0; d0 < 4; ++d0) qf[d0] = *(const bf16x8*)(qp + d0 * 16);
      const short one = hi == 0 ? (short)0x3F80 : (short)0; qf[4] = (bf16x8){one, one, one, 0, 0, 0, 0, 0}; }
    const int sj = tid >> 3, sc = tid & 7;
    const int slot = ((sj >> 5) * 32) + (((sj >> 4) & 1) * 16) + (((sj >> 2) & 1) * 8) + (((sj >> 3) & 1) * 4) + (sj & 3);
    const int vgrp = (slot >> 3) ^ sc, vpos = vgrp * 16 + (slot & 7) * 2;
    const int ej = tid >> 1, eh = tid & 1;
    v4u kreg, vreg, ereg = (v4u){0u, 0u, 0u, 0u};
#define AT_LOAD(t) do { const bool val_ = (t) > 0 || sj < 16; const size_t row_ = (t) == 0 ? (size_t)(TR + (sj & 15)) : rowb + 64 * ((t) - 1) + sj; \
        kreg = *(const v4u*)(Kb + row_ * 1024 + h * 64 + sc * 8); vreg = *(const v4u*)(Vb + row_ * 1024 + h * 64 + sc * 8); \
        if (!val_) { kreg = (v4u){0u, 0u, 0u, 0u}; vreg = (v4u){0u, 0u, 0u, 0u}; } \
        if (tid < 128) ereg = *(const v4u*)(KE + (size_t)(64 * (t) + ej) * 16 + eh * 8); } while (0)
#define AT_STORE(bufo) do { LAS unsigned char* kt_ = lds + (bufo); LAS unsigned char* vt_ = kt_ + AT_KBYTES; \
        *(LAS v4u*)(kt_ + sj * AT_KROW + sc * 16) = kreg; if (tid < 128) *(LAS v4u*)(kt_ + ej * AT_KROW + 128 + eh * 16) = ereg; \
        _Pragma("unroll") for (int i_ = 0; i_ < 8; ++i_) { const unsigned w_ = vreg[i_ >> 1]; *(LAS unsigned short*)(vt_ + (8 * sc + i_) * AT_VROW + vpos) = (unsigned short)((i_ & 1) ? (w_ >> 16) : (w_ & 0xffffu)); } } while (0)
    AT_LOAD(0); AT_STORE(0); __syncthreads();
    f32x16 o0 = {}, o1 = {}; float m = -INFINITY, l = 0.f;
    for (int t = 0; t < NTL; ++t) {
        if (t + 1 < NTL) AT_LOAD(t + 1);
        const int bufo = (t & 1) * AT_BUF; const int key0 = 64 * (t - 1);
        const bool skip = t >= 1 && key0 > qw0 + 31;
        if (!skip) {
            const LAS unsigned char* Kt = lds + bufo; const LAS unsigned char* Vt = Kt + AT_KBYTES;
            f32x16 s0 = {}, s1 = {};
#pragma unroll
            for (int d0 = 0; d0 < 5; ++d0) { const int off = d0 < 4 ? d0 * 32 + hi * 16 : 128 + hi * 16;
                const bf16x8 k0 = *(const LAS bf16x8*)(Kt + n * AT_KROW + off), k1 = *(const LAS bf16x8*)(Kt + (32 + n) * AT_KROW + off);
                s0 = __builtin_amdgcn_mfma_f32_32x32x16_bf16(k0, qf[d0], s0, 0, 0, 0); s1 = __builtin_amdgcn_mfma_f32_32x32x16_bf16(k1, qf[d0], s1, 0, 0, 0); }
            if (t >= 1 && key0 + 63 > qw0) {
#pragma unroll
                for (int r = 0; r < 16; ++r) { const int key = key0 + crow(r, hi); if (key > qrow) s0[r] = -INFINITY; if (key + 32 > qrow) s1[r] = -INFINITY; } }
            float mx = fmaxf(s0[0], s1[0]);
#pragma unroll
            for (int r = 1; r < 16; ++r) mx = fmaxf(mx, fmaxf(s0[r], s1[r]));
            mx = fmaxf(mx, __shfl_xor(mx, 32));
            const float mn = fmaxf(m, mx), f = __builtin_amdgcn_exp2f(m - mn); m = mn; l *= f;
#pragma unroll
            for (int r = 0; r < 16; ++r) { o0[r] *= f; o1[r] *= f; }
            float ls = 0.f;
#pragma unroll
            for (int r = 0; r < 16; ++r) { s0[r] = __builtin_amdgcn_exp2f(s0[r] - mn); s1[r] = __builtin_amdgcn_exp2f(s1[r] - mn); ls += s0[r] + s1[r]; }
            l += ls;
            v4u pa[4];
#pragma unroll
            for (int e = 0; e < 4; ++e) { pa[0][e] = pk2(s0[2 * e], s0[2 * e + 1]); pa[1][e] = pk2(s0[8 + 2 * e], s0[8 + 2 * e + 1]); pa[2][e] = pk2(s1[2 * e], s1[2 * e + 1]); pa[3][e] = pk2(s1[8 + 2 * e], s1[8 + 2 * e + 1]); }
#pragma unroll
            for (int sl = 0; sl < 4; ++sl) { const int grp = sl * 2 + hi; const bf16x8 pb = __builtin_bit_cast(bf16x8, pa[sl]);
                const bf16x8 v0 = *(const LAS bf16x8*)(Vt + n * AT_VROW + ((grp ^ ((n >> 3) & 7)) * 16));
                const bf16x8 v1 = *(const LAS bf16x8*)(Vt + (32 + n) * AT_VROW + ((grp ^ (((32 + n) >> 3) & 7)) * 16));
                o0 = __builtin_amdgcn_mfma_f32_32x32x16_bf16(v0, pb, o0, 0, 0, 0); o1 = __builtin_amdgcn_mfma_f32_32x32x16_bf16(v1, pb, o1, 0, 0, 0); }
        }
        if (t + 1 < NTL) AT_STORE(((t + 1) & 1) * AT_BUF);
        __syncthreads();
    }
#undef AT_LOAD
#undef AT_STORE
    l += __shfl_xor(l, 32); const float inv = 1.0f / l;
    bf16* op = Qb + (rowb + qrow) * 1024 + h * 64;
#pragma unroll
    for (int r4 = 0; r4 < 4; ++r4) {
        __hip_atomic_store((unsigned long long*)(op + 8 * r4 + 4 * hi), (unsigned long long)pk2(o0[4 * r4] * inv, o0[4 * r4 + 1] * inv) | ((unsigned long long)pk2(o0[4 * r4 + 2] * inv, o0[4 * r4 + 3] * inv) << 32), __ATOMIC_RELAXED, __HIP_MEMORY_SCOPE_AGENT);
        __hip_atomic_store((unsigned long long*)(op + 32 + 8 * r4 + 4 * hi), (unsigned long long)pk2(o1[4 * r4] * inv, o1[4 * r4 + 1] * inv) | ((unsigned long long)pk2(o1[4 * r4 + 2] * inv, o1[4 * r4 + 3] * inv) << 32), __ATOMIC_RELAXED, __HIP_MEMORY_SCOPE_AGENT); }
}

#define XB_TMO      128
#define XB_XCNT(j)  (256  + 64 * (j))
#define XB_XSUB(j)  (1280 + 64 * (j))
#define XB_XGEN(j)  (2304 + 64 * (j))
#define XB_TOP      3328
#define XB_TOPGEN   3392
#define XCD_BAR_WORDS 3456
#define XB_SPIN_CAP (1u << 18)

__device__ __forceinline__ unsigned xb_ld(unsigned* p)              { return __hip_atomic_load(p, __ATOMIC_RELAXED, __HIP_MEMORY_SCOPE_AGENT); }
__device__ __forceinline__ unsigned xb_add(unsigned* p, unsigned v) { return __hip_atomic_fetch_add(p, v, __ATOMIC_RELAXED, __HIP_MEMORY_SCOPE_AGENT); }
__device__ __forceinline__ unsigned xb_xcc_id() { return (unsigned)__builtin_amdgcn_s_getreg((3 << 11) | 20) & 0xFu; }
#define XB_SPIN(cond, bar) do { unsigned _sp = 0; while (cond) { __builtin_amdgcn_s_sleep(1); \
    if ((++_sp & 255u) == 0u) { if (xb_ld(&(bar)[XB_TMO])) break; if (_sp > XB_SPIN_CAP) { atomicAdd(&(bar)[XB_TMO], 1u); break; } } } } while (0)

struct XcdBarrier {
    unsigned* bar; unsigned x;
    volatile LAS unsigned* st;
};

__device__ __forceinline__ XcdBarrier xcd_barrier_post(unsigned* bar, volatile LAS unsigned* st) {
    XcdBarrier b; b.bar = bar; b.x = xb_xcc_id(); b.st = st;
    if (threadIdx.x == 0) (void)xb_add(&bar[XB_XCNT(b.x)], 1u);
    return b;
}
__device__ __forceinline__ void xcd_barrier_complete(unsigned* bar, unsigned x, unsigned& nloc, unsigned& nx) {
    const unsigned G = gridDim.x * gridDim.y * gridDim.z;
    unsigned sum, cnt, mine, sp = 0u;
    for (;;) {
        sum = 0u; cnt = 0u; mine = 0u;
#pragma unroll
        for (unsigned j = 0; j < 16; ++j) { const unsigned c = xb_ld(&bar[XB_XCNT(j)]); sum += c; cnt += (c > 0u) ? 1u : 0u; mine = (j == x) ? c : mine; }
        if (sum == G) break;
        __builtin_amdgcn_s_sleep(1);
        if ((++sp & 255u) == 0u) { if (xb_ld(&bar[XB_TMO])) break; if (sp > XB_SPIN_CAP) { atomicAdd(&bar[XB_TMO], 1u); break; } }
    }
    nloc = mine > 0u ? mine : 1u; nx = cnt > 0u ? cnt : 1u;
}

__device__ __forceinline__ void xcd_barrier(const XcdBarrier& b) {
    asm volatile("s_waitcnt vmcnt(0)" ::: "memory");
    __syncthreads();
    if (threadIdx.x == 0) {
        unsigned* bar = b.bar;
        __builtin_amdgcn_s_waitcnt(0);
        unsigned nloc = b.st[0], nx = b.st[1];
        if (nloc == 0u) { xcd_barrier_complete(bar, b.x, nloc, nx); b.st[0] = nloc; b.st[1] = nx; }
        const unsigned old = xb_add(&bar[XB_XSUB(b.x)], 1u);
        const unsigned gen = old / nloc;
        if (old + 1u == (gen + 1u) * nloc) {
            __builtin_amdgcn_fence(__ATOMIC_RELEASE, "agent");
            asm volatile("s_waitcnt vmcnt(0)" ::: "memory");
            const unsigned og = xb_add(&bar[XB_TOP], 1u);
            const unsigned tg = og / nx;
            if (og + 1u == (tg + 1u) * nx) xb_add(&bar[XB_TOPGEN], 1u);
            else XB_SPIN(xb_ld(&bar[XB_TOPGEN]) == tg, bar);
            __builtin_amdgcn_fence(__ATOMIC_ACQUIRE, "agent");
            xb_add(&bar[XB_XGEN(b.x)], 1u);
            asm volatile("s_waitcnt vmcnt(0)" ::: "memory");
        } else {
            XB_SPIN(xb_ld(&bar[XB_XGEN(b.x)]) == gen, bar);
            __builtin_amdgcn_fence(__ATOMIC_ACQUIRE, "agent");
            asm volatile("s_waitcnt vmcnt(0)" ::: "memory");
        }
    }
    __syncthreads();
}

struct Args { const float* in[24]; float* out; unsigned char* ws; };
__global__ void __launch_bounds__(NTHR, 2) fwd_megakernel(Args args) {
    extern __shared__ __attribute__((aligned(16))) unsigned char lds_raw[];
    cg::grid_group grid = cg::this_grid();
    LAS unsigned char* lds = (LAS unsigned char*)lds_raw;
    const int tid = threadIdx.x, G = gridDim.x;
    Ptrs P;
    P.x = args.in[0]; P.meta = args.in[1]; P.n1 = args.in[2]; P.w_in = args.in[3]; P.mu = args.in[4]; P.w0 = args.in[5]; P.w2 = args.in[6]; P.a0 = args.in[7]; P.a2 = args.in[8];
    P.g2 = args.in[9]; P.k_k = args.in[10]; P.k_a = args.in[11]; P.r_k = args.in[12]; P.gn_w = args.in[13]; P.gn_b = args.in[14]; P.q_g = args.in[15]; P.k_g = args.in[16];
    P.f_bias = args.in[17]; P.w_a = args.in[18]; P.w_b = args.in[19]; P.w_o = args.in[20]; P.n2 = args.in[21]; P.w_gu = args.in[22]; P.w_dn = args.in[23];
    P.out = args.out; P.ws = args.ws;
    unsigned char* ws = args.ws;
    typedef pg8::bf16_t pb;
    volatile LAS unsigned* bst = (volatile LAS unsigned*)(lds + LDS_BYTES - 64);
    if (tid < 2) bst[tid] = 0u;
    __syncthreads();
    const XcdBarrier xbar = xcd_barrier_post((unsigned*)(ws + WS_CTL) + 1024, bst);
    p0_prologue<false>(P, lds, tid, (int)blockIdx.x, G);
    xcd_barrier(xbar);
    if (G == 0x7fffffff) grid.sync();
    { pg8::Gemm g{(const pb*)(ws + WS_XN), (const pb*)(ws + WS_WIN), TP, N1, DM}; pg8::StaticOrder S; S.init(TP, N1, G, (int)blockIdx.x);
      pg8::Epi1 E{(pb*)(ws + WS_ZR), (pb*)(ws + WS_Q), (pb*)args.out};
      pg8::gemm_phase<pg8::Epi1, pg8::StaticOrder, true, true>(lds, g, S, E); }
    xcd_barrier(xbar);
    p2a_prep(P, tid);
    xcd_barrier(xbar);
#pragma unroll 1
    for (int j = 0; j < 3; ++j) {
      pg8::Gemm g{(const pb*)(ws + WS_U) + (size_t)TP * 128 * j, (const pb*)(ws + WS_WLORA) + 131072 * j, TP, 1024, j == 2 ? 256 : 128}; pg8::StaticOrder S; S.init(TP, 1024, G, (int)((blockIdx.x + 64u * j) % (unsigned)G));
      pg8::EpiLora E{P.w0, P.a0, (float*)(ws + WS_LW), (pb*)(ws + WS_LA), (pb*)(ws + WS_LG), j};
      pg8::gemm_phase<pg8::EpiLora, pg8::StaticOrder, true, true>(lds, g, S, E);
      __syncthreads(); }
    if (G == 256) { if (blockIdx.x >= 192) p2b_cumsum(P, (int)blockIdx.x - 192, lds, tid); }
    else for (int bh = blockIdx.x; bh < 64; bh += G) p2b_cumsum(P, bh, lds, tid);
    xcd_barrier(xbar);
    for (int bh = blockIdx.x; bh < 64; bh += G) p3_scanc(P, bh, lds, tid);
    unsigned* ctr = (unsigned*)(ws + WS_CTL); unsigned* adone = ctr + 8192; unsigned* efail = ctr + 8256;
    { LAS unsigned* slot = (LAS unsigned*)(lds + 2 * AT_BUF); unsigned nprev = 0u;
      for (;;) {
          if (tid == 0) { if (nprev) __hip_atomic_fetch_add(adone, nprev, __ATOMIC_RELAXED, __HIP_MEMORY_SCOPE_AGENT); *slot = atomicAdd(ctr, 1u); }
          __syncthreads();
          const unsigned u = *slot;
          __syncthreads();
          if (u >= 1024u) break;
          attn_unit(P, (int)(u & 63u), 15 - (int)(u >> 6), lds, tid);
          asm volatile("s_waitcnt vmcnt(0)" ::: "memory"); __syncthreads();
          nprev = 1u;
      } }
    if (G <= 64) p0_prologue<true>(P, lds, tid, (int)blockIdx.x, G);
    else if (blockIdx.x >= 64) p0_prologue<true>(P, lds, tid, (int)blockIdx.x - 64, G - 64);
    if (G == 256 && blockIdx.x >= 64) {
        LAS unsigned* okw = (LAS unsigned*)(lds + 2 * AT_BUF);
        __syncthreads();
        if (tid == 0) { unsigned ok = 0u;
            for (int it = 0; it < 4000; ++it) { if (__hip_atomic_load(adone, __ATOMIC_RELAXED, __HIP_MEMORY_SCOPE_AGENT) >= 1024u) { ok = 1u; break; } __builtin_amdgcn_s_sleep(16); }
            if (!ok) __hip_atomic_fetch_add(efail, 1u, __ATOMIC_RELAXED, __HIP_MEMORY_SCOPE_AGENT);
            *okw = ok; }
        __syncthreads();
        const unsigned ok = *okw;
        __syncthreads();
        if (ok) {
            __builtin_amdgcn_fence(__ATOMIC_ACQUIRE, "agent");
            pg8::Gemm g{(const pb*)(ws + WS_Q), (const pb*)(ws + WS_WB), TR, DM, 1024}; pg8::StaticOrder S; S.init(TR, DM, 192, (int)blockIdx.x - 64);
            pg8::EpiB E{(const pb*)args.out, (pb*)(ws + WS_K)};
            pg8::gemm_phase<pg8::EpiB, pg8::StaticOrder, true, true>(lds, g, S, E);
        }
    }
    xcd_barrier(xbar);
    if (G != 256 || __hip_atomic_load(efail, __ATOMIC_RELAXED, __HIP_MEMORY_SCOPE_AGENT) != 0u) {
      pg8::Gemm g{(const pb*)(ws + WS_Q), (const pb*)(ws + WS_WB), TR, DM, 1024}; pg8::StaticOrder S; S.init(TR, DM, G, (int)blockIdx.x);
      pg8::EpiB E{(const pb*)args.out, (pb*)(ws + WS_K)};
      pg8::gemm_phase<pg8::EpiB, pg8::StaticOrder, true, true>(lds, g, S, E);
      xcd_barrier(xbar); }
    { pg8::Gemm g{(const pb*)(ws + WS_YA), (const pb*)(ws + WS_WA), TR, DM, 1024}; pg8::StaticOrder S; S.init(TR, DM, G, (int)blockIdx.x);
      pg8::EpiA E{(const pb*)args.out, (const pb*)(ws + WS_K), (pb*)(ws + WS_MG)};
      pg8::gemm_phase<pg8::EpiA, pg8::StaticOrder, true, true>(lds, g, S, E); }
    xcd_barrier(xbar);
    { pg8::Gemm g{(const pb*)(ws + WS_MG), (const pb*)(ws + WS_WO), TR, DM, DM}; pg8::StaticOrder S; S.init(TR, DM, G, (int)blockIdx.x);
      pg8::EpiO E{P.x, P.n2, args.out, (pb*)(ws + WS_XN2), (float*)(ws + WS_CTL + CTL_SSQ)};
      pg8::gemm_phase<pg8::EpiO, pg8::StaticOrder, true, true>(lds, g, S, E); }
    xcd_barrier(xbar);
    { pg8::Gemm g{(const pb*)(ws + WS_XN2), (const pb*)(ws + WS_WGU), TR, NGU, DM}; pg8::StaticOrder S; S.init(TR, NGU, G, (int)blockIdx.x);
      pg8::EpiGU E{(const float*)(ws + WS_CTL + CTL_SSQ), (pb*)(ws + WS_ACT)};
      pg8::gemm_phase<pg8::EpiGU, pg8::StaticOrder, true, true>(lds, g, S, E); }
    xcd_barrier(xbar);
    { pg8::Gemm g{(const pb*)(ws + WS_ACT), (const pb*)(ws + WS_WDN), TR, DM, DFF}; pg8::StaticOrder S; S.init(TR, DM, G, (int)blockIdx.x);
      pg8::EpiDN E{args.out};
      pg8::gemm_phase<pg8::EpiDN, pg8::StaticOrder, true, true>(lds, g, S, E); }
}

extern "C" void kernel_launch(void* const* d_in, const int* in_sizes, int n_in, void* d_out, int out_size, void* d_ws, size_t ws_size, hipStream_t stream) {
    static int grid = 0;
    if (grid == 0) {
        if (n_in != 24 || out_size != TR * DM || ws_size < WS_END) { fprintf(stderr, "kernel_launch: unexpected shapes (n_in %d, out %d, ws %zu < %zu)\n", n_in, out_size, ws_size, (size_t)WS_END); grid = -1; return; }
        int dev = 0, cus = 0, per_cu = 0;
        hipGetDevice(&dev); hipDeviceGetAttribute(&cus, hipDeviceAttributeMultiprocessorCount, dev);
        if (hipFuncSetAttribute((const void*)fwd_megakernel, hipFuncAttributeMaxDynamicSharedMemorySize, LDS_BYTES) != hipSuccess) { fprintf(stderr, "kernel_launch: hipFuncSetAttribute failed\n"); grid = -1; return; }
        if (hipOccupancyMaxActiveBlocksPerMultiprocessor(&per_cu, (const void*)fwd_megakernel, NTHR, LDS_BYTES) != hipSuccess || per_cu < 1) { fprintf(stderr, "kernel_launch: occupancy query says %d\n", per_cu); per_cu = 1; }
        (void)hipGetLastError();
        grid = cus;
    }
    if (grid < 0) return;
    (void)hipMemsetAsync((char*)d_ws + WS_CTL, 0, CTL_ZERO_BYTES, stream);
    Args a{};
    for (int i = 0; i < 24; ++i) a.in[i] = (const float*)d_in[i];
    a.out = (float*)d_out; a.ws = (unsigned char*)d_ws;
    void* kargs[] = {&a};
    hipError_t e = hipLaunchCooperativeKernel((const void*)fwd_megakernel, dim3(grid), dim3(NTHR), kargs, LDS_BYTES, stream);
    if (e != hipSuccess) fprintf(stderr, "kernel_launch: cooperative launch failed: %s (grid %d)\n", hipGetErrorString(e), grid);
}
```

```cpp
#include <hip/hip_runtime.h>
#include <hip/hip_cooperative_groups.h>
#include <cstdio>
#include <cstdint>
namespace cg = cooperative_groups;
namespace pg8 {
#define PG8_LAS __attribute__((address_space(3)))
typedef unsigned short bf16_t;
typedef short bf16x8 __attribute__((ext_vector_type(8)));
typedef float f32x4 __attribute__((ext_vector_type(4)));
typedef unsigned u32x4 __attribute__((ext_vector_type(4)));
constexpr int BM = 256, BK = 64, HALF = 128, HTB = HALF * BK * 2  , STAGE_BYTES = 8 * HTB, NXCD = 8, WGM = 8;

__host__ __device__ __forceinline__ int lds_byte(int r, int c) { const int st = (r >> 4) * 2 + (c >> 5), rr = r & 15, cc = c & 31, ob = rr * 64 + cc * 2; return st * 1024 + (ob ^ (((ob >> 9) & 1) << 5)); }
__host__ __device__ __forceinline__ void stage_rc(int b, int& R, int& C) { const int st = b / 1024, sb = b % 1024, swz = sb ^ (((sb >> 9) & 1) << 5); R = (st >> 1) * 16 + swz / 64; C = (st & 1) * 32 + (swz % 64) / 2; }
__host__ __device__ __forceinline__ int perm32(int rho) { const int n = rho >> 4, i = rho & 15; return 8 * (i >> 2) + 4 * n + (i & 3); }

struct Unit { int pm, pn; };
struct Gemm { const bf16_t* A; const bf16_t* Bt; int M, N, K; };

struct StaticOrder {
    int nM, nN, nwg, G, c;
    __host__ __device__ void init(int M, int N, int G_, int c_) { nM = M / BM; nN = N / BM; nwg = nM * nN; G = G_; c = c_; }
    __host__ __device__ bool next(int i, Unit& u) const {
        const long L = (long)i * G + c; if (L >= nwg) return false;
        int wgid = (int)L; { const int q = nwg / NXCD, r = nwg % NXCD, xcd = wgid % NXCD, off = wgid / NXCD; wgid = (xcd < r ? xcd * (q + 1) : r * (q + 1) + (xcd - r) * q) + off; }
        const int nig = WGM * nN, gid = wgid / nig, fm = gid * WGM, gsz = (nM - fm) < WGM ? (nM - fm) : WGM;
        u.pm = fm + ((wgid % nig) % gsz); u.pn = (wgid % nig) / gsz; return true;
    }
    __device__ __forceinline__ void a_ready(const Unit&) const {}
    __device__ __forceinline__ void done(const Unit&) const {}
};

__device__ __forceinline__ unsigned cvt_pk_bf16(float lo, float hi) { unsigned r; asm volatile("v_cvt_pk_bf16_f32 %0, %1, %2" : "=v"(r) : "v"(lo), "v"(hi)); return r; }

template <class Epi, class Sched, bool ALIGN_EPI = false, bool SP2 = false>
__device__ __forceinline__ void gemm_phase(PG8_LAS unsigned char* lds, const Gemm g, const Sched& S, const Epi& E) {
    int tid_ = threadIdx.x; asm volatile("" : "+v"(tid_));
    const int tid = tid_, wid = __builtin_amdgcn_readfirstlane(tid >> 6), lane = tid & 63, wr = wid >> 2, wc = wid & 3, fr = lane & 15, fq = lane >> 4;
    const int K = g.K, nt = K / BK;
    unsigned voffA[2], voffB[2];
#pragma unroll
    for (int i = 0; i < 2; ++i) { int R, C; stage_rc(tid * 16 + i * 8192, R, C); const int Rb = Epi::PERM ? ((R & ~31) + perm32(R & 31)) : R;
        voffA[i] = (unsigned)(R * K + C) * 2u; voffB[i] = (unsigned)(Rb * K + C) * 2u; }
    const size_t kstep = (size_t)(BK * 2);
    const size_t hstep = (size_t)HALF * K * 2;
    const size_t tstep = 2 * hstep;
    const unsigned ldsw = (unsigned)wid * 1024u;
    const int aoff = lds_byte(wr * 64 + fr, fq * 8), boff = lds_byte(wc * 32 + fr, fq * 8);
#define PG8_SA(b, h) (((b) * 2 + (h)) * HTB)
#define PG8_SB(b, h) ((4 + (b) * 2 + (h)) * HTB)
#define PG8_STAGE(bufoff, gbase, voff) do { _Pragma("unroll") for (int _i = 0; _i < 2; ++_i) \
        __builtin_amdgcn_global_load_lds((const unsigned*)((const char*)(gbase) + (voff)[_i]), (PG8_LAS unsigned*)(lds + (bufoff) + ldsw + _i * 8192), 16, 0, 0); } while (0)
#define PG8_LDA(dst, b, h) do { _Pragma("unroll") for (int m = 0; m < 4; ++m) _Pragma("unroll") for (int k = 0; k < 2; ++k) dst[m][k] = *(const PG8_LAS bf16x8*)(lds + PG8_SA(b, h) + aoff + m * 2048 + k * 1024); } while (0)
#define PG8_LDB(dst, b, h) do { _Pragma("unroll") for (int n = 0; n < 2; ++n) _Pragma("unroll") for (int k = 0; k < 2; ++k) dst[n][k] = *(const PG8_LAS bf16x8*)(lds + PG8_SB(b, h) + boff + n * 2048 + k * 1024); } while (0)
#define PG8_MMA(ai, bj, At, Bt) do { __builtin_amdgcn_s_setprio(1); _Pragma("unroll") for (int m = 0; m < 4; ++m) _Pragma("unroll") for (int n = 0; n < 2; ++n) _Pragma("unroll") for (int k = 0; k < 2; ++k) \
        acc[ai][bj][m][n] = __builtin_amdgcn_mfma_f32_16x16x32_bf16(Bt[n][k], At[m][k], acc[ai][bj][m][n], 0, 0, 0); __builtin_amdgcn_s_setprio(0); } while (0)
#define PG8_WAIT_V(n) asm volatile("s_waitcnt vmcnt(" #n ")" ::: "memory")
#define PG8_WAIT_L(n) asm volatile("s_waitcnt lgkmcnt(" #n ")" ::: "memory")
#define PG8_BAR __builtin_amdgcn_s_barrier()
#define PG8_SCHED __builtin_amdgcn_sched_barrier(0)
    Unit cur, nxt; int ui = 0;
    if (!S.next(0, cur)) return;
    f32x4 acc[2][2][4][2];
#pragma unroll
    for (int a = 0; a < 2; ++a)
#pragma unroll
        for (int b = 0; b < 2; ++b)
#pragma unroll
            for (int m = 0; m < 4; ++m)
#pragma unroll
                for (int n = 0; n < 2; ++n) acc[a][b][m][n] = (f32x4){0.f, 0.f, 0.f, 0.f};
    bf16x8 At[4][2], B0[2][2], B1[2][2];
    const char* cA = (const char*)g.A + (size_t)cur.pm * tstep; const char* cB = (const char*)g.Bt + (size_t)cur.pn * tstep;
    S.a_ready(cur);
    if constexpr (SP2) {
        PG8_STAGE(PG8_SB(0, 0), cB, voffB); PG8_STAGE(PG8_SB(0, 1), cB + hstep, voffB); PG8_STAGE(PG8_SA(0, 0), cA, voffA); PG8_STAGE(PG8_SA(0, 1), cA + hstep, voffA);
        if (wr == 1) PG8_BAR;
        PG8_WAIT_V(2); PG8_BAR;
        PG8_STAGE(PG8_SB(1, 0), cB + kstep, voffB); PG8_STAGE(PG8_SA(1, 0), cA + kstep, voffA); PG8_STAGE(PG8_SB(1, 1), cB + hstep + kstep, voffB);
        PG8_WAIT_V(6); PG8_BAR;
    } else {
        PG8_STAGE(PG8_SB(0, 0), cB, voffB); PG8_STAGE(PG8_SA(0, 0), cA, voffA); PG8_STAGE(PG8_SB(0, 1), cB + hstep, voffB); PG8_STAGE(PG8_SA(0, 1), cA + hstep, voffA);
        if (wr == 1) PG8_BAR;
        PG8_WAIT_V(4); PG8_BAR;
        PG8_STAGE(PG8_SB(1, 0), cB + kstep, voffB); PG8_STAGE(PG8_SA(1, 0), cA + kstep, voffA); PG8_STAGE(PG8_SB(1, 1), cB + hstep + kstep, voffB);
        PG8_WAIT_V(6); PG8_BAR;
    }
    for (;;) {
        const bool has_next = S.next(ui + 1, nxt);
        const char* nA = has_next ? (const char*)g.A + (size_t)nxt.pm * tstep : cA; const char* nB = has_next ? (const char*)g.Bt + (size_t)nxt.pn * tstep : cB;
        for (int t = 0; t < nt; t += 2) {
            const bool last = (t == nt - 2);
            const char* a1 = cA + (size_t)(t + 1) * kstep;
            const char* a2 = last ? nA : cA + (size_t)(t + 2) * kstep; const char* b2 = last ? nB : cB + (size_t)(t + 2) * kstep;
            const char* a3 = a2 + kstep; const char* b3 = b2 + kstep;
            if (last && has_next) S.a_ready(nxt);
            if constexpr (SP2) {
            PG8_LDB(B0, 0, 0); PG8_LDB(B1, 0, 1); PG8_SCHED; PG8_LDA(At, 0, 0); PG8_STAGE(PG8_SA(1, 1), a1 + hstep, voffA);
            PG8_WAIT_V(8); PG8_WAIT_L(0); PG8_BAR; PG8_MMA(0, 0, At, B0); PG8_MMA(0, 1, At, B1); PG8_BAR; PG8_SCHED;
            PG8_LDA(At, 0, 1); PG8_STAGE(PG8_SB(0, 0), b2, voffB); PG8_STAGE(PG8_SB(0, 1), b2 + hstep, voffB); PG8_STAGE(PG8_SA(0, 0), a2, voffA);
            PG8_WAIT_V(8); PG8_WAIT_L(0); PG8_BAR; PG8_MMA(1, 0, At, B0); PG8_MMA(1, 1, At, B1); PG8_BAR; PG8_SCHED;
            PG8_LDB(B0, 1, 0); PG8_LDB(B1, 1, 1); PG8_SCHED; PG8_LDA(At, 1, 0); PG8_STAGE(PG8_SA(0, 1), a2 + hstep, voffA);
            PG8_WAIT_V(8); PG8_WAIT_L(0); PG8_BAR; PG8_MMA(0, 0, At, B0); PG8_MMA(0, 1, At, B1); PG8_BAR; PG8_SCHED;
            PG8_LDA(At, 1, 1); PG8_STAGE(PG8_SB(1, 0), b3, voffB); PG8_STAGE(PG8_SB(1, 1), b3 + hstep, voffB); PG8_STAGE(PG8_SA(1, 0), a3, voffA);
            PG8_WAIT_V(8); PG8_WAIT_L(0); PG8_BAR; PG8_MMA(1, 0, At, B0); PG8_MMA(1, 1, At, B1); PG8_BAR; PG8_SCHED;
            } else {
            PG8_LDB(B0, 0, 0); PG8_SCHED; PG8_LDA(At, 0, 0); PG8_STAGE(PG8_SA(1, 1), a1 + hstep, voffA);
            PG8_WAIT_L(8); PG8_BAR; PG8_WAIT_L(0); PG8_MMA(0, 0, At, B0); PG8_BAR; PG8_SCHED;
            PG8_LDB(B1, 0, 1); PG8_STAGE(PG8_SB(0, 0), b2, voffB);
            PG8_BAR; PG8_WAIT_L(0); PG8_MMA(0, 1, At, B1); PG8_BAR;
            PG8_LDA(At, 0, 1); PG8_STAGE(PG8_SA(0, 0), a2, voffA);
            PG8_BAR; PG8_WAIT_L(0); PG8_MMA(1, 0, At, B0); PG8_BAR; PG8_SCHED;
            PG8_STAGE(PG8_SB(0, 1), b2 + hstep, voffB);
            PG8_WAIT_V(6); PG8_BAR; PG8_MMA(1, 1, At, B1); PG8_BAR;
            PG8_LDB(B0, 1, 0); PG8_SCHED; PG8_LDA(At, 1, 0); PG8_STAGE(PG8_SA(0, 1), a2 + hstep, voffA);
            PG8_WAIT_L(8); PG8_BAR; PG8_WAIT_L(0); PG8_MMA(0, 0, At, B0); PG8_BAR; PG8_SCHED;
            PG8_LDB(B1, 1, 1); PG8_STAGE(PG8_SB(1, 0), b3, voffB);
            PG8_BAR; PG8_WAIT_L(0); PG8_MMA(0, 1, At, B1); PG8_BAR;
            PG8_LDA(At, 1, 1); PG8_STAGE(PG8_SA(1, 0), a3, voffA);
            PG8_BAR; PG8_WAIT_L(0); PG8_MMA(1, 0, At, B0); PG8_BAR; PG8_SCHED;
            PG8_STAGE(PG8_SB(1, 1), b3 + hstep, voffB);
            PG8_WAIT_V(6); PG8_BAR; PG8_MMA(1, 1, At, B1); PG8_BAR;
            }
        }
        if constexpr (ALIGN_EPI) { if (wr == 0) PG8_BAR; }
        if constexpr (!Epi::AFTER_DRAIN) { E(acc, cur, wr, wc, fr, fq); S.done(cur); }
        if (!has_next) break;
#pragma unroll
        for (int a = 0; a < 2; ++a)
#pragma unroll
            for (int b = 0; b < 2; ++b)
#pragma unroll
                for (int m = 0; m < 4; ++m)
#pragma unroll
                    for (int n = 0; n < 2; ++n) acc[a][b][m][n] = (f32x4){0.f, 0.f, 0.f, 0.f};
        cur = nxt; cA = nA; cB = nB; ++ui;
        if constexpr (ALIGN_EPI) { if (wr == 1) PG8_BAR; }
    }
    PG8_WAIT_V(0);
    if constexpr (!ALIGN_EPI) { if (wr == 0) PG8_BAR; }
    PG8_BAR;
    if constexpr (Epi::AFTER_DRAIN) { E.fused(acc, cur, wr, wc, fr, fq, lds, wid, lane); S.done(cur); }
#undef PG8_SA
#undef PG8_SB
#undef PG8_STAGE
#undef PG8_LDA
#undef PG8_LDB
#undef PG8_MMA
#undef PG8_WAIT_V
#undef PG8_WAIT_L
#undef PG8_BAR
#undef PG8_SCHED
}
}

#define GAS __attribute__((address_space(1)))
#define LAS __attribute__((address_space(3)))
typedef unsigned short bf16;
typedef unsigned v4u __attribute__((ext_vector_type(4)));
typedef unsigned v2u __attribute__((ext_vector_type(2)));
typedef float f4 __attribute__((ext_vector_type(4)));
typedef float f2 __attribute__((ext_vector_type(2)));
typedef short bf16x8 __attribute__((ext_vector_type(8)));
typedef float f32x16 __attribute__((ext_vector_type(16)));
#define LDS_WAIT() asm volatile("s_waitcnt lgkmcnt(0)" ::: "memory")
__device__ __forceinline__ unsigned f2bf(float f) { unsigned u = __builtin_bit_cast(unsigned, f); return (u + 0x7fffu + ((u >> 16) & 1u)) >> 16; }
__device__ __forceinline__ unsigned pk2(float lo, float hi) { unsigned r; asm("v_cvt_pk_bf16_f32 %0, %1, %2" : "=v"(r) : "v"(lo), "v"(hi)); return r; }
__device__ __forceinline__ float bf2f(unsigned h) { return __uint_as_float(h << 16); }
__device__ __forceinline__ float bflo(unsigned w) { return __uint_as_float(w << 16); }
__device__ __forceinline__ float bfhi(unsigned w) { return __uint_as_float(w & 0xffff0000u); }
__device__ __forceinline__ float sigmoidf_(float x) { return __builtin_amdgcn_rcpf(1.f + __builtin_amdgcn_exp2f(-1.4426950408889634f * x)); }
__device__ __forceinline__ float wave_sum(float v) {
#pragma unroll
    for (int o = 1; o < 64; o <<= 1) v += __shfl_xor(v, o);
    return v;
}

constexpr int NWAVES = 8, NTHR = 512;
constexpr int DM = 2048, TR = 16384, TV = 16400, TP = 16640, SEQ = 4096, NBATCH = 4, NH = 16;
constexpr int N1 = 10752, ZRW = 3584, NLORA = 3072, KLORA = 512, DFF = 5632, NGU = 11264, NIN = 10704;
constexpr int KEROWS = 4160;
constexpr float C2 = 0.125f * 1.4426950408889634f;
constexpr float LOG2E = 1.4426950408889634f;
constexpr size_t MiB = (size_t)1 << 20;
constexpr size_t WS_CTL = 0, CTL_ZERO_BYTES = 192 * 1024, CTL_SSQ = 65536;
constexpr size_t WS_WIN = 1 * MiB, WS_WLORA = 43 * MiB, WS_WA = 46 * MiB, WS_WB = 50 * MiB, WS_WO = 54 * MiB, WS_WGU = 62 * MiB, WS_WDN = 106 * MiB;
constexpr size_t WS_XN = 128 * MiB, WS_U = 128 * MiB, WS_YA = 128 * MiB, WS_LA = 160 * MiB;
constexpr size_t WS_ZR = 193 * MiB, WS_MG = 193 * MiB, WS_XN2 = 257 * MiB;
constexpr size_t WS_Q = 307 * MiB, QKV_STRIDE_B = (size_t)TP * 1024 * 2, WS_K = WS_Q + QKV_STRIDE_B, WS_V = WS_K + QKV_STRIDE_B;
constexpr size_t WS_LW = WS_V + QKV_STRIDE_B;
constexpr size_t WS_LG = WS_LW + (size_t)TP * 1024 * 4;
constexpr size_t WS_LOGF = 502 * MiB;
constexpr size_t WS_KE = WS_LOGF + 5 * MiB / 4;
constexpr size_t WS_T1 = WS_K;
constexpr size_t WS_ACT = 321 * MiB;
constexpr size_t WS_END = WS_KE + (size_t)64 * KEROWS * 32;
static_assert(WS_END <= 512 * MiB && WS_LG + (size_t)TP * 1024 * 2 <= WS_LOGF && WS_T1 + (size_t)TR * 2048 * 4 <= WS_LOGF && WS_ACT + (size_t)TR * DFF * 2 <= WS_LOGF && WS_XN2 + (size_t)TR * 2048 * 2 <= WS_ACT, "ws map");
constexpr int LDS_BYTES = 147456;

namespace pg8 {
#define EPI_PACK8(v0, v1) ((u32x4){cvt_pk_bf16((v0)[0], (v0)[1]), cvt_pk_bf16((v0)[2], (v0)[3]), cvt_pk_bf16((v1)[0], (v1)[1]), cvt_pk_bf16((v1)[2], (v1)[3])})
__device__ __forceinline__ float sigm(float x) { return __builtin_amdgcn_rcpf(1.f + __builtin_amdgcn_exp2f(-1.4426950408889634f * x)); }
struct Epi1 { static constexpr bool PERM = true, AFTER_DRAIN = false;
    bf16_t* ZR; bf16_t* Q; bf16_t* G; const float* q_g; const float* k_g;
    __device__ __forceinline__ void operator()(const f32x4 (&acc)[2][2][4][2], const Unit& u, int wr, int wc, int fr, int fq) const {
        const int pn = u.pn; bf16_t* base; int ldc, colt; bool sig = false;
        if (pn >= 14 && pn < 22) {
            const int t = (pn - 14) >> 2; bf16_t* b0 = Q + (size_t)t * ((size_t)16640 * 1024) + ((pn - 14) & 3) * 256 + 64 * wc + 8 * fq; const float* gp = (t ? k_g : q_g) + 8 * fq;
            const f32x4 g00 = *(const f32x4*)gp, g01 = *(const f32x4*)(gp + 4), g10 = *(const f32x4*)(gp + 32), g11 = *(const f32x4*)(gp + 36);
            const int row0 = u.pm * BM + wr * 64 + fr;
#pragma unroll
            for (int ai = 0; ai < 2; ++ai)
#pragma unroll
                for (int m = 0; m < 4; ++m) { float ss = 0.f;
#pragma unroll
                    for (int bj = 0; bj < 2; ++bj)
#pragma unroll
                        for (int n = 0; n < 2; ++n) { const f32x4 x = acc[ai][bj][m][n]; ss += (x[0] * x[0] + x[1] * x[1]) + (x[2] * x[2] + x[3] * x[3]); }
                    { auto r16 = __builtin_amdgcn_permlane16_swap(__float_as_uint(ss), __float_as_uint(ss), false, false); ss = __uint_as_float(r16[0]) + __uint_as_float(r16[1]);
                      auto r32 = __builtin_amdgcn_permlane32_swap(__float_as_uint(ss), __float_as_uint(ss), false, false); ss = __uint_as_float(r32[0]) + __uint_as_float(r32[1]); }
                    const float rs = (1.0f / sqrtf(ss * (1.0f / 64.0f) + 1e-6f)) * (t ? 1.0f : ::C2);
                    bf16_t* rowp = b0 + (size_t)(row0 + ai * HALF + m * 16) * 1024;
                    const f32x4 a0 = acc[ai][0][m][0] * rs * g00, a1 = acc[ai][0][m][1] * rs * g01, c0 = acc[ai][1][m][0] * rs * g10, c1 = acc[ai][1][m][1] * rs * g11;
                    *(u32x4*)rowp = EPI_PACK8(a0, a1); *(u32x4*)(rowp + 32) = EPI_PACK8(c0, c1); }
            return; }
        if (pn < 14) { base = ZR; ldc = 3584; colt = pn * 256; }
        else if (pn < 26) { const int t = (pn - 14) >> 2; base = Q + (size_t)t * ((size_t)16640 * 1024); ldc = 1024; colt = ((pn - 14) & 3) * 256; }
        else { if (u.pm >= 64) return; base = G; ldc = 4096; colt = (pn - 26) * 256; sig = true; }
        const int row0 = u.pm * BM + wr * 64 + fr, col0 = colt + wc * 32 + 8 * fq;
#pragma unroll
        for (int ai = 0; ai < 2; ++ai)
#pragma unroll
            for (int m = 0; m < 4; ++m) { bf16_t* rowp = base + (size_t)(row0 + ai * HALF + m * 16) * ldc + col0;
#pragma unroll
                for (int bj = 0; bj < 2; ++bj) { f32x4 v0 = acc[ai][bj][m][0], v1 = acc[ai][bj][m][1];
                    if (sig) {
#pragma unroll
                        for (int e = 0; e < 4; ++e) { v0[e] = sigm(v0[e]); v1[e] = sigm(v1[e]); } }
                    *(u32x4*)(rowp + bj * HALF) = EPI_PACK8(v0, v1); } }
    }
};
struct EpiLora { static constexpr bool PERM = true, AFTER_DRAIN = false;
    const float* w0; const float* a0; float* LW; bf16_t* LA; bf16_t* LG; int mode;
    __device__ __forceinline__ void operator()(const f32x4 (&acc)[2][2][4][2], const Unit& u, int wr, int wc, int fr, int fq) const {
        const int colt = u.pn * 256;
        const int row0 = u.pm * BM + wr * 64 + fr, col0 = colt + wc * 32 + 8 * fq;
        f32x4 bv[2][2];
#pragma unroll
        for (int bj = 0; bj < 2; ++bj)
#pragma unroll
            for (int n = 0; n < 2; ++n) bv[bj][n] = mode == 0 ? *(const f32x4*)(w0 + col0 + bj * HALF + 4 * n) : (mode == 1 ? *(const f32x4*)(a0 + col0 + bj * HALF + 4 * n) : (f32x4){0.f, 0.f, 0.f, 0.f});
#pragma unroll
        for (int ai = 0; ai < 2; ++ai)
#pragma unroll
            for (int m = 0; m < 4; ++m) { const size_t ro = (size_t)(row0 + ai * HALF + m * 16) * 1024 + col0;
#pragma unroll
                for (int bj = 0; bj < 2; ++bj) { f32x4 v0 = acc[ai][bj][m][0] + bv[bj][0], v1 = acc[ai][bj][m][1] + bv[bj][1];
                    if (mode == 0) {
#pragma unroll
                        for (int e = 0; e < 4; ++e) { v0[e] = __builtin_amdgcn_exp2f(-0.60653066f * 1.4426950408889634f * sigm(v0[e])); v1[e] = __builtin_amdgcn_exp2f(-0.60653066f * 1.4426950408889634f * sigm(v1[e])); }
                        *(f32x4*)(LW + ro + bj * HALF) = v0; *(f32x4*)(LW + ro + bj * HALF + 4) = v1;
                    } else if (mode == 1) {
#pragma unroll
                        for (int e = 0; e < 4; ++e) { v0[e] = sigm(v0[e]); v1[e] = sigm(v1[e]); }
                        *(u32x4*)(LA + ro + bj * HALF) = EPI_PACK8(v0, v1);
                    } else { *(u32x4*)(LG + ro + bj * HALF) = EPI_PACK8(v0, v1); } } }
    }
};
__device__ __forceinline__ void unpack8(const u32x4 w, float (&g)[8]) {
#pragma unroll
    for (int e = 0; e < 4; ++e) { g[2 * e] = __uint_as_float(w[e] << 16); g[2 * e + 1] = __uint_as_float(w[e] & 0xffff0000u); }
}
struct EpiB { static constexpr bool PERM = true, AFTER_DRAIN = false;
    const bf16_t* G; bf16_t* T1;
    __device__ __forceinline__ void operator()(const f32x4 (&acc)[2][2][4][2], const Unit& u, int wr, int wc, int fr, int fq) const {
        const int row0 = u.pm * BM + wr * 64 + fr, col0 = u.pn * BM + wc * 32 + 8 * fq;
#pragma unroll
        for (int ai = 0; ai < 2; ++ai)
#pragma unroll
            for (int m = 0; m < 4; ++m) { const size_t r = (size_t)(row0 + ai * HALF + m * 16);
#pragma unroll
                for (int bj = 0; bj < 2; ++bj) { const int c = col0 + bj * HALF; float g[8]; unpack8(*(const u32x4*)(G + r * 4096 + 2048 + c), g);
                    f32x4 v0 = acc[ai][bj][m][0], v1 = acc[ai][bj][m][1];
#pragma unroll
                    for (int e = 0; e < 4; ++e) { v0[e] *= g[e]; v1[e] *= g[4 + e]; }
                    *(u32x4*)(T1 + r * 2048 + c) = EPI_PACK8(v0, v1); } }
    }
};
struct EpiA { static constexpr bool PERM = true, AFTER_DRAIN = false;
    const bf16_t* G; const bf16_t* T1; bf16_t* MG;
    __device__ __forceinline__ void operator()(const f32x4 (&acc)[2][2][4][2], const Unit& u, int wr, int wc, int fr, int fq) const {
        const int row0 = u.pm * BM + wr * 64 + fr, col0 = u.pn * BM + wc * 32 + 8 * fq;
#pragma unroll
        for (int ai = 0; ai < 2; ++ai)
#pragma unroll
            for (int m = 0; m < 4; ++m) { const size_t r = (size_t)(row0 + ai * HALF + m * 16);
#pragma unroll
                for (int bj = 0; bj < 2; ++bj) { const int c = col0 + bj * HALF; float g[8], t[8]; unpack8(*(const u32x4*)(G + r * 4096 + c), g); unpack8(*(const u32x4*)(T1 + r * 2048 + c), t);
                    f32x4 v0 = acc[ai][bj][m][0], v1 = acc[ai][bj][m][1];
#pragma unroll
                    for (int e = 0; e < 4; ++e) { v0[e] = t[e] + v0[e] * g[e]; v1[e] = t[4 + e] + v1[e] * g[4 + e]; }
                    *(u32x4*)(MG + r * 2048 + c) = EPI_PACK8(v0, v1); } }
    }
};
struct EpiO { static constexpr bool PERM = true, AFTER_DRAIN = false;
    const float* x; const float* n2; float* H1; bf16_t* XN2; float* ssq;
    __device__ __forceinline__ void operator()(const f32x4 (&acc)[2][2][4][2], const Unit& u, int wr, int wc, int fr, int fq) const {
        const int row0 = u.pm * BM + wr * 64 + fr, col0 = u.pn * BM + wc * 32 + 8 * fq;
        f32x4 nv[2][2];
#pragma unroll
        for (int bj = 0; bj < 2; ++bj)
#pragma unroll
            for (int n = 0; n < 2; ++n) nv[bj][n] = *(const f32x4*)(n2 + col0 + bj * HALF + 4 * n);
#pragma unroll
        for (int ai = 0; ai < 2; ++ai)
#pragma unroll
            for (int m = 0; m < 4; ++m) { const size_t r = (size_t)(row0 + ai * HALF + m * 16); float sq = 0.f;
#pragma unroll
                for (int bj = 0; bj < 2; ++bj) { const int c = col0 + bj * HALF;
                    const f32x4 h0 = acc[ai][bj][m][0] + *(const f32x4*)(x + r * 2048 + c), h1 = acc[ai][bj][m][1] + *(const f32x4*)(x + r * 2048 + c + 4);
                    *(f32x4*)(H1 + r * 2048 + c) = h0; *(f32x4*)(H1 + r * 2048 + c + 4) = h1;
                    sq += (h0[0] * h0[0] + h0[1] * h0[1]) + (h0[2] * h0[2] + h0[3] * h0[3]) + (h1[0] * h1[0] + h1[1] * h1[1]) + (h1[2] * h1[2] + h1[3] * h1[3]);
                    const f32x4 a0 = h0 * nv[bj][0], a1 = h1 * nv[bj][1];
                    *(u32x4*)(XN2 + r * 2048 + c) = EPI_PACK8(a0, a1); }
                sq += __shfl_xor(sq, 16); sq += __shfl_xor(sq, 32);
                if (fq == 0) atomicAdd(ssq + r, sq); }
    }
};
struct EpiGU { static constexpr bool PERM = true, AFTER_DRAIN = false;
    const float* ssq; bf16_t* ACT;
    __device__ __forceinline__ void operator()(const f32x4 (&acc)[2][2][4][2], const Unit& u, int wr, int wc, int fr, int fq) const {
        const int row0 = u.pm * BM + wr * 64 + fr, col0 = u.pn * HALF + wc * 32 + 8 * fq;
#pragma unroll
        for (int ai = 0; ai < 2; ++ai)
#pragma unroll
            for (int m = 0; m < 4; ++m) { const size_t r = (size_t)(row0 + ai * HALF + m * 16);
                const float rstd = 1.0f / sqrtf(ssq[r] * (1.0f / 2048.0f) + 1e-6f);
                f32x4 o0, o1;
#pragma unroll
                for (int e = 0; e < 4; ++e) { const float g0 = acc[ai][0][m][0][e] * rstd, u0 = acc[ai][1][m][0][e] * rstd, g1 = acc[ai][0][m][1][e] * rstd, u1 = acc[ai][1][m][1][e] * rstd;
                    o0[e] = g0 * sigm(g0) * u0; o1[e] = g1 * sigm(g1) * u1; }
                *(u32x4*)(ACT + r * 5632 + col0) = EPI_PACK8(o0, o1); }
    }
};
struct EpiDN { static constexpr bool PERM = true, AFTER_DRAIN = false;
    float* out;
    __device__ __forceinline__ void operator()(const f32x4 (&acc)[2][2][4][2], const Unit& u, int wr, int wc, int fr, int fq) const {
        const int row0 = u.pm * BM + wr * 64 + fr, col0 = u.pn * BM + wc * 32 + 8 * fq;
#pragma unroll
        for (int ai = 0; ai < 2; ++ai)
#pragma unroll
            for (int m = 0; m < 4; ++m) { const size_t r = (size_t)(row0 + ai * HALF + m * 16);
#pragma unroll
                for (int bj = 0; bj < 2; ++bj) { float* p = out + r * 2048 + col0 + bj * HALF;
                    const f32x4 h0 = *(const f32x4*)p + acc[ai][bj][m][0], h1 = *(const f32x4*)(p + 4) + acc[ai][bj][m][1];
                    *(f32x4*)p = h0; *(f32x4*)(p + 4) = h1; } }
    }
};
}

__device__ __forceinline__ void transpose_item(const float* W, int N, int K, bf16* WT, int src_col0, int dst_row0, int ncols, int kb, int nb, LAS float* scr, int lane) {
    const int k0 = 64 * kb, n0 = 32 * nb, kr = lane >> 3, c4 = lane & 7; const bool nv = (n0 + 4 * c4) < ncols;
    const float* src = W + (size_t)(k0 + kr) * N + src_col0 + n0 + 4 * c4;
    f4 v[8];
#pragma unroll
    for (int i = 0; i < 8; ++i) v[i] = nv ? *(const f4*)(src + (size_t)(8 * i) * N) : (f4){0.f, 0.f, 0.f, 0.f};
#pragma unroll
    for (int i = 0; i < 8; ++i) { LAS float* d = scr + (8 * i + kr) * 33 + 4 * c4; d[0] = v[i].x; d[1] = v[i].y; d[2] = v[i].z; d[3] = v[i].w; }
    LDS_WAIT(); asm volatile("" ::: "memory");
    const int c = lane & 7;
#pragma unroll
    for (int j = 0; j < 4; ++j) { const int n = (lane >> 3) + 8 * j; const LAS float* s = scr + (8 * c) * 33 + n;
        v4u o; o.x = pk2(s[0 * 33], s[1 * 33]); o.y = pk2(s[2 * 33], s[3 * 33]); o.z = pk2(s[4 * 33], s[5 * 33]); o.w = pk2(s[6 * 33], s[7 * 33]);
        if (n0 + n < ncols) *(v4u*)(WT + (size_t)(dst_row0 + n0 + n) * K + k0 + 8 * c) = o; }
    LDS_WAIT(); asm volatile("" ::: "memory");
}

struct Ptrs {
    const float *x, *meta, *n1, *w_in, *mu, *w0, *w2, *a0, *a2, *g2, *k_k, *k_a, *r_k, *gn_w, *gn_b, *q_g, *k_g, *f_bias, *w_a, *w_b, *w_o, *n2, *w_gu, *w_dn;
    float* out; unsigned char* ws;
};

template <bool LATE> __device__ __forceinline__ void p0_prologue(const Ptrs& P, LAS unsigned char* lds, int tid, int bi, int nb) {
    const int lane = tid & 63, wave = tid >> 6;
    LAS float* scr = (LAS float*)(lds + wave * 16384);
    const int gw = bi * NWAVES + wave, NGW = nb * NWAVES;
    bf16* WIN = (bf16*)(P.ws + WS_WIN); bf16* WA = (bf16*)(P.ws + WS_WA); bf16* WB = (bf16*)(P.ws + WS_WB); bf16* WO = (bf16*)(P.ws + WS_WO);
    bf16* WGU = (bf16*)(P.ws + WS_WGU); bf16* WDN = (bf16*)(P.ws + WS_WDN); bf16* WL = (bf16*)(P.ws + WS_WLORA); bf16* XN = (bf16*)(P.ws + WS_XN);
    constexpr int I0 = 32 * 110, I1 = 32 * 1, I2 = 32 * 96, I3 = 32 * 128, I4 = 16 * 64, I5 = 16 * 64, I6 = 32 * 64, I7 = 88 * 128, I8 = 88 * 64;
    constexpr int NITEMS = I0 + I1 + I2 + I3 + I4 + I5 + I6 + I7 + I8;
    constexpr int NEARLY = I0 + I1 + I2 + I3;
    for (int it = (LATE ? NEARLY : 0) + gw; it < (LATE ? NITEMS : NEARLY); it += NGW) {
        int r = it;
        if (r < I0) { transpose_item(P.w_in, NIN, 2048, WIN, 0, 0, 3520, r / 110, r % 110, scr, lane); continue; } r -= I0;
        if (r < I1) { transpose_item(P.w_in, NIN, 2048, WIN, 6592, 3520, 16, r, 0, scr, lane); continue; } r -= I1;
        if (r < I2) { const int kb_ = r / 96, nb_ = r % 96; int dnb_ = nb_;
            if (nb_ < 64) { const int w_ = nb_ & 7; dnb_ = (nb_ & ~7) + 4 * (w_ & 1) + (w_ >> 1); }
            transpose_item(P.w_in, NIN, 2048, WIN, 3520 + 32 * nb_, 3584 + 32 * dnb_, 32, kb_, 0, scr, lane); continue; } r -= I2;
        if (r < I3) { transpose_item(P.w_in, NIN, 2048, WIN, 6608, 6656, 4096, r / 128, r % 128, scr, lane); continue; } r -= I3;
        if (r < I4) { transpose_item(P.w_a, 2048, 1024, WA, 0, 0, 2048, r / 64, r % 64, scr, lane); continue; } r -= I4;
        if (r < I5) { transpose_item(P.w_b, 2048, 1024, WB, 0, 0, 2048, r / 64, r % 64, scr, lane); continue; } r -= I5;
        if (r < I6) { transpose_item(P.w_o, 2048, 2048, WO, 0, 0, 2048, r / 64, r % 64, scr, lane); continue; } r -= I6;
        if (r < I7) { const int seg = r / 128, rem = r % 128, q = seg >> 1, bj = seg & 1;
            transpose_item(P.w_gu, NGU, 2048, WGU, bj * DFF + 128 * q, 256 * q + 128 * bj, 128, rem / 4, rem % 4, scr, lane); continue; } r -= I7;
        transpose_item(P.w_dn, 2048, DFF, WDN, 0, 0, 2048, r / 64, r % 64, scr, lane);
    }
    if (LATE) return;
    for (int t = gw; t < TP; t += NGW) {
        bf16* orow = XN + (size_t)t * DM;
        if (t >= TV) {
#pragma unroll
            for (int j = 0; j < 4; ++j) *(v4u*)(orow + 8 * (lane + 64 * j)) = (v4u){0u, 0u, 0u, 0u};
            continue; }
        const float* src = (t < TR) ? P.x + (size_t)t * DM : P.meta + (size_t)(t - TR) * DM;
        f4 v[8]; float ss = 0.f;
#pragma unroll
        for (int j = 0; j < 8; ++j) { v[j] = *(const f4*)(src + 4 * (lane + 64 * j)); ss += (v[j].x * v[j].x + v[j].y * v[j].y) + (v[j].z * v[j].z + v[j].w * v[j].w); }
        const float rstd = 1.0f / sqrtf(wave_sum(ss) * (1.0f / DM) + 1e-6f);
#pragma unroll
        for (int j = 0; j < 8; ++j) { const f4 g = *(const f4*)(P.n1 + 4 * (lane + 64 * j));
            *(v2u*)(orow + 4 * (lane + 64 * j)) = (v2u){pk2(v[j].x * rstd * g.x, v[j].y * rstd * g.y), pk2(v[j].z * rstd * g.z, v[j].w * rstd * g.w)}; }
    }
    const int gt = blockIdx.x * NTHR + tid, NGT = gridDim.x * NTHR;
    for (int idx = gt; idx < 16384; idx += NGT) { const int n = idx & 1023, c = idx >> 10; float v[8];
#pragma unroll
        for (int e = 0; e < 8; ++e) { const int k = 8 * c + e; v[e] = k < 96 ? P.w2[(size_t)k * 1024 + n] : 0.f; }
        *(v4u*)(WL + (size_t)n * 128 + 8 * c) = (v4u){pk2(v[0], v[1]), pk2(v[2], v[3]), pk2(v[4], v[5]), pk2(v[6], v[7])}; }
    for (int idx = gt; idx < 16384; idx += NGT) { const int n = idx & 1023, c = idx >> 10; float v[8];
#pragma unroll
        for (int e = 0; e < 8; ++e) { const int k = 8 * c + e; v[e] = k < 96 ? P.a2[(size_t)k * 1024 + n] : 0.f; }
        *(v4u*)(WL + 131072 + (size_t)n * 128 + 8 * c) = (v4u){pk2(v[0], v[1]), pk2(v[2], v[3]), pk2(v[4], v[5]), pk2(v[6], v[7])}; }
    for (int idx = gt; idx < 32768; idx += NGT) { const int n = idx & 1023, c = idx >> 10; float v[8];
#pragma unroll
        for (int e = 0; e < 8; ++e) { const int k = 8 * c + e; v[e] = P.g2[(size_t)k * 1024 + n]; }
        *(v4u*)(WL + 262144 + (size_t)n * 256 + 8 * c) = (v4u){pk2(v[0], v[1]), pk2(v[2], v[3]), pk2(v[4], v[5]), pk2(v[6], v[7])}; }
    for (int idx = gt; idx < 48 * 256; idx += NGT) *(v4u*)(WIN + (size_t)(3536 + idx / 256) * 2048 + 8 * (idx % 256)) = (v4u){0u, 0u, 0u, 0u};
}

__device__ __forceinline__ void p2a_prep(const Ptrs& P, int tid) {
    const int lane = tid & 63, wave = tid >> 6;
    const int gw = blockIdx.x * NWAVES + wave, NGW = gridDim.x * NWAVES;
    const bf16* ZR = (const bf16*)(P.ws + WS_ZR); bf16* U = (bf16*)(P.ws + WS_U); bf16* Q = (bf16*)(P.ws + WS_Q); bf16* K = (bf16*)(P.ws + WS_K);
    float* LOGF = (float*)(P.ws + WS_LOGF);
    for (int t = gw; t < TP; t += NGW) {
        bf16* u1 = U + (size_t)t * 128; bf16* u2 = U + (size_t)TP * 128 + (size_t)t * 128; bf16* u3 = U + (size_t)TP * 256 + (size_t)t * 256;
        if (t >= TV) { if (lane < 16) { *(v4u*)(u1 + 8 * lane) = (v4u){0u, 0u, 0u, 0u}; *(v4u*)(u2 + 8 * lane) = (v4u){0u, 0u, 0u, 0u}; } if (lane < 32) *(v4u*)(u3 + 8 * lane) = (v4u){0u, 0u, 0u, 0u}; continue; }
        const int tp = (t < TR) ? ((t & (SEQ - 1)) ? t - 1 : TV - 1) : (t > TR ? t - 1 : -1);
        const bf16* z = ZR + (size_t)t * ZRW; const bf16* zp = ZR + (size_t)(tp < 0 ? 0 : tp) * ZRW;
        if (lane < 56) {
            const int c8 = 8 * lane; float zc[8], zq[8], o[8];
            { const v4u a = *(const v4u*)(z + 3072 + c8); const v4u b_ = tp < 0 ? (v4u){0u, 0u, 0u, 0u} : *(const v4u*)(zp + 3072 + c8);
#pragma unroll
              for (int e = 0; e < 4; ++e) { zc[2 * e] = bflo(a[e]); zc[2 * e + 1] = bfhi(a[e]); zq[2 * e] = bflo(b_[e]); zq[2 * e + 1] = bfhi(b_[e]); } }
            const f4 m0 = *(const f4*)(P.mu + 3072 + c8), m1 = *(const f4*)(P.mu + 3072 + c8 + 4); const float mu8[8] = {m0.x, m0.y, m0.z, m0.w, m1.x, m1.y, m1.z, m1.w};
#pragma unroll
            for (int e = 0; e < 8; ++e) { const float zs = zc[e] + (zq[e] - zc[e]) * mu8[e];
                if (c8 < 96) { const float ex = __builtin_amdgcn_exp2f(2.f * LOG2E * zs); o[e] = 1.f - 2.f * __builtin_amdgcn_rcpf(ex + 1.f); }
                else if (c8 < 192) o[e] = zs;
                else o[e] = sigmoidf_(zs); }
            bf16* dst = c8 < 96 ? u1 + c8 : (c8 < 192 ? u2 + (c8 - 96) : u3 + (c8 - 192));
            *(v4u*)dst = (v4u){pk2(o[0], o[1]), pk2(o[2], o[3]), pk2(o[4], o[5]), pk2(o[6], o[7])};
        } else { bf16* dst = (lane < 60 ? u1 : u2) + 96 + 8 * (lane & 3); *(v4u*)dst = (v4u){0u, 0u, 0u, 0u}; }
        if (lane < 16) { const float xx = bf2f(z[3520 + lane]) + P.f_bias[lane];
            LOGF[(size_t)t * 16 + lane] = fminf(xx, 0.f) - log1pf(__expf(-fabsf(xx))); }
    }
}

__device__ __forceinline__ v4u split3(float x) { const unsigned h = f2bf(x); const float r1 = x - bf2f(h); const unsigned m = f2bf(r1); const float r2 = r1 - bf2f(m); const unsigned l = f2bf(r2);
    return (v4u){h | (m << 16), l, 0u, 0u}; }
__device__ __forceinline__ void p2b_cumsum(const Ptrs& P, int bh, LAS unsigned char* lds, int tid) {
    const int b = bh >> 4, h = bh & 15;
    const float* LOGF = (const float*)(P.ws + WS_LOGF); bf16* KE = (bf16*)(P.ws + WS_KE) + (size_t)bh * KEROWS * 16;
    LAS float* sc = (LAS float*)lds;
    float v[8]; float s = 0.f;
#pragma unroll
    for (int j = 0; j < 8; ++j) { s += LOGF[((size_t)b * SEQ + 8 * tid + j) * 16 + h]; v[j] = s; }
    sc[tid] = s; __syncthreads();
    for (int o = 1; o < NTHR; o <<= 1) { const float add = tid >= o ? sc[tid - o] : 0.f; __syncthreads(); sc[tid] += add; __syncthreads(); }
    const float off = sc[tid] - s;
#pragma unroll
    for (int j = 0; j < 8; ++j) { bf16* e = KE + (size_t)(64 + 8 * tid + j) * 16; *(v4u*)e = split3(-(off + v[j]) * LOG2E); *(v4u*)(e + 8) = (v4u){0u, 0u, 0u, 0u}; }
    if (tid < 64) { float kb = -30000.f;
        if (tid < 16) { float c15 = 0.f, cj = 0.f; for (int m = 0; m < 16; ++m) { const float lf = LOGF[(size_t)(TR + m) * 16 + h]; c15 += lf; if (m <= tid) cj += lf; } kb = (c15 - cj) * LOG2E; }
        bf16* e = KE + (size_t)tid * 16; *(v4u*)e = split3(kb); *(v4u*)(e + 8) = (v4u){0u, 0u, 0u, 0u}; }
    __syncthreads();
}

template <int CTRL> __device__ __forceinline__ float dppf(float v) { return __uint_as_float((unsigned)__builtin_amdgcn_update_dpp(0, (int)__float_as_uint(v), CTRL, 0xF, 0xF, true)); }
__device__ __forceinline__ float red8(float v) { v += dppf<0xB1>(v); v += dppf<0x4E>(v); v += dppf<0x141>(v); return v; }
__device__ __forceinline__ float red16(float v) { v += dppf<0xB1>(v); v += dppf<0x4E>(v); v += dppf<0x141>(v); v += dppf<0x140>(v); return v; }
constexpr int SC_T = 32, SC_ARR = SC_T * 64, SC_BUF = 6 * SC_ARR;
__device__ __forceinline__ void unpk8(const v4u w, float (&o)[8]) {
#pragma unroll
    for (int e = 0; e < 4; ++e) { o[2 * e] = bflo(w[e]); o[2 * e + 1] = bfhi(w[e]); }
}
#define SC_BAR() do { asm volatile("s_waitcnt lgkmcnt(0)" ::: "memory"); __builtin_amdgcn_s_barrier(); asm volatile("" ::: "memory"); } while (0)
constexpr int CS_XA = 0, CS_XB = 4608, CS_XK = 9216, CS_XR = 13824;
constexpr int CS_TB = 18432, CS_TK = 23552, CS_TV = 28672;
constexpr int CS_DEC = 33792, CS_WT = 41984, CS_GL = 42240;
constexpr int CS_GA = 46336, CS_GB = 48896, CS_GK = 51456;
constexpr int CS_SS = 54016, CS_RH = 63232, CS_UT = 72448, CS_YS = 77568;
constexpr int CS_FLG = 43008;
constexpr int CS_GSV = 137216;
constexpr int CS_RKS = 136960;
constexpr int CS_PRM = 134912;
constexpr int CS_OP2 = 101120;
constexpr int CS_LP = 85760, CS_LT = 98560;
__device__ __forceinline__ f32x16 mfma32(bf16x8 a, bf16x8 b, f32x16 c) { return __builtin_amdgcn_mfma_f32_32x32x16_bf16(a, b, c, 0, 0, 0); }
__device__ __forceinline__ int crow(int r, int hi) { return (r & 3) + 8 * (r >> 2) + 4 * hi; }
__device__ __forceinline__ void p3_scanc(const Ptrs& P, int bh, LAS unsigned char* lds, int tid) {
    const int lane = tid & 63, wid = __builtin_amdgcn_readfirstlane(tid >> 6), b = bh >> 4, h = bh & 15, n = lane & 31, hi = lane >> 5;
    const bf16* ZR = (const bf16*)(P.ws + WS_ZR); const float* LW = (const float*)(P.ws + WS_LW); const bf16* LA = (const bf16*)(P.ws + WS_LA); const bf16* LG = (const bf16*)(P.ws + WS_LG);
    bf16* YA = (bf16*)(P.ws + WS_YA);
    constexpr int NSTEP = 16 + SEQ, NCH = (NSTEP + 31) / 32;
    constexpr int OPB = 33792;
    const bool prep = wid >= 4;
    const int t2 = tid & 255, sl = t2 >> 3, cgp = t2 & 7, c0 = h * 64 + 8 * cgp, pw = (wid & 3), q8 = lane >> 3;
    { const int kind = tid >> 6, ch = tid & 63; const float* srcp = kind == 0 ? P.mu : kind == 1 ? P.mu + 1024 : kind == 2 ? P.mu + 2048 : kind == 3 ? P.k_k : kind == 4 ? P.k_a : kind == 5 ? P.r_k : kind == 6 ? P.gn_w : P.gn_b;
      ((LAS float*)(lds + CS_PRM))[kind * 64 + ch] = srcp[h * 64 + ch]; }
    if (tid == 0) *(LAS unsigned*)(lds + CS_FLG) = 0u;
#define CS_PRM8(kind, arr) float arr[8]; { const f4 p0_ = *(const LAS f4*)(lds + CS_PRM + (kind) * 256 + cgp * 32), p1_ = *(const LAS f4*)(lds + CS_PRM + (kind) * 256 + cgp * 32 + 16); \
        arr[0] = p0_.x; arr[1] = p0_.y; arr[2] = p0_.z; arr[3] = p0_.w; arr[4] = p1_.x; arr[5] = p1_.y; arr[6] = p1_.z; arr[7] = p1_.w; }
    for (int i = tid; i < 9216 / 4; i += NTHR) ((LAS unsigned*)(lds + CS_SS))[i] = 0u;
    SC_BAR();
    f32x16 ST = {};
    v4u q_zr, q_zk, q_zv, q_pr, q_pk, q_pv, q_la, q_g; f4 q_d0, q_d1;
#define CS_FETCH(chunk) do { const int s_ = (chunk) * 32 + sl; const v4u z0_ = (v4u){0u, 0u, 0u, 0u}; \
        q_zr = z0_; q_zk = z0_; q_zv = z0_; q_pr = z0_; q_pk = z0_; q_pv = z0_; q_la = z0_; q_g = z0_; q_d0 = (f4){1.f, 1.f, 1.f, 1.f}; q_d1 = q_d0; \
        if (s_ < NSTEP) { const int row_ = s_ < 16 ? TR + s_ : b * SEQ + s_ - 16; const int prow_ = s_ == 0 ? -1 : (s_ <= 16 ? TR + s_ - 1 : row_ - 1); \
            const bf16* z_ = ZR + (size_t)row_ * ZRW + c0; q_zr = *(const v4u*)z_; q_zk = *(const v4u*)(z_ + 1024); q_zv = *(const v4u*)(z_ + 2048); \
            if (prow_ >= 0) { const bf16* zp_ = ZR + (size_t)prow_ * ZRW + c0; q_pr = *(const v4u*)zp_; q_pk = *(const v4u*)(zp_ + 1024); q_pv = *(const v4u*)(zp_ + 2048); } \
            q_d0 = *(const f4*)(LW + (size_t)row_ * 1024 + c0); q_d1 = *(const f4*)(LW + (size_t)row_ * 1024 + c0 + 4); q_la = *(const v4u*)(LA + (size_t)row_ * 1024 + c0); \
            if (s_ >= 16) q_g = *(const v4u*)(LG + (size_t)row_ * 1024 + c0); } } while (0)
#define CS_W16(base, o, val) (*(LAS unsigned short*)(ob_ + (base) + (o)) = (unsigned short)(val))
#define CS_ALPHA_A(bufsel) do { LAS unsigned char* ob_ = lds + ((bufsel) ? CS_OP2 : 0); \
        *(LAS f4*)(lds + CS_DEC + sl * 256 + cgp * 32) = q_d0; *(LAS f4*)(lds + CS_DEC + sl * 256 + cgp * 32 + 16) = q_d1; \
        asm volatile("s_waitcnt lgkmcnt(0)" ::: "memory"); if (lane == 0) __hip_atomic_fetch_add((LAS unsigned*)(lds + CS_FLG), 1u, __ATOMIC_RELAXED, __HIP_MEMORY_SCOPE_WORKGROUP);     \
        float r_[8], k_[8], v_[8], a_[8], pr_[8], pk_[8], pv_[8]; CS_PRM8(0, mu_r) CS_PRM8(1, mu_k) CS_PRM8(2, mu_v) CS_PRM8(3, kkw) CS_PRM8(4, kaw) CS_PRM8(5, rkw) \
        unpk8(q_zr, r_); unpk8(q_zk, k_); unpk8(q_zv, v_); unpk8(q_pr, pr_); unpk8(q_pk, pk_); unpk8(q_pv, pv_); unpk8(q_la, a_); \
        *(LAS v4u*)(lds + CS_GSV + (bufsel) * 4096 + sl * 128 + cgp * 16) = q_g; \
        float kkv_[8], kf_[8], ss_ = 0.f, rk_ = 0.f; \
        _Pragma("unroll") for (int j = 0; j < 8; ++j) { r_[j] = r_[j] + (pr_[j] - r_[j]) * mu_r[j]; const float kk_ = k_[j] + (pk_[j] - k_[j]) * mu_k[j]; v_[j] = v_[j] + (pv_[j] - v_[j]) * mu_v[j]; \
            kkv_[j] = kk_ * kkw[j]; ss_ += kkv_[j] * kkv_[j]; kf_[j] = kk_ * (1.f + (a_[j] - 1.f) * kaw[j]); rk_ += r_[j] * kf_[j] * rkw[j]; } \
        ss_ = red8(ss_); rk_ = red8(rk_); \
        const float inv_ = __builtin_amdgcn_rcpf(fmaxf(__builtin_amdgcn_sqrtf(ss_), 1e-12f)); \
        float kn_[8], bv_[8]; \
        _Pragma("unroll") for (int j = 0; j < 8; ++j) { kn_[j] = kkv_[j] * inv_; bv_[j] = kn_[j] * a_[j]; } \
        const int ro_ = sl * 144 + cgp * 16; \
        *(LAS v4u*)(ob_ + CS_XR + ro_) = (v4u){pk2(r_[0], r_[1]), pk2(r_[2], r_[3]), pk2(r_[4], r_[5]), pk2(r_[6], r_[7])}; \
        *(LAS v4u*)(ob_ + CS_XK + ro_) = (v4u){pk2(kf_[0], kf_[1]), pk2(kf_[2], kf_[3]), pk2(kf_[4], kf_[5]), pk2(kf_[6], kf_[7])}; \
        *(LAS v4u*)(ob_ + CS_XA + ro_) = (v4u){pk2(kn_[0], kn_[1]), pk2(kn_[2], kn_[3]), pk2(kn_[4], kn_[5]), pk2(kn_[6], kn_[7])}; \
        *(LAS v4u*)(ob_ + CS_XB + ro_) = (v4u){pk2(bv_[0], bv_[1]), pk2(bv_[2], bv_[3]), pk2(bv_[4], bv_[5]), pk2(bv_[6], bv_[7])}; \
        { const v4u pv_2 = (v4u){pk2(v_[0], v_[1]), pk2(v_[2], v_[3]), pk2(v_[4], v_[5]), pk2(v_[6], v_[7])}; const int to_ = (8 * cgp) * 80 + sl * 2; \
          _Pragma("unroll") for (int e_ = 0; e_ < 4; ++e_) { CS_W16(CS_TV, to_ + (2 * e_) * 80, pv_2[e_] & 0xffffu); CS_W16(CS_TV, to_ + (2 * e_ + 1) * 80, pv_2[e_] >> 16); } } \
        if (cgp == 0) ((LAS float*)(lds + CS_RKS))[(bufsel) * 32 + sl] = rk_; \
        } while (0)
#define CS_ALPHA_B(bufsel) do { LAS unsigned char* ob_ = lds + ((bufsel) ? CS_OP2 : 0); \
        const int ro_ = sl * 144 + cgp * 16; \
        float xa_[8], xb_[8], xk_[8], xr_[8], wt_[8], wm_[8]; \
        { const f4 w0_ = *(const LAS f4*)(lds + CS_DEC + sl * 256 + cgp * 32), w1_ = *(const LAS f4*)(lds + CS_DEC + sl * 256 + cgp * 32 + 16); \
          const int slm_ = sl > 0 ? sl - 1 : 0; const f4 m0_ = *(const LAS f4*)(lds + CS_DEC + slm_ * 256 + cgp * 32), m1_ = *(const LAS f4*)(lds + CS_DEC + slm_ * 256 + cgp * 32 + 16); \
          wt_[0] = w0_.x; wt_[1] = w0_.y; wt_[2] = w0_.z; wt_[3] = w0_.w; wt_[4] = w1_.x; wt_[5] = w1_.y; wt_[6] = w1_.z; wt_[7] = w1_.w; \
          wm_[0] = m0_.x; wm_[1] = m0_.y; wm_[2] = m0_.z; wm_[3] = m0_.w; wm_[4] = m1_.x; wm_[5] = m1_.y; wm_[6] = m1_.z; wm_[7] = m1_.w; \
          if (sl == 0) { _Pragma("unroll") for (int j = 0; j < 8; ++j) wm_[j] = 1.f; } } \
        unpk8(*(const LAS v4u*)(ob_ + CS_XA + ro_), xa_); unpk8(*(const LAS v4u*)(ob_ + CS_XB + ro_), xb_); unpk8(*(const LAS v4u*)(ob_ + CS_XK + ro_), xk_); unpk8(*(const LAS v4u*)(ob_ + CS_XR + ro_), xr_); \
        _Pragma("unroll") for (int j = 0; j < 8; ++j) { const float W_ = wt_[j], iw_ = __builtin_amdgcn_rcpf(W_); \
            xa_[j] = -xa_[j] * wm_[j]; xb_[j] = xb_[j] * iw_; xk_[j] = xk_[j] * iw_; xr_[j] = xr_[j] * W_; } \
        const v4u pa_ = (v4u){pk2(xa_[0], xa_[1]), pk2(xa_[2], xa_[3]), pk2(xa_[4], xa_[5]), pk2(xa_[6], xa_[7])}, pb_ = (v4u){pk2(xb_[0], xb_[1]), pk2(xb_[2], xb_[3]), pk2(xb_[4], xb_[5]), pk2(xb_[6], xb_[7])}; \
        const v4u pk_2 = (v4u){pk2(xk_[0], xk_[1]), pk2(xk_[2], xk_[3]), pk2(xk_[4], xk_[5]), pk2(xk_[6], xk_[7])}, pr_2 = (v4u){pk2(xr_[0], xr_[1]), pk2(xr_[2], xr_[3]), pk2(xr_[4], xr_[5]), pk2(xr_[6], xr_[7])}; \
        *(LAS v4u*)(ob_ + CS_XA + ro_) = pa_; *(LAS v4u*)(ob_ + CS_XB + ro_) = pb_; *(LAS v4u*)(ob_ + CS_XK + ro_) = pk_2; *(LAS v4u*)(ob_ + CS_XR + ro_) = pr_2; \
        const int to_ = (8 * cgp) * 80 + sl * 2; \
        _Pragma("unroll") for (int e_ = 0; e_ < 4; ++e_) { CS_W16(CS_TB, to_ + (2 * e_) * 80, pb_[e_] & 0xffffu); CS_W16(CS_TB, to_ + (2 * e_ + 1) * 80, pb_[e_] >> 16); \
            CS_W16(CS_TK, to_ + (2 * e_) * 80, pk_2[e_] & 0xffffu); CS_W16(CS_TK, to_ + (2 * e_ + 1) * 80, pk_2[e_] >> 16); } \
        if (sl == 31) { *(LAS f4*)(lds + CS_WT + (bufsel) * 256 + cgp * 32) = (f4){wt_[0], wt_[1], wt_[2], wt_[3]}; *(LAS f4*)(lds + CS_WT + (bufsel) * 256 + cgp * 32 + 16) = (f4){wt_[4], wt_[5], wt_[6], wt_[7]}; } } while (0)
#define CS_POST(chunk) do { const int s_ = (chunk) * 32 + sl; const f4 y0_ = *(const LAS f4*)(lds + CS_YS + sl * 256 + cgp * 32), y1_ = *(const LAS f4*)(lds + CS_YS + sl * 256 + cgp * 32 + 16); \
        float y_[8] = {y0_.x, y0_.y, y0_.z, y0_.w, y1_.x, y1_.y, y1_.z, y1_.w}, g_[8], o_[8], vv_[8]; unpk8(*(const LAS v4u*)(lds + CS_GSV + ((chunk) & 1) * 4096 + sl * 128 + cgp * 16), g_); CS_PRM8(6, gnw) CS_PRM8(7, gnb) \
        { const LAS unsigned char* tv_ = lds + (((chunk) & 1) ? CS_OP2 : 0) + CS_TV + (8 * cgp) * 80 + sl * 2; _Pragma("unroll") for (int j = 0; j < 8; ++j) vv_[j] = bf2f(*(const LAS unsigned short*)(tv_ + j * 80)); } \
        const float rkp_ = ((const LAS float*)(lds + CS_RKS))[((chunk) & 1) * 32 + sl]; \
        float sum_ = 0.f; _Pragma("unroll") for (int j = 0; j < 8; ++j) sum_ += y_[j]; \
        const float mean_ = red8(sum_) * (1.f / 64.f); float m2_ = 0.f; \
        _Pragma("unroll") for (int j = 0; j < 8; ++j) { y_[j] -= mean_; m2_ += y_[j] * y_[j]; } \
        const float rstd_ = __builtin_amdgcn_rsqf(red8(m2_) * (1.f / 64.f) + 64e-5f); \
        _Pragma("unroll") for (int j = 0; j < 8; ++j) o_[j] = (y_[j] * rstd_ * gnw[j] + gnb[j] + rkp_ * vv_[j]) * g_[j]; \
        if (s_ >= 16 && s_ < NSTEP) *(v4u*)(YA + (size_t)(b * SEQ + s_ - 16) * 1024 + c0) = (v4u){pk2(o_[0], o_[1]), pk2(o_[2], o_[3]), pk2(o_[4], o_[5]), pk2(o_[6], o_[7])}; } while (0)
#define CS_KEEP_ROT() do { } while (0)
#define CS_CUMPROD(want) do { while (__hip_atomic_load((LAS unsigned*)(lds + CS_FLG), __ATOMIC_RELAXED, __HIP_MEMORY_SCOPE_WORKGROUP) < (want)) __builtin_amdgcn_s_sleep(1); \
        asm volatile("" ::: "memory"); LAS float* dcol_ = (LAS float*)(lds + CS_DEC) + lane; float d_[32]; \
        _Pragma("unroll") for (int t_ = 0; t_ < 32; ++t_) d_[t_] = dcol_[t_ * 64]; \
        _Pragma("unroll") for (int t_ = 1; t_ < 32; ++t_) d_[t_] *= d_[t_ - 1]; \
        _Pragma("unroll") for (int t_ = 1; t_ < 32; ++t_) dcol_[t_ * 64] = d_[t_]; } while (0)
    if (prep) { CS_FETCH(0); CS_ALPHA_A(0); CS_FETCH(1); }
    SC_BAR();
    if (wid == 1) CS_CUMPROD(4u);
    SC_BAR();
    if (prep) { CS_ALPHA_B(0); CS_KEEP_ROT(); }
    SC_BAR();
    for (int c = 0; c < NCH; ++c) {
        const LAS unsigned char* ob = lds + ((c & 1) ? CS_OP2 : 0);
        if (!prep) {
            const LAS unsigned char* As = ob + (wid < 2 ? CS_XA : CS_XR) + n * 144 + hi * 16; const LAS unsigned char* Bs = ob + ((wid & 1) ? CS_XK : CS_XB) + n * 144 + hi * 16;
            f32x16 g = {};
#pragma unroll
            for (int ks = 0; ks < 4; ++ks) g = mfma32(*(const LAS bf16x8*)(As + ks * 32), *(const LAS bf16x8*)(Bs + ks * 32), g);
            if (wid == 0) {
#pragma unroll
                for (int r = 0; r < 16; ++r) if (n >= crow(r, hi)) g[r] = 0.f;
                for (int i = 0; i < 5; ++i) {
                    LAS unsigned short* lp = (LAS unsigned short*)(lds + CS_LP + i * 2560);
#pragma unroll
                    for (int r = 0; r < 16; ++r) lp[crow(r, hi) * 40 + n] = (unsigned short)(pk2(g[r], 0.f) & 0xffffu);
                    if (i == 4) break;
                    const bf16x8 b0 = __builtin_bit_cast(bf16x8, (v4u){pk2(g[0], g[1]), pk2(g[2], g[3]), pk2(g[4], g[5]), pk2(g[6], g[7])});
                    const bf16x8 b1 = __builtin_bit_cast(bf16x8, (v4u){pk2(g[8], g[9]), pk2(g[10], g[11]), pk2(g[12], g[13]), pk2(g[14], g[15])});
                    asm volatile("s_waitcnt lgkmcnt(0)" ::: "memory");
                    const LAS unsigned char* Ap = lds + CS_LP + i * 2560 + n * 80 + hi * 8;
                    const v2u a00 = *(const LAS v2u*)Ap, a01 = *(const LAS v2u*)(Ap + 16), a10 = *(const LAS v2u*)(Ap + 32), a11 = *(const LAS v2u*)(Ap + 48);
                    asm volatile("s_waitcnt lgkmcnt(0)" ::: "memory");
                    f32x16 g2 = {}; g2 = mfma32(__builtin_bit_cast(bf16x8, (v4u){a00[0], a00[1], a01[0], a01[1]}), b0, g2); g2 = mfma32(__builtin_bit_cast(bf16x8, (v4u){a10[0], a10[1], a11[0], a11[1]}), b1, g2);
                    asm volatile("s_nop 15\n\ts_nop 7" : "+v"(g2)); g = g2;
                }
            } else {
                LAS unsigned short* G = (LAS unsigned short*)(lds + (wid == 1 ? CS_GA : (wid == 2 ? CS_GB : CS_GK)));
#pragma unroll
                for (int r = 0; r < 16; ++r) { const int t = crow(r, hi); const bool keep = wid == 1 ? (n < t) : (n <= t); G[t * 40 + n] = (unsigned short)(pk2(keep ? g[r] : 0.f, 0.f) & 0xffffu); }
            }
            if (wid == 1 && c + 1 < NCH) CS_CUMPROD(4u * (unsigned)(c + 2));
        } else {
            if (c >= 1) CS_POST(c - 1);
            if (c + 1 < NCH) { CS_ALPHA_A((c + 1) & 1); if (c + 2 < NCH) CS_FETCH(c + 2); }
        }
        SC_BAR();
        if (!prep) {
            const int vb = wid & 1;
            const LAS unsigned char* As = ob + (wid < 2 ? CS_XA : CS_XR) + n * 144 + hi * 16; const LAS unsigned char* Bs = lds + CS_SS + (32 * vb + n) * 144 + hi * 16;
            f32x16 acc = {};
#pragma unroll
            for (int ks = 0; ks < 4; ++ks) acc = mfma32(*(const LAS bf16x8*)(As + ks * 32), *(const LAS bf16x8*)(Bs + ks * 32), acc);
            if (wid < 2) {
                const LAS unsigned char* Ga = lds + CS_GA + n * 80 + hi * 16; const LAS unsigned char* Tv = ob + CS_TV + (32 * vb + n) * 80 + hi * 16;
#pragma unroll
                for (int js = 0; js < 2; ++js) acc = mfma32(*(const LAS bf16x8*)(Ga + js * 32), *(const LAS bf16x8*)(Tv + js * 32), acc);
                LAS unsigned char* xt = lds + CS_UT + (32 * vb + n) * 80; asm volatile("s_nop 15\n\ts_nop 7" : "+v"(acc));
#pragma unroll 1
                for (int i = 0; i < 5; ++i) {
                    const LAS unsigned char* Ap = lds + CS_LP + i * 2560 + n * 80 + hi * 8;
                    const v2u a00 = *(const LAS v2u*)Ap, a01 = *(const LAS v2u*)(Ap + 16), a10 = *(const LAS v2u*)(Ap + 32), a11 = *(const LAS v2u*)(Ap + 48);
                    const bf16x8 b0 = __builtin_bit_cast(bf16x8, (v4u){pk2(acc[0], acc[1]), pk2(acc[2], acc[3]), pk2(acc[4], acc[5]), pk2(acc[6], acc[7])});
                    const bf16x8 b1 = __builtin_bit_cast(bf16x8, (v4u){pk2(acc[8], acc[9]), pk2(acc[10], acc[11]), pk2(acc[12], acc[13]), pk2(acc[14], acc[15])});
                    asm volatile("s_waitcnt lgkmcnt(0)" ::: "memory");
                    acc = mfma32(__builtin_bit_cast(bf16x8, (v4u){a00[0], a00[1], a01[0], a01[1]}), b0, acc); acc = mfma32(__builtin_bit_cast(bf16x8, (v4u){a10[0], a10[1], a11[0], a11[1]}), b1, acc);
                    asm volatile("s_nop 15\n\ts_nop 7" : "+v"(acc));
                }
#pragma unroll
                for (int r4 = 0; r4 < 4; ++r4) *(LAS v2u*)(xt + (8 * r4 + 4 * hi) * 2) = (v2u){pk2(acc[4 * r4], acc[4 * r4 + 1]), pk2(acc[4 * r4 + 2], acc[4 * r4 + 3])};
            } else { LAS float* ys = (LAS float*)(lds + CS_YS) + 32 * vb + n; asm volatile("s_nop 15\n\ts_nop 7" : "+v"(acc));
#pragma unroll
                for (int r = 0; r < 16; ++r) ys[crow(r, hi) * 64] = acc[r]; }
        } else if (c + 1 < NCH) { CS_ALPHA_B((c + 1) & 1); CS_KEEP_ROT(); }
        else { CS_KEEP_ROT(); }
        SC_BAR();
        if (!prep) {
            const int vb = wid & 1, kb = wid >> 1;
            const LAS unsigned char* Ut = lds + CS_UT + (32 * vb + n) * 80 + hi * 16; const LAS unsigned char* Tv = ob + CS_TV + (32 * vb + n) * 80 + hi * 16;
            if (wid >= 2) {
                f32x16 acc; { const LAS float* ys0 = (const LAS float*)(lds + CS_YS) + 32 * vb + n;
#pragma unroll
                  for (int r = 0; r < 16; ++r) acc[r] = ys0[crow(r, hi) * 64]; }
                const LAS unsigned char* Gb = lds + CS_GB + n * 80 + hi * 16; const LAS unsigned char* Gk = lds + CS_GK + n * 80 + hi * 16;
#pragma unroll
                for (int js = 0; js < 2; ++js) { acc = mfma32(*(const LAS bf16x8*)(Gb + js * 32), *(const LAS bf16x8*)(Ut + js * 32), acc); acc = mfma32(*(const LAS bf16x8*)(Gk + js * 32), *(const LAS bf16x8*)(Tv + js * 32), acc); }
                LAS float* ys = (LAS float*)(lds + CS_YS) + 32 * vb + n;
#pragma unroll
                for (int r = 0; r < 16; ++r) ys[crow(r, hi) * 64] = acc[r];
            }
            const LAS unsigned char* Tb = ob + CS_TB + (32 * kb + n) * 80 + hi * 16; const LAS unsigned char* Tk = ob + CS_TK + (32 * kb + n) * 80 + hi * 16;
#pragma unroll
            for (int js = 0; js < 2; ++js) { ST = mfma32(*(const LAS bf16x8*)(Tb + js * 32), *(const LAS bf16x8*)(Ut + js * 32), ST); ST = mfma32(*(const LAS bf16x8*)(Tk + js * 32), *(const LAS bf16x8*)(Tv + js * 32), ST); }
            const LAS float* wt = (const LAS float*)(lds + CS_WT + (c & 1) * 256) + 32 * kb + 4 * hi; LAS unsigned char* ss = lds + CS_SS + (32 * vb + n) * 144 + (32 * kb + 4 * hi) * 2;
#pragma unroll
            for (int r4 = 0; r4 < 4; ++r4) { const f4 w = *(const LAS f4*)(wt + 8 * r4);
                ST[4 * r4] *= w.x; ST[4 * r4 + 1] *= w.y; ST[4 * r4 + 2] *= w.z; ST[4 * r4 + 3] *= w.w;
                *(LAS v2u*)(ss + 16 * r4) = (v2u){pk2(ST[4 * r4], ST[4 * r4 + 1]), pk2(ST[4 * r4 + 2], ST[4 * r4 + 3])}; }
        }
        SC_BAR();
    }
    if (prep) CS_POST(NCH - 1);
#undef CS_FETCH
#undef CS_ALPHA_A
#undef CS_ALPHA_B
#undef CS_W16
#undef CS_POST
#undef CS_KEEP_ROT
#undef CS_PRM8
#undef CS_CUMPROD
    __syncthreads();
}

constexpr int AT_KROW = 176, AT_VROW = 144, AT_KBYTES = 64 * AT_KROW, AT_BUF = AT_KBYTES + 64 * AT_VROW;
__device__ __forceinline__ void attn_unit(const Ptrs& P, int bh, int qb, LAS unsigned char* lds, int tid) {
    const int lane = tid & 63, wid = tid >> 6, n = lane & 31, hi = lane >> 5, b = bh >> 4, h = bh & 15;
    bf16* Qb = (bf16*)(P.ws + WS_Q); const bf16* Kb = (const bf16*)(P.ws + WS_K); const bf16* Vb = (const bf16*)(P.ws + WS_V);
    const bf16* KE = (const bf16*)(P.ws + WS_KE) + (size_t)bh * KEROWS * 16;
    const int NTL = 4 * (qb + 1) + 1; const size_t rowb = (size_t)b * SEQ; const int qrow = 256 * qb + 32 * wid + n, qw0 = 256 * qb + 32 * wid;
    bf16x8 qf[5];
    { const bf16* qp = Qb + (rowb + qrow) * 1024 + h * 64 + hi * 8;
#pragma unroll
      for (int d0 = 0; d0 < 4; ++d0) qf[d0] = *(const bf16x8*)(qp + d0 * 16);
      const short one = hi == 0 ? (short)0x3F80 : (short)0; qf[4] = (bf16x8){one, one, one, 0, 0, 0, 0, 0}; }
    const int sj = tid >> 3, sc = tid & 7;
    const int slot = ((sj >> 5) * 32) + (((sj >> 4) & 1) * 16) + (((sj >> 2) & 1) * 8) + (((sj >> 3) & 1) * 4) + (sj & 3);
    const int vgrp = (slot >> 3) ^ sc, vpos = vgrp * 16 + (slot & 7) * 2;
    const int ej = tid >> 1, eh = tid & 1;
    v4u kreg, vreg, ereg = (v4u){0u, 0u, 0u, 0u};
#define AT_LOAD(t) do { const bool val_ = (t) > 0 || sj < 16; const size_t row_ = (t) == 0 ? (size_t)(TR + (sj & 15)) : rowb + 64 * ((t) - 1) + sj; \
        kreg = *(const v4u*)(Kb + row_ * 1024 + h * 64 + sc * 8); vreg = *(const v4u*)(Vb + row_ * 1024 + h * 64 + sc * 8); \
        if (!val_) { kreg = (v4u){0u, 0u, 0u, 0u}; vreg = (v4u){0u, 0u, 0u, 0u}; } \
        if (tid < 128) ereg = *(const v4u*)(KE + (size_t)(64 * (t) + ej) * 16 + eh * 8); } while (0)
#define AT_STORE(bufo) do { LAS unsigned char* kt_ = lds + (bufo); LAS unsigned char* vt_ = kt_ + AT_KBYTES; \
        *(LAS v4u*)(kt_ + sj * AT_KROW + sc * 16) = kreg; if (tid < 128) *(LAS v4u*)(kt_ + ej * AT_KROW + 128 + eh * 16) = ereg; \
        _Pragma("unroll") for (int i_ = 0; i_ < 8; ++i_) { const unsigned w_ = vreg[i_ >> 1]; *(LAS unsigned short*)(vt_ + (8 * sc + i_) * AT_VROW + vpos) = (unsigned short)((i_ & 1) ? (w_ >> 16) : (w_ & 0xffffu)); } } while (0)
    AT_LOAD(0); AT_STORE(0); __syncthreads();
    f32x16 o0 = {}, o1 = {}; float m = -INFINITY, l = 0.f;
    for (int t = 0; t < NTL; ++t) {
        if (t + 1 < NTL) AT_LOAD(t + 1);
        const int bufo = (t & 1) * AT_BUF; const int key0 = 64 * (t - 1);
        const bool skip = t >= 1 && key0 > qw0 + 31;
        if (!skip) {
            const LAS unsigned char* Kt = lds + bufo; const LAS unsigned char* Vt = Kt + AT_KBYTES;
            f32x16 s0 = {}, s1 = {};
#pragma unroll
            for (int d0 = 0; d0 < 5; ++d0) { const int off = d0 < 4 ? d0 * 32 + hi * 16 : 128 + hi * 16;
                const bf16x8 k0 = *(const LAS bf16x8*)(Kt + n * AT_KROW + off), k1 = *(const LAS bf16x8*)(Kt + (32 + n) * AT_KROW + off);
                s0 = __builtin_amdgcn_mfma_f32_32x32x16_bf16(k0, qf[d0], s0, 0, 0, 0); s1 = __builtin_amdgcn_mfma_f32_32x32x16_bf16(k1, qf[d0], s1, 0, 0, 0); }
            if (t >= 1 && key0 + 63 > qw0) {
#pragma unroll
                for (int r = 0; r < 16; ++r) { const int key = key0 + crow(r, hi); if (key > qrow) s0[r] = -INFINITY; if (key + 32 > qrow) s1[r] = -INFINITY; } }
            float mx = fmaxf(s0[0], s1[0]);
#pragma unroll
            for (int r = 1; r < 16; ++r) mx = fmaxf(mx, fmaxf(s0[r], s1[r]));
            mx = fmaxf(mx, __shfl_xor(mx, 32));
            const float mn = fmaxf(m, mx), f = __builtin_amdgcn_exp2f(m - mn); m = mn; l *= f;
#pragma unroll
            for (int r = 0; r < 16; ++r) { o0[r] *= f; o1[r] *= f; }
            float ls = 0.f;
#pragma unroll
            for (int r = 0; r < 16; ++r) { s0[r] = __builtin_amdgcn_exp2f(s0[r] - mn); s1[r] = __builtin_amdgcn_exp2f(s1[r] - mn); ls += s0[r] + s1[r]; }
            l += ls;
            v4u pa[4];
#pragma unroll
            for (int e = 0; e < 4; ++e) { pa[0][e] = pk2(s0[2 * e], s0[2 * e + 1]); pa[1][e] = pk2(s0[8 + 2 * e], s0[8 + 2 * e + 1]); pa[2][e] = pk2(s1[2 * e], s1[2 * e + 1]); pa[3][e] = pk2(s1[8 + 2 * e], s1[8 + 2 * e + 1]); }
#pragma unroll
            for (int sl = 0; sl < 4; ++sl) { const int grp = sl * 2 + hi; const bf16x8 pb = __builtin_bit_cast(bf16x8, pa[sl]);
                const bf16x8 v0 = *(const LAS bf16x8*)(Vt + n * AT_VROW + ((grp ^ ((n >> 3) & 7)) * 16));
                const bf16x8 v1 = *(const LAS bf16x8*)(Vt + (32 + n) * AT_VROW + ((grp ^ (((32 + n) >> 3) & 7)) * 16));
                o0 = __builtin_amdgcn_mfma_f32_32x32x16_bf16(v0, pb, o0, 0, 0, 0); o1 = __builtin_amdgcn_mfma_f32_32x32x16_bf16(v1, pb, o1, 0, 0, 0); }
        }
        if (t + 1 < NTL) AT_STORE(((t + 1) & 1) * AT_BUF);
        __syncthreads();
    }
#undef AT_LOAD
#undef AT_STORE
    l += __shfl_xor(l, 32); const float inv = 1.0f / l;
    bf16* op = Qb + (rowb + qrow) * 1024 + h * 64;
#pragma unroll
    for (int r4 = 0; r4 < 4; ++r4) {
        __hip_atomic_store((unsigned long long*)(op + 8 * r4 + 4 * hi), (unsigned long long)pk2(o0[4 * r4] * inv, o0[4 * r4 + 1] * inv) | ((unsigned long long)pk2(o0[4 * r4 + 2] * inv, o0[4 * r4 + 3] * inv) << 32), __ATOMIC_RELAXED, __HIP_MEMORY_SCOPE_AGENT);
        __hip_atomic_store((unsigned long long*)(op + 32 + 8 * r4 + 4 * hi), (unsigned long long)pk2(o1[4 * r4] * inv, o1[4 * r4 + 1] * inv) | ((unsigned long long)pk2(o1[4 * r4 + 2] * inv, o1[4 * r4 + 3] * inv) << 32), __ATOMIC_RELAXED, __HIP_MEMORY_SCOPE_AGENT); }
}

#define XB_TMO      128
#define XB_XCNT(j)  (256  + 64 * (j))
#define XB_XSUB(j)  (1280 + 64 * (j))
#define XB_XGEN(j)  (2304 + 64 * (j))
#define XB_TOP      3328
#define XB_TOPGEN   3392
#define XCD_BAR_WORDS 3456
#define XB_SPIN_CAP (1u << 18)

__device__ __forceinline__ unsigned xb_ld(unsigned* p)              { return __hip_atomic_load(p, __ATOMIC_RELAXED, __HIP_MEMORY_SCOPE_AGENT); }
__device__ __forceinline__ unsigned xb_add(unsigned* p, unsigned v) { return __hip_atomic_fetch_add(p, v, __ATOMIC_RELAXED, __HIP_MEMORY_SCOPE_AGENT); }
__device__ __forceinline__ unsigned xb_xcc_id() { return (unsigned)__builtin_amdgcn_s_getreg((3 << 11) | 20) & 0xFu; }
#define XB_SPIN(cond, bar) do { unsigned _sp = 0; while (cond) { __builtin_amdgcn_s_sleep(1); \
    if ((++_sp & 255u) == 0u) { if (xb_ld(&(bar)[XB_TMO])) break; if (_sp > XB_SPIN_CAP) { atomicAdd(&(bar)[XB_TMO], 1u); break; } } } } while (0)

struct XcdBarrier {
    unsigned* bar; unsigned x;
    volatile LAS unsigned* st;
};

__device__ __forceinline__ XcdBarrier xcd_barrier_post(unsigned* bar, volatile LAS unsigned* st) {
    XcdBarrier b; b.bar = bar; b.x = xb_xcc_id(); b.st = st;
    if (threadIdx.x == 0) (void)xb_add(&bar[XB_XCNT(b.x)], 1u);
    return b;
}
__device__ __forceinline__ void xcd_barrier_complete(unsigned* bar, unsigned x, unsigned& nloc, unsigned& nx) {
    const unsigned G = gridDim.x * gridDim.y * gridDim.z;
    unsigned sum, cnt, mine, sp = 0u;
    for (;;) {
        sum = 0u; cnt = 0u; mine = 0u;
#pragma unroll
        for (unsigned j = 0; j < 16; ++j) { const unsigned c = xb_ld(&bar[XB_XCNT(j)]); sum += c; cnt += (c > 0u) ? 1u : 0u; mine = (j == x) ? c : mine; }
        if (sum == G) break;
        __builtin_amdgcn_s_sleep(1);
        if ((++sp & 255u) == 0u) { if (xb_ld(&bar[XB_TMO])) break; if (sp > XB_SPIN_CAP) { atomicAdd(&bar[XB_TMO], 1u); break; } }
    }
    nloc = mine > 0u ? mine : 1u; nx = cnt > 0u ? cnt : 1u;
}

__device__ __forceinline__ void xcd_barrier(const XcdBarrier& b) {
    asm volatile("s_waitcnt vmcnt(0)" ::: "memory");
    __syncthreads();
    if (threadIdx.x == 0) {
        unsigned* bar = b.bar;
        __builtin_amdgcn_s_waitcnt(0);
        unsigned nloc = b.st[0], nx = b.st[1];
        if (nloc == 0u) { xcd_barrier_complete(bar, b.x, nloc, nx); b.st[0] = nloc; b.st[1] = nx; }
        const unsigned old = xb_add(&bar[XB_XSUB(b.x)], 1u);
        const unsigned gen = old / nloc;
        if (old + 1u == (gen + 1u) * nloc) {
            __builtin_amdgcn_fence(__ATOMIC_RELEASE, "agent");
            asm volatile("s_waitcnt vmcnt(0)" ::: "memory");
            const unsigned og = xb_add(&bar[XB_TOP], 1u);
            const unsigned tg = og / nx;
            if (og + 1u == (tg + 1u) * nx) xb_add(&bar[XB_TOPGEN], 1u);
            else XB_SPIN(xb_ld(&bar[XB_TOPGEN]) == tg, bar);
            __builtin_amdgcn_fence(__ATOMIC_ACQUIRE, "agent");
            xb_add(&bar[XB_XGEN(b.x)], 1u);
            asm volatile("s_waitcnt vmcnt(0)" ::: "memory");
        } else {
            XB_SPIN(xb_ld(&bar[XB_XGEN(b.x)]) == gen, bar);
            __builtin_amdgcn_fence(__ATOMIC_ACQUIRE, "agent");
            asm volatile("s_waitcnt vmcnt(0)" ::: "memory");
        }
    }
    __syncthreads();
}

struct Args { const float* in[24]; float* out; unsigned char* ws; };
__global__ void __launch_bounds__(NTHR, 2) fwd_megakernel(Args args) {
    extern __shared__ __attribute__((aligned(16))) unsigned char lds_raw[];
    cg::grid_group grid = cg::this_grid();
    LAS unsigned char* lds = (LAS unsigned char*)lds_raw;
    const int tid = threadIdx.x, G = gridDim.x;
    Ptrs P;
    P.x = args.in[0]; P.meta = args.in[1]; P.n1 = args.in[2]; P.w_in = args.in[3]; P.mu = args.in[4]; P.w0 = args.in[5]; P.w2 = args.in[6]; P.a0 = args.in[7]; P.a2 = args.in[8];
    P.g2 = args.in[9]; P.k_k = args.in[10]; P.k_a = args.in[11]; P.r_k = args.in[12]; P.gn_w = args.in[13]; P.gn_b = args.in[14]; P.q_g = args.in[15]; P.k_g = args.in[16];
    P.f_bias = args.in[17]; P.w_a = args.in[18]; P.w_b = args.in[19]; P.w_o = args.in[20]; P.n2 = args.in[21]; P.w_gu = args.in[22]; P.w_dn = args.in[23];
    P.out = args.out; P.ws = args.ws;
    unsigned char* ws = args.ws;
    typedef pg8::bf16_t pb;
    volatile LAS unsigned* bst = (volatile LAS unsigned*)(lds + LDS_BYTES - 64);
    if (tid < 2) bst[tid] = 0u;
    __syncthreads();
    const XcdBarrier xbar = xcd_barrier_post((unsigned*)(ws + WS_CTL) + 1024, bst);
    p0_prologue<false>(P, lds, tid, (int)blockIdx.x, G);
    xcd_barrier(xbar);
    if (G == 0x7fffffff) grid.sync();
    { pg8::Gemm g{(const pb*)(ws + WS_XN), (const pb*)(ws + WS_WIN), TP, N1, DM}; pg8::StaticOrder S; S.init(TP, N1, G, (int)blockIdx.x);
      pg8::Epi1 E{(pb*)(ws + WS_ZR), (pb*)(ws + WS_Q), (pb*)args.out, P.q_g, P.k_g};
      pg8::gemm_phase<pg8::Epi1, pg8::StaticOrder, true, true>(lds, g, S, E); }
    xcd_barrier(xbar);
    p2a_prep(P, tid);
    xcd_barrier(xbar);
#pragma unroll 1
    for (int j = 0; j < 3; ++j) {
      pg8::Gemm g{(const pb*)(ws + WS_U) + (size_t)TP * 128 * j, (const pb*)(ws + WS_WLORA) + 131072 * j, TP, 1024, j == 2 ? 256 : 128}; pg8::StaticOrder S; S.init(TP, 1024, G, (int)((blockIdx.x + 64u * j) % (unsigned)G));
      pg8::EpiLora E{P.w0, P.a0, (float*)(ws + WS_LW), (pb*)(ws + WS_LA), (pb*)(ws + WS_LG), j};
      pg8::gemm_phase<pg8::EpiLora, pg8::StaticOrder, true, true>(lds, g, S, E);
      __syncthreads(); }
    if (G == 256) { if (blockIdx.x >= 192) p2b_cumsum(P, (int)blockIdx.x - 192, lds, tid); }
    else for (int bh = blockIdx.x; bh < 64; bh += G) p2b_cumsum(P, bh, lds, tid);
    xcd_barrier(xbar);
    for (int bh = blockIdx.x; bh < 64; bh += G) p3_scanc(P, bh, lds, tid);
    unsigned* ctr = (unsigned*)(ws + WS_CTL); unsigned* adone = ctr + 8192; unsigned* efail = ctr + 8256;
    { LAS unsigned* slot = (LAS unsigned*)(lds + 2 * AT_BUF); unsigned nprev = 0u;
      for (;;) {
          if (tid == 0) { if (nprev) __hip_atomic_fetch_add(adone, nprev, __ATOMIC_RELAXED, __HIP_MEMORY_SCOPE_AGENT); *slot = atomicAdd(ctr, 1u); }
          __syncthreads();
          const unsigned u = *slot;
          __syncthreads();
          if (u >= 1024u) break;
          attn_unit(P, (int)(u & 63u), 15 - (int)(u >> 6), lds, tid);
          asm volatile("s_waitcnt vmcnt(0)" ::: "memory"); __syncthreads();
          nprev = 1u;
      } }
    if (G <= 64) p0_prologue<true>(P, lds, tid, (int)blockIdx.x, G);
    else if (blockIdx.x >= 64) p0_prologue<true>(P, lds, tid, (int)blockIdx.x - 64, G - 64);
    if (G == 256 && blockIdx.x >= 64) {
        LAS unsigned* okw = (LAS unsigned*)(lds + 2 * AT_BUF);
        __syncthreads();
        if (tid == 0) { unsigned ok = 0u;
            for (int it = 0; it < 4000; ++it) { if (__hip_atomic_load(adone, __ATOMIC_RELAXED, __HIP_MEMORY_SCOPE_AGENT) >= 1024u) { ok = 1u; break; } __builtin_amdgcn_s_sleep(16); }
            if (!ok) __hip_atomic_fetch_add(efail, 1u, __ATOMIC_RELAXED, __HIP_MEMORY_SCOPE_AGENT);
            *okw = ok; }
        __syncthreads();
        const unsigned ok = *okw;
        __syncthreads();
        if (ok) {
            __builtin_amdgcn_fence(__ATOMIC_ACQUIRE, "agent");
            pg8::Gemm g{(const pb*)(ws + WS_Q), (const pb*)(ws + WS_WB), TR, DM, 1024}; pg8::StaticOrder S; S.init(TR, DM, 192, (int)blockIdx.x - 64);
            pg8::EpiB E{(const pb*)args.out, (pb*)(ws + WS_K)};
            pg8::gemm_phase<pg8::EpiB, pg8::StaticOrder, true, true>(lds, g, S, E);
        }
    }
    xcd_barrier(xbar);
    if (G != 256 || __hip_atomic_load(efail, __ATOMIC_RELAXED, __HIP_MEMORY_SCOPE_AGENT) != 0u) {
      pg8::Gemm g{(const pb*)(ws + WS_Q), (const pb*)(ws + WS_WB), TR, DM, 1024}; pg8::StaticOrder S; S.init(TR, DM, G, (int)blockIdx.x);
      pg8::EpiB E{(const pb*)args.out, (pb*)(ws + WS_K)};
      pg8::gemm_phase<pg8::EpiB, pg8::StaticOrder, true, true>(lds, g, S, E);
      xcd_barrier(xbar); }
    { pg8::Gemm g{(const pb*)(ws + WS_YA), (const pb*)(ws + WS_WA), TR, DM, 1024}; pg8::StaticOrder S; S.init(TR, DM, G, (int)blockIdx.x);
      pg8::EpiA E{(const pb*)args.out, (const pb*)(ws + WS_K), (pb*)(ws + WS_MG)};
      pg8::gemm_phase<pg8::EpiA, pg8::StaticOrder, true, true>(lds, g, S, E); }
    xcd_barrier(xbar);
    { pg8::Gemm g{(const pb*)(ws + WS_MG), (const pb*)(ws + WS_WO), TR, DM, DM}; pg8::StaticOrder S; S.init(TR, DM, G, (int)blockIdx.x);
      pg8::EpiO E{P.x, P.n2, args.out, (pb*)(ws + WS_XN2), (float*)(ws + WS_CTL + CTL_SSQ)};
      pg8::gemm_phase<pg8::EpiO, pg8::StaticOrder, true, true>(lds, g, S, E); }
    xcd_barrier(xbar);
    { pg8::Gemm g{(const pb*)(ws + WS_XN2), (const pb*)(ws + WS_WGU), TR, NGU, DM}; pg8::StaticOrder S; S.init(TR, NGU, G, (int)blockIdx.x);
      pg8::EpiGU E{(const float*)(ws + WS_CTL + CTL_SSQ), (pb*)(ws + WS_ACT)};
      pg8::gemm_phase<pg8::EpiGU, pg8::StaticOrder, true, true>(lds, g, S, E); }
    xcd_barrier(xbar);
    { pg8::Gemm g{(const pb*)(ws + WS_ACT), (const pb*)(ws + WS_WDN), TR, DM, DFF}; pg8::StaticOrder S; S.init(TR, DM, G, (int)blockIdx.x);
      pg8::EpiDN E{args.out};
      pg8::gemm_phase<pg8::EpiDN, pg8::StaticOrder, true, true>(lds, g, S, E); }
}

extern "C" void kernel_launch(void* const* d_in, const int* in_sizes, int n_in, void* d_out, int out_size, void* d_ws, size_t ws_size, hipStream_t stream) {
    static int grid = 0;
    if (grid == 0) {
        if (n_in != 24 || out_size != TR * DM || ws_size < WS_END) { fprintf(stderr, "kernel_launch: unexpected shapes (n_in %d, out %d, ws %zu < %zu)\n", n_in, out_size, ws_size, (size_t)WS_END); grid = -1; return; }
        int dev = 0, cus = 0, per_cu = 0;
        hipGetDevice(&dev); hipDeviceGetAttribute(&cus, hipDeviceAttributeMultiprocessorCount, dev);
        if (hipFuncSetAttribute((const void*)fwd_megakernel, hipFuncAttributeMaxDynamicSharedMemorySize, LDS_BYTES) != hipSuccess) { fprintf(stderr, "kernel_launch: hipFuncSetAttribute failed\n"); grid = -1; return; }
        if (hipOccupancyMaxActiveBlocksPerMultiprocessor(&per_cu, (const void*)fwd_megakernel, NTHR, LDS_BYTES) != hipSuccess || per_cu < 1) { fprintf(stderr, "kernel_launch: occupancy query says %d\n", per_cu); per_cu = 1; }
        (void)hipGetLastError();
        grid = cus;
    }
    if (grid < 0) return;
    (void)hipMemsetAsync((char*)d_ws + WS_CTL, 0, CTL_ZERO_BYTES, stream);
    Args a{};
    for (int i = 0; i < 24; ++i) a.in[i] = (const float*)d_in[i];
    a.out = (float*)d_out; a.ws = (unsigned char*)d_ws;
    void* kargs[] = {&a};
    hipError_t e = hipLaunchCooperativeKernel((const void*)fwd_megakernel, dim3(grid), dim3(NTHR), kargs, LDS_BYTES, stream);
    if (e != hipSuccess) fprintf(stderr, "kernel_launch: cooperative launch failed: %s (grid %d)\n", hipGetErrorString(e), grid);
}
```

```cpp
#include <hip/hip_runtime.h>
#include <hip/hip_cooperative_groups.h>
#include <cstdio>
#include <cstdint>
namespace cg = cooperative_groups;
namespace pg8 {
#define PG8_LAS __attribute__((address_space(3)))
typedef unsigned short bf16_t;
typedef short bf16x8 __attribute__((ext_vector_type(8)));
typedef float f32x4 __attribute__((ext_vector_type(4)));
typedef unsigned u32x4 __attribute__((ext_vector_type(4)));
constexpr int BM = 256, BK = 64, HALF = 128, HTB = HALF * BK * 2  , STAGE_BYTES = 8 * HTB, NXCD = 8, WGM = 8;

__host__ __device__ __forceinline__ int lds_byte(int r, int c) { const int st = (r >> 4) * 2 + (c >> 5), rr = r & 15, cc = c & 31, ob = rr * 64 + cc * 2; return st * 1024 + (ob ^ (((ob >> 9) & 1) << 5)); }
__host__ __device__ __forceinline__ void stage_rc(int b, int& R, int& C) { const int st = b / 1024, sb = b % 1024, swz = sb ^ (((sb >> 9) & 1) << 5); R = (st >> 1) * 16 + swz / 64; C = (st & 1) * 32 + (swz % 64) / 2; }
__host__ __device__ __forceinline__ int perm32(int rho) { const int n = rho >> 4, i = rho & 15; return 8 * (i >> 2) + 4 * n + (i & 3); }

struct Unit { int pm, pn; };
struct Gemm { const bf16_t* A; const bf16_t* Bt; int M, N, K; };

struct StaticOrder {
    int nM, nN, nwg, G, c;
    __host__ __device__ void init(int M, int N, int G_, int c_) { nM = M / BM; nN = N / BM; nwg = nM * nN; G = G_; c = c_; }
    __host__ __device__ bool next(int i, Unit& u) const {
        const long L = (long)i * G + c; if (L >= nwg) return false;
        int wgid = (int)L; { const int q = nwg / NXCD, r = nwg % NXCD, xcd = wgid % NXCD, off = wgid / NXCD; wgid = (xcd < r ? xcd * (q + 1) : r * (q + 1) + (xcd - r) * q) + off; }
        const int nig = WGM * nN, gid = wgid / nig, fm = gid * WGM, gsz = (nM - fm) < WGM ? (nM - fm) : WGM;
        u.pm = fm + ((wgid % nig) % gsz); u.pn = (wgid % nig) / gsz; return true;
    }
    __device__ __forceinline__ void a_ready(const Unit&) const {}
    __device__ __forceinline__ void done(const Unit&) const {}
};

__device__ __forceinline__ unsigned cvt_pk_bf16(float lo, float hi) { unsigned r; asm volatile("v_cvt_pk_bf16_f32 %0, %1, %2" : "=v"(r) : "v"(lo), "v"(hi)); return r; }

template <class Epi, class Sched, bool ALIGN_EPI = false, bool SP2 = false>
__device__ __forceinline__ void gemm_phase(PG8_LAS unsigned char* lds, const Gemm g, const Sched& S, const Epi& E) {
    int tid_ = threadIdx.x; asm volatile("" : "+v"(tid_));
    const int tid = tid_, wid = __builtin_amdgcn_readfirstlane(tid >> 6), lane = tid & 63, wr = wid >> 2, wc = wid & 3, fr = lane & 15, fq = lane >> 4;
    const int K = g.K, nt = K / BK;
    unsigned voffA[2], voffB[2];
#pragma unroll
    for (int i = 0; i < 2; ++i) { int R, C; stage_rc(tid * 16 + i * 8192, R, C); const int Rb = Epi::PERM ? ((R & ~31) + perm32(R & 31)) : R;
        voffA[i] = (unsigned)(R * K + C) * 2u; voffB[i] = (unsigned)(Rb * K + C) * 2u; }
    const size_t kstep = (size_t)(BK * 2);
    const size_t hstep = (size_t)HALF * K * 2;
    const size_t tstep = 2 * hstep;
    const unsigned ldsw = (unsigned)wid * 1024u;
    const int aoff = lds_byte(wr * 64 + fr, fq * 8), boff = lds_byte(wc * 32 + fr, fq * 8);
#define PG8_SA(b, h) (((b) * 2 + (h)) * HTB)
#define PG8_SB(b, h) ((4 + (b) * 2 + (h)) * HTB)
#define PG8_STAGE(bufoff, gbase, voff) do { _Pragma("unroll") for (int _i = 0; _i < 2; ++_i) \
        __builtin_amdgcn_global_load_lds((const unsigned*)((const char*)(gbase) + (voff)[_i]), (PG8_LAS unsigned*)(lds + (bufoff) + ldsw + _i * 8192), 16, 0, 0); } while (0)
#define PG8_LDA(dst, b, h) do { _Pragma("unroll") for (int m = 0; m < 4; ++m) _Pragma("unroll") for (int k = 0; k < 2; ++k) dst[m][k] = *(const PG8_LAS bf16x8*)(lds + PG8_SA(b, h) + aoff + m * 2048 + k * 1024); } while (0)
#define PG8_LDB(dst, b, h) do { _Pragma("unroll") for (int n = 0; n < 2; ++n) _Pragma("unroll") for (int k = 0; k < 2; ++k) dst[n][k] = *(const PG8_LAS bf16x8*)(lds + PG8_SB(b, h) + boff + n * 2048 + k * 1024); } while (0)
#define PG8_MMA(ai, bj, At, Bt) do { __builtin_amdgcn_s_setprio(1); _Pragma("unroll") for (int m = 0; m < 4; ++m) _Pragma("unroll") for (int n = 0; n < 2; ++n) _Pragma("unroll") for (int k = 0; k < 2; ++k) \
        acc[ai][bj][m][n] = __builtin_amdgcn_mfma_f32_16x16x32_bf16(Bt[n][k], At[m][k], acc[ai][bj][m][n], 0, 0, 0); __builtin_amdgcn_s_setprio(0); } while (0)
#define PG8_WAIT_V(n) asm volatile("s_waitcnt vmcnt(" #n ")" ::: "memory")
#define PG8_WAIT_L(n) asm volatile("s_waitcnt lgkmcnt(" #n ")" ::: "memory")
#define PG8_BAR __builtin_amdgcn_s_barrier()
#define PG8_SCHED __builtin_amdgcn_sched_barrier(0)
    Unit cur, nxt; int ui = 0;
    if (!S.next(0, cur)) return;
    f32x4 acc[2][2][4][2];
#pragma unroll
    for (int a = 0; a < 2; ++a)
#pragma unroll
        for (int b = 0; b < 2; ++b)
#pragma unroll
            for (int m = 0; m < 4; ++m)
#pragma unroll
                for (int n = 0; n < 2; ++n) acc[a][b][m][n] = (f32x4){0.f, 0.f, 0.f, 0.f};
    bf16x8 At[4][2], B0[2][2], B1[2][2];
    const char* cA = (const char*)g.A + (size_t)cur.pm * tstep; const char* cB = (const char*)g.Bt + (size_t)cur.pn * tstep;
    S.a_ready(cur);
    if constexpr (SP2) {
        PG8_STAGE(PG8_SB(0, 0), cB, voffB); PG8_STAGE(PG8_SB(0, 1), cB + hstep, voffB); PG8_STAGE(PG8_SA(0, 0), cA, voffA); PG8_STAGE(PG8_SA(0, 1), cA + hstep, voffA);
        if (wr == 1) PG8_BAR;
        PG8_WAIT_V(2); PG8_BAR;
        PG8_STAGE(PG8_SB(1, 0), cB + kstep, voffB); PG8_STAGE(PG8_SA(1, 0), cA + kstep, voffA); PG8_STAGE(PG8_SB(1, 1), cB + hstep + kstep, voffB);
        PG8_WAIT_V(6); PG8_BAR;
    } else {
        PG8_STAGE(PG8_SB(0, 0), cB, voffB); PG8_STAGE(PG8_SA(0, 0), cA, voffA); PG8_STAGE(PG8_SB(0, 1), cB + hstep, voffB); PG8_STAGE(PG8_SA(0, 1), cA + hstep, voffA);
        if (wr == 1) PG8_BAR;
        PG8_WAIT_V(4); PG8_BAR;
        PG8_STAGE(PG8_SB(1, 0), cB + kstep, voffB); PG8_STAGE(PG8_SA(1, 0), cA + kstep, voffA); PG8_STAGE(PG8_SB(1, 1), cB + hstep + kstep, voffB);
        PG8_WAIT_V(6); PG8_BAR;
    }
    for (;;) {
        const bool has_next = S.next(ui + 1, nxt);
        const char* nA = has_next ? (const char*)g.A + (size_t)nxt.pm * tstep : cA; const char* nB = has_next ? (const char*)g.Bt + (size_t)nxt.pn * tstep : cB;
        for (int t = 0; t < nt; t += 2) {
            const bool last = (t == nt - 2);
            const char* a1 = cA + (size_t)(t + 1) * kstep;
            const char* a2 = last ? nA : cA + (size_t)(t + 2) * kstep; const char* b2 = last ? nB : cB + (size_t)(t + 2) * kstep;
            const char* a3 = a2 + kstep; const char* b3 = b2 + kstep;
            if (last && has_next) S.a_ready(nxt);
            if constexpr (SP2) {
            PG8_LDB(B0, 0, 0); PG8_LDB(B1, 0, 1); PG8_SCHED; PG8_LDA(At, 0, 0); PG8_STAGE(PG8_SA(1, 1), a1 + hstep, voffA);
            PG8_WAIT_V(8); PG8_WAIT_L(0); PG8_BAR; PG8_MMA(0, 0, At, B0); PG8_MMA(0, 1, At, B1); PG8_BAR; PG8_SCHED;
            PG8_LDA(At, 0, 1); PG8_STAGE(PG8_SB(0, 0), b2, voffB); PG8_STAGE(PG8_SB(0, 1), b2 + hstep, voffB); PG8_STAGE(PG8_SA(0, 0), a2, voffA);
            PG8_WAIT_V(8); PG8_WAIT_L(0); PG8_BAR; PG8_MMA(1, 0, At, B0); PG8_MMA(1, 1, At, B1); PG8_BAR; PG8_SCHED;
            PG8_LDB(B0, 1, 0); PG8_LDB(B1, 1, 1); PG8_SCHED; PG8_LDA(At, 1, 0); PG8_STAGE(PG8_SA(0, 1), a2 + hstep, voffA);
            PG8_WAIT_V(8); PG8_WAIT_L(0); PG8_BAR; PG8_MMA(0, 0, At, B0); PG8_MMA(0, 1, At, B1); PG8_BAR; PG8_SCHED;
            PG8_LDA(At, 1, 1); PG8_STAGE(PG8_SB(1, 0), b3, voffB); PG8_STAGE(PG8_SB(1, 1), b3 + hstep, voffB); PG8_STAGE(PG8_SA(1, 0), a3, voffA);
            PG8_WAIT_V(8); PG8_WAIT_L(0); PG8_BAR; PG8_MMA(1, 0, At, B0); PG8_MMA(1, 1, At, B1); PG8_BAR; PG8_SCHED;
            } else {
            PG8_LDB(B0, 0, 0); PG8_SCHED; PG8_LDA(At, 0, 0); PG8_STAGE(PG8_SA(1, 1), a1 + hstep, voffA);
            PG8_WAIT_L(8); PG8_BAR; PG8_WAIT_L(0); PG8_MMA(0, 0, At, B0); PG8_BAR; PG8_SCHED;
            PG8_LDB(B1, 0, 1); PG8_STAGE(PG8_SB(0, 0), b2, voffB);
            PG8_BAR; PG8_WAIT_L(0); PG8_MMA(0, 1, At, B1); PG8_BAR;
            PG8_LDA(At, 0, 1); PG8_STAGE(PG8_SA(0, 0), a2, voffA);
            PG8_BAR; PG8_WAIT_L(0); PG8_MMA(1, 0, At, B0); PG8_BAR; PG8_SCHED;
            PG8_STAGE(PG8_SB(0, 1), b2 + hstep, voffB);
            PG8_WAIT_V(6); PG8_BAR; PG8_MMA(1, 1, At, B1); PG8_BAR;
            PG8_LDB(B0, 1, 0); PG8_SCHED; PG8_LDA(At, 1, 0); PG8_STAGE(PG8_SA(0, 1), a2 + hstep, voffA);
            PG8_WAIT_L(8); PG8_BAR; PG8_WAIT_L(0); PG8_MMA(0, 0, At, B0); PG8_BAR; PG8_SCHED;
            PG8_LDB(B1, 1, 1); PG8_STAGE(PG8_SB(1, 0), b3, voffB);
            PG8_BAR; PG8_WAIT_L(0); PG8_MMA(0, 1, At, B1); PG8_BAR;
            PG8_LDA(At, 1, 1); PG8_STAGE(PG8_SA(1, 0), a3, voffA);
            PG8_BAR; PG8_WAIT_L(0); PG8_MMA(1, 0, At, B0); PG8_BAR; PG8_SCHED;
            PG8_STAGE(PG8_SB(1, 1), b3 + hstep, voffB);
            PG8_WAIT_V(6); PG8_BAR; PG8_MMA(1, 1, At, B1); PG8_BAR;
            }
        }
        if constexpr (ALIGN_EPI) { if (wr == 0) PG8_BAR; }
        if constexpr (!Epi::AFTER_DRAIN) { E(acc, cur, wr, wc, fr, fq); S.done(cur); }
        if (!has_next) break;
#pragma unroll
        for (int a = 0; a < 2; ++a)
#pragma unroll
            for (int b = 0; b < 2; ++b)
#pragma unroll
                for (int m = 0; m < 4; ++m)
#pragma unroll
                    for (int n = 0; n < 2; ++n) acc[a][b][m][n] = (f32x4){0.f, 0.f, 0.f, 0.f};
        cur = nxt; cA = nA; cB = nB; ++ui;
        if constexpr (ALIGN_EPI) { if (wr == 1) PG8_BAR; }
    }
    PG8_WAIT_V(0);
    if constexpr (!ALIGN_EPI) { if (wr == 0) PG8_BAR; }
    PG8_BAR;
    if constexpr (Epi::AFTER_DRAIN) { E.fused(acc, cur, wr, wc, fr, fq, lds, wid, lane); S.done(cur); }
#undef PG8_SA
#undef PG8_SB
#undef PG8_STAGE
#undef PG8_LDA
#undef PG8_LDB
#undef PG8_MMA
#undef PG8_WAIT_V
#undef PG8_WAIT_L
#undef PG8_BAR
#undef PG8_SCHED
}
}

#define GAS __attribute__((address_space(1)))
#define LAS __attribute__((address_space(3)))
typedef unsigned short bf16;
typedef unsigned v4u __attribute__((ext_vector_type(4)));
typedef unsigned v2u __attribute__((ext_vector_type(2)));
typedef float f4 __attribute__((ext_vector_type(4)));
typedef float f2 __attribute__((ext_vector_type(2)));
typedef short bf16x8 __attribute__((ext_vector_type(8)));
typedef float f32x16 __attribute__((ext_vector_type(16)));
#define LDS_WAIT() asm volatile("s_waitcnt lgkmcnt(0)" ::: "memory")
__device__ __forceinline__ unsigned f2bf(float f) { unsigned u = __builtin_bit_cast(unsigned, f); return (u + 0x7fffu + ((u >> 16) & 1u)) >> 16; }
__device__ __forceinline__ unsigned pk2(float lo, float hi) { unsigned r; asm("v_cvt_pk_bf16_f32 %0, %1, %2" : "=v"(r) : "v"(lo), "v"(hi)); return r; }
__device__ __forceinline__ float bf2f(unsigned h) { return __uint_as_float(h << 16); }
__device__ __forceinline__ float bflo(unsigned w) { return __uint_as_float(w << 16); }
__device__ __forceinline__ float bfhi(unsigned w) { return __uint_as_float(w & 0xffff0000u); }
__device__ __forceinline__ float sigmoidf_(float x) { return __builtin_amdgcn_rcpf(1.f + __builtin_amdgcn_exp2f(-1.4426950408889634f * x)); }
__device__ __forceinline__ float wave_sum(float v) {
#pragma unroll
    for (int o = 1; o < 64; o <<= 1) v += __shfl_xor(v, o);
    return v;
}

constexpr int NWAVES = 8, NTHR = 512;
constexpr int DM = 2048, TR = 16384, TV = 16400, TP = 16640, SEQ = 4096, NBATCH = 4, NH = 16;
constexpr int N1 = 10752, ZRW = 3584, NLORA = 3072, KLORA = 512, DFF = 5632, NGU = 11264, NIN = 10704;
constexpr int KEROWS = 4160;
constexpr float C2 = 0.125f * 1.4426950408889634f;
constexpr float LOG2E = 1.4426950408889634f;
constexpr size_t MiB = (size_t)1 << 20;
constexpr size_t WS_CTL = 0, CTL_ZERO_BYTES = 192 * 1024, CTL_SSQ = 65536;
constexpr size_t WS_WIN = 1 * MiB, WS_WLORA = 43 * MiB, WS_WA = 46 * MiB, WS_WB = 50 * MiB, WS_WO = 54 * MiB, WS_WGU = 62 * MiB, WS_WDN = 106 * MiB;
constexpr size_t WS_XN = 128 * MiB, WS_U = 128 * MiB, WS_YA = 128 * MiB, WS_LA = 160 * MiB;
constexpr size_t WS_ZR = 193 * MiB, WS_MG = 193 * MiB, WS_XN2 = 257 * MiB;
constexpr size_t WS_Q = 307 * MiB, QKV_STRIDE_B = (size_t)TP * 1024 * 2, WS_K = WS_Q + QKV_STRIDE_B, WS_V = WS_K + QKV_STRIDE_B;
constexpr size_t WS_LW = WS_V + QKV_STRIDE_B;
constexpr size_t WS_LG = WS_LW + (size_t)TP * 1024 * 4;
constexpr size_t WS_LOGF = 502 * MiB;
constexpr size_t WS_KE = WS_LOGF + 5 * MiB / 4;
constexpr size_t WS_T1 = WS_K;
constexpr size_t WS_ACT = 321 * MiB;
constexpr size_t WS_END = WS_KE + (size_t)64 * KEROWS * 32;
static_assert(WS_END <= 512 * MiB && WS_LG + (size_t)TP * 1024 * 2 <= WS_LOGF && WS_T1 + (size_t)TR * 2048 * 4 <= WS_LOGF && WS_ACT + (size_t)TR * DFF * 2 <= WS_LOGF && WS_XN2 + (size_t)TR * 2048 * 2 <= WS_ACT, "ws map");
constexpr int LDS_BYTES = 147456;

namespace pg8 {
#define EPI_PACK8(v0, v1) ((u32x4){cvt_pk_bf16((v0)[0], (v0)[1]), cvt_pk_bf16((v0)[2], (v0)[3]), cvt_pk_bf16((v1)[0], (v1)[1]), cvt_pk_bf16((v1)[2], (v1)[3])})
__device__ __forceinline__ float sigm(float x) { return __builtin_amdgcn_rcpf(1.f + __builtin_amdgcn_exp2f(-1.4426950408889634f * x)); }
struct Epi1 { static constexpr bool PERM = true, AFTER_DRAIN = false;
    bf16_t* ZR; bf16_t* Q; bf16_t* G; const float* q_g; const float* k_g;
    __device__ __forceinline__ void operator()(const f32x4 (&acc)[2][2][4][2], const Unit& u, int wr, int wc, int fr, int fq) const {
        const int pn = u.pn; bf16_t* base; int ldc, colt; bool sig = false;
        if (pn >= 14 && pn < 22) {
            const int t = (pn - 14) >> 2; bf16_t* b0 = Q + (size_t)t * ((size_t)16640 * 1024) + ((pn - 14) & 3) * 256 + 64 * wc + 8 * fq; const float* gp = (t ? k_g : q_g) + 8 * fq;
            const f32x4 g00 = *(const f32x4*)gp, g01 = *(const f32x4*)(gp + 4), g10 = *(const f32x4*)(gp + 32), g11 = *(const f32x4*)(gp + 36);
            const int row0 = u.pm * BM + wr * 64 + fr;
#pragma unroll
            for (int ai = 0; ai < 2; ++ai)
#pragma unroll
                for (int m = 0; m < 4; ++m) { float ss = 0.f;
#pragma unroll
                    for (int bj = 0; bj < 2; ++bj)
#pragma unroll
                        for (int n = 0; n < 2; ++n) { const f32x4 x = acc[ai][bj][m][n]; ss += (x[0] * x[0] + x[1] * x[1]) + (x[2] * x[2] + x[3] * x[3]); }
                    { auto r16 = __builtin_amdgcn_permlane16_swap(__float_as_uint(ss), __float_as_uint(ss), false, false); ss = __uint_as_float(r16[0]) + __uint_as_float(r16[1]);
                      auto r32 = __builtin_amdgcn_permlane32_swap(__float_as_uint(ss), __float_as_uint(ss), false, false); ss = __uint_as_float(r32[0]) + __uint_as_float(r32[1]); }
                    const float rs = (1.0f / sqrtf(ss * (1.0f / 64.0f) + 1e-6f)) * (t ? 1.0f : ::C2);
                    bf16_t* rowp = b0 + (size_t)(row0 + ai * HALF + m * 16) * 1024;
                    const f32x4 a0 = acc[ai][0][m][0] * rs * g00, a1 = acc[ai][0][m][1] * rs * g01, c0 = acc[ai][1][m][0] * rs * g10, c1 = acc[ai][1][m][1] * rs * g11;
                    *(u32x4*)rowp = EPI_PACK8(a0, a1); *(u32x4*)(rowp + 32) = EPI_PACK8(c0, c1); }
            return; }
        if (pn < 14) { base = ZR; ldc = 3584; colt = pn * 256; }
        else if (pn < 26) { const int t = (pn - 14) >> 2; base = Q + (size_t)t * ((size_t)16640 * 1024); ldc = 1024; colt = ((pn - 14) & 3) * 256; }
        else { if (u.pm >= 64) return; base = G; ldc = 4096; colt = (pn - 26) * 256; sig = true; }
        const int row0 = u.pm * BM + wr * 64 + fr, col0 = colt + wc * 32 + 8 * fq;
#pragma unroll
        for (int ai = 0; ai < 2; ++ai)
#pragma unroll
            for (int m = 0; m < 4; ++m) { bf16_t* rowp = base + (size_t)(row0 + ai * HALF + m * 16) * ldc + col0;
#pragma unroll
                for (int bj = 0; bj < 2; ++bj) { f32x4 v0 = acc[ai][bj][m][0], v1 = acc[ai][bj][m][1];
                    if (sig) {
#pragma unroll
                        for (int e = 0; e < 4; ++e) { v0[e] = sigm(v0[e]); v1[e] = sigm(v1[e]); } }
                    *(u32x4*)(rowp + bj * HALF) = EPI_PACK8(v0, v1); } }
    }
};
struct EpiLora { static constexpr bool PERM = true, AFTER_DRAIN = false;
    const float* w0; const float* a0; float* LW; bf16_t* LA; bf16_t* LG; int mode;
    __device__ __forceinline__ void operator()(const f32x4 (&acc)[2][2][4][2], const Unit& u, int wr, int wc, int fr, int fq) const {
        const int colt = u.pn * 256;
        const int row0 = u.pm * BM + wr * 64 + fr, col0 = colt + wc * 32 + 8 * fq;
        f32x4 bv[2][2];
#pragma unroll
        for (int bj = 0; bj < 2; ++bj)
#pragma unroll
            for (int n = 0; n < 2; ++n) bv[bj][n] = mode == 0 ? *(const f32x4*)(w0 + col0 + bj * HALF + 4 * n) : (mode == 1 ? *(const f32x4*)(a0 + col0 + bj * HALF + 4 * n) : (f32x4){0.f, 0.f, 0.f, 0.f});
#pragma unroll
        for (int ai = 0; ai < 2; ++ai)
#pragma unroll
            for (int m = 0; m < 4; ++m) { const size_t ro = (size_t)(row0 + ai * HALF + m * 16) * 1024 + col0;
#pragma unroll
                for (int bj = 0; bj < 2; ++bj) { f32x4 v0 = acc[ai][bj][m][0] + bv[bj][0], v1 = acc[ai][bj][m][1] + bv[bj][1];
                    if (mode == 0) {
#pragma unroll
                        for (int e = 0; e < 4; ++e) { v0[e] = __builtin_amdgcn_exp2f(-0.60653066f * 1.4426950408889634f * sigm(v0[e])); v1[e] = __builtin_amdgcn_exp2f(-0.60653066f * 1.4426950408889634f * sigm(v1[e])); }
                        *(f32x4*)(LW + ro + bj * HALF) = v0; *(f32x4*)(LW + ro + bj * HALF + 4) = v1;
                    } else if (mode == 1) {
#pragma unroll
                        for (int e = 0; e < 4; ++e) { v0[e] = sigm(v0[e]); v1[e] = sigm(v1[e]); }
                        *(u32x4*)(LA + ro + bj * HALF) = EPI_PACK8(v0, v1);
                    } else { *(u32x4*)(LG + ro + bj * HALF) = EPI_PACK8(v0, v1); } } }
    }
};
__device__ __forceinline__ void unpack8(const u32x4 w, float (&g)[8]) {
#pragma unroll
    for (int e = 0; e < 4; ++e) { g[2 * e] = __uint_as_float(w[e] << 16); g[2 * e + 1] = __uint_as_float(w[e] & 0xffff0000u); }
}
struct EpiB { static constexpr bool PERM = true, AFTER_DRAIN = false;
    const bf16_t* G; bf16_t* T1;
    __device__ __forceinline__ void operator()(const f32x4 (&acc)[2][2][4][2], const Unit& u, int wr, int wc, int fr, int fq) const {
        const int row0 = u.pm * BM + wr * 64 + fr, col0 = u.pn * BM + wc * 32 + 8 * fq;
#pragma unroll
        for (int ai = 0; ai < 2; ++ai)
#pragma unroll
            for (int m = 0; m < 4; ++m) { const size_t r = (size_t)(row0 + ai * HALF + m * 16);
#pragma unroll
                for (int bj = 0; bj < 2; ++bj) { const int c = col0 + bj * HALF; float g[8]; unpack8(*(const u32x4*)(G + r * 4096 + 2048 + c), g);
                    f32x4 v0 = acc[ai][bj][m][0], v1 = acc[ai][bj][m][1];
#pragma unroll
                    for (int e = 0; e < 4; ++e) { v0[e] *= g[e]; v1[e] *= g[4 + e]; }
                    *(u32x4*)(T1 + r * 2048 + c) = EPI_PACK8(v0, v1); } }
    }
};
struct EpiA { static constexpr bool PERM = true, AFTER_DRAIN = false;
    const bf16_t* G; const bf16_t* T1; bf16_t* MG;
    __device__ __forceinline__ void operator()(const f32x4 (&acc)[2][2][4][2], const Unit& u, int wr, int wc, int fr, int fq) const {
        const int row0 = u.pm * BM + wr * 64 + fr, col0 = u.pn * BM + wc * 32 + 8 * fq;
#pragma unroll
        for (int ai = 0; ai < 2; ++ai)
#pragma unroll
            for (int m = 0; m < 4; ++m) { const size_t r = (size_t)(row0 + ai * HALF + m * 16);
#pragma unroll
                for (int bj = 0; bj < 2; ++bj) { const int c = col0 + bj * HALF; float g[8], t[8]; unpack8(*(const u32x4*)(G + r * 4096 + c), g); unpack8(*(const u32x4*)(T1 + r * 2048 + c), t);
                    f32x4 v0 = acc[ai][bj][m][0], v1 = acc[ai][bj][m][1];
#pragma unroll
                    for (int e = 0; e < 4; ++e) { v0[e] = t[e] + v0[e] * g[e]; v1[e] = t[4 + e] + v1[e] * g[4 + e]; }
                    *(u32x4*)(MG + r * 2048 + c) = EPI_PACK8(v0, v1); } }
    }
};
struct EpiO { static constexpr bool PERM = true, AFTER_DRAIN = false;
    const float* x; const float* n2; float* H1; bf16_t* XN2; float* ssq;
    __device__ __forceinline__ void operator()(const f32x4 (&acc)[2][2][4][2], const Unit& u, int wr, int wc, int fr, int fq) const {
        const int row0 = u.pm * BM + wr * 64 + fr, col0 = u.pn * BM + wc * 32 + 8 * fq;
        f32x4 nv[2][2];
#pragma unroll
        for (int bj = 0; bj < 2; ++bj)
#pragma unroll
            for (int n = 0; n < 2; ++n) nv[bj][n] = *(const f32x4*)(n2 + col0 + bj * HALF + 4 * n);
#pragma unroll
        for (int ai = 0; ai < 2; ++ai)
#pragma unroll
            for (int m = 0; m < 4; ++m) { const size_t r = (size_t)(row0 + ai * HALF + m * 16); float sq = 0.f;
#pragma unroll
                for (int bj = 0; bj < 2; ++bj) { const int c = col0 + bj * HALF;
                    const f32x4 h0 = acc[ai][bj][m][0] + *(const f32x4*)(x + r * 2048 + c), h1 = acc[ai][bj][m][1] + *(const f32x4*)(x + r * 2048 + c + 4);
                    *(f32x4*)(H1 + r * 2048 + c) = h0; *(f32x4*)(H1 + r * 2048 + c + 4) = h1;
                    sq += (h0[0] * h0[0] + h0[1] * h0[1]) + (h0[2] * h0[2] + h0[3] * h0[3]) + (h1[0] * h1[0] + h1[1] * h1[1]) + (h1[2] * h1[2] + h1[3] * h1[3]);
                    const f32x4 a0 = h0 * nv[bj][0], a1 = h1 * nv[bj][1];
                    *(u32x4*)(XN2 + r * 2048 + c) = EPI_PACK8(a0, a1); }
                { auto r16 = __builtin_amdgcn_permlane16_swap(__float_as_uint(sq), __float_as_uint(sq), false, false); sq = __uint_as_float(r16[0]) + __uint_as_float(r16[1]);
                  auto r32 = __builtin_amdgcn_permlane32_swap(__float_as_uint(sq), __float_as_uint(sq), false, false); sq = __uint_as_float(r32[0]) + __uint_as_float(r32[1]); }
                if (fq == 0) atomicAdd(ssq + r, sq); }
    }
};
struct EpiGU { static constexpr bool PERM = true, AFTER_DRAIN = false;
    const float* ssq; bf16_t* ACT;
    __device__ __forceinline__ void operator()(const f32x4 (&acc)[2][2][4][2], const Unit& u, int wr, int wc, int fr, int fq) const {
        const int row0 = u.pm * BM + wr * 64 + fr, col0 = u.pn * HALF + wc * 32 + 8 * fq;
#pragma unroll
        for (int ai = 0; ai < 2; ++ai)
#pragma unroll
            for (int m = 0; m < 4; ++m) { const size_t r = (size_t)(row0 + ai * HALF + m * 16);
                const float rstd = 1.0f / sqrtf(ssq[r] * (1.0f / 2048.0f) + 1e-6f);
                f32x4 o0, o1;
#pragma unroll
                for (int e = 0; e < 4; ++e) { const float g0 = acc[ai][0][m][0][e] * rstd, u0 = acc[ai][1][m][0][e] * rstd, g1 = acc[ai][0][m][1][e] * rstd, u1 = acc[ai][1][m][1][e] * rstd;
                    o0[e] = g0 * sigm(g0) * u0; o1[e] = g1 * sigm(g1) * u1; }
                *(u32x4*)(ACT + r * 5632 + col0) = EPI_PACK8(o0, o1); }
    }
};
struct EpiDN { static constexpr bool PERM = true, AFTER_DRAIN = false;
    float* out;
    __device__ __forceinline__ void operator()(const f32x4 (&acc)[2][2][4][2], const Unit& u, int wr, int wc, int fr, int fq) const {
        const int row0 = u.pm * BM + wr * 64 + fr, col0 = u.pn * BM + wc * 32 + 8 * fq;
#pragma unroll
        for (int ai = 0; ai < 2; ++ai)
#pragma unroll
            for (int m = 0; m < 4; ++m) { const size_t r = (size_t)(row0 + ai * HALF + m * 16);
#pragma unroll
                for (int bj = 0; bj < 2; ++bj) { float* p = out + r * 2048 + col0 + bj * HALF;
                    const f32x4 h0 = *(const f32x4*)p + acc[ai][bj][m][0], h1 = *(const f32x4*)(p + 4) + acc[ai][bj][m][1];
                    *(f32x4*)p = h0; *(f32x4*)(p + 4) = h1; } }
    }
};
}

__device__ __forceinline__ void transpose_item(const float* W, int N, int K, bf16* WT, int src_col0, int dst_row0, int ncols, int kb, int nb, LAS float* scr, int lane) {
    const int k0 = 64 * kb, n0 = 32 * nb, kr = lane >> 3, c4 = lane & 7; const bool nv = (n0 + 4 * c4) < ncols;
    const float* src = W + (size_t)(k0 + kr) * N + src_col0 + n0 + 4 * c4;
    f4 v[8];
#pragma unroll
    for (int i = 0; i < 8; ++i) v[i] = nv ? *(const f4*)(src + (size_t)(8 * i) * N) : (f4){0.f, 0.f, 0.f, 0.f};
#pragma unroll
    for (int i = 0; i < 8; ++i) { LAS float* d = scr + (8 * i + kr) * 33 + 4 * c4; d[0] = v[i].x; d[1] = v[i].y; d[2] = v[i].z; d[3] = v[i].w; }
    LDS_WAIT(); asm volatile("" ::: "memory");
    const int c = lane & 7;
#pragma unroll
    for (int j = 0; j < 4; ++j) { const int n = (lane >> 3) + 8 * j; const LAS float* s = scr + (8 * c) * 33 + n;
        v4u o; o.x = pk2(s[0 * 33], s[1 * 33]); o.y = pk2(s[2 * 33], s[3 * 33]); o.z = pk2(s[4 * 33], s[5 * 33]); o.w = pk2(s[6 * 33], s[7 * 33]);
        if (n0 + n < ncols) *(v4u*)(WT + (size_t)(dst_row0 + n0 + n) * K + k0 + 8 * c) = o; }
    LDS_WAIT(); asm volatile("" ::: "memory");
}

struct Ptrs {
    const float *x, *meta, *n1, *w_in, *mu, *w0, *w2, *a0, *a2, *g2, *k_k, *k_a, *r_k, *gn_w, *gn_b, *q_g, *k_g, *f_bias, *w_a, *w_b, *w_o, *n2, *w_gu, *w_dn;
    float* out; unsigned char* ws;
};

template <bool LATE> __device__ __forceinline__ void p0_prologue(const Ptrs& P, LAS unsigned char* lds, int tid, int bi, int nb) {
    const int lane = tid & 63, wave = tid >> 6;
    LAS float* scr = (LAS float*)(lds + wave * 16384);
    const int gw = bi * NWAVES + wave, NGW = nb * NWAVES;
    bf16* WIN = (bf16*)(P.ws + WS_WIN); bf16* WA = (bf16*)(P.ws + WS_WA); bf16* WB = (bf16*)(P.ws + WS_WB); bf16* WO = (bf16*)(P.ws + WS_WO);
    bf16* WGU = (bf16*)(P.ws + WS_WGU); bf16* WDN = (bf16*)(P.ws + WS_WDN); bf16* WL = (bf16*)(P.ws + WS_WLORA); bf16* XN = (bf16*)(P.ws + WS_XN);
    constexpr int I0 = 32 * 110, I1 = 32 * 1, I2 = 32 * 96, I3 = 32 * 128, I4 = 16 * 64, I5 = 16 * 64, I6 = 32 * 64, I7 = 88 * 128, I8 = 88 * 64;
    constexpr int NITEMS = I0 + I1 + I2 + I3 + I4 + I5 + I6 + I7 + I8;
    constexpr int NEARLY = I0 + I1 + I2 + I3;
    for (int it = (LATE ? NEARLY : 0) + gw; it < (LATE ? NITEMS : NEARLY); it += NGW) {
        int r = it;
        if (r < I0) { transpose_item(P.w_in, NIN, 2048, WIN, 0, 0, 3520, r / 110, r % 110, scr, lane); continue; } r -= I0;
        if (r < I1) { transpose_item(P.w_in, NIN, 2048, WIN, 6592, 3520, 16, r, 0, scr, lane); continue; } r -= I1;
        if (r < I2) { const int kb_ = r / 96, nb_ = r % 96; int dnb_ = nb_;
            if (nb_ < 64) { const int w_ = nb_ & 7; dnb_ = (nb_ & ~7) + 4 * (w_ & 1) + (w_ >> 1); }
            transpose_item(P.w_in, NIN, 2048, WIN, 3520 + 32 * nb_, 3584 + 32 * dnb_, 32, kb_, 0, scr, lane); continue; } r -= I2;
        if (r < I3) { transpose_item(P.w_in, NIN, 2048, WIN, 6608, 6656, 4096, r / 128, r % 128, scr, lane); continue; } r -= I3;
        if (r < I4) { transpose_item(P.w_a, 2048, 1024, WA, 0, 0, 2048, r / 64, r % 64, scr, lane); continue; } r -= I4;
        if (r < I5) { transpose_item(P.w_b, 2048, 1024, WB, 0, 0, 2048, r / 64, r % 64, scr, lane); continue; } r -= I5;
        if (r < I6) { transpose_item(P.w_o, 2048, 2048, WO, 0, 0, 2048, r / 64, r % 64, scr, lane); continue; } r -= I6;
        if (r < I7) { const int seg = r / 128, rem = r % 128, q = seg >> 1, bj = seg & 1;
            transpose_item(P.w_gu, NGU, 2048, WGU, bj * DFF + 128 * q, 256 * q + 128 * bj, 128, rem / 4, rem % 4, scr, lane); continue; } r -= I7;
        transpose_item(P.w_dn, 2048, DFF, WDN, 0, 0, 2048, r / 64, r % 64, scr, lane);
    }
    if (LATE) return;
    for (int t = gw; t < TP; t += NGW) {
        bf16* orow = XN + (size_t)t * DM;
        if (t >= TV) {
#pragma unroll
            for (int j = 0; j < 4; ++j) *(v4u*)(orow + 8 * (lane + 64 * j)) = (v4u){0u, 0u, 0u, 0u};
            continue; }
        const float* src = (t < TR) ? P.x + (size_t)t * DM : P.meta + (size_t)(t - TR) * DM;
        f4 v[8]; float ss = 0.f;
#pragma unroll
        for (int j = 0; j < 8; ++j) { v[j] = *(const f4*)(src + 4 * (lane + 64 * j)); ss += (v[j].x * v[j].x + v[j].y * v[j].y) + (v[j].z * v[j].z + v[j].w * v[j].w); }
        const float rstd = 1.0f / sqrtf(wave_sum(ss) * (1.0f / DM) + 1e-6f);
#pragma unroll
        for (int j = 0; j < 8; ++j) { const f4 g = *(const f4*)(P.n1 + 4 * (lane + 64 * j));
            *(v2u*)(orow + 4 * (lane + 64 * j)) = (v2u){pk2(v[j].x * rstd * g.x, v[j].y * rstd * g.y), pk2(v[j].z * rstd * g.z, v[j].w * rstd * g.w)}; }
    }
    const int gt = blockIdx.x * NTHR + tid, NGT = gridDim.x * NTHR;
    for (int idx = gt; idx < 16384; idx += NGT) { const int n = idx & 1023, c = idx >> 10; float v[8];
#pragma unroll
        for (int e = 0; e < 8; ++e) { const int k = 8 * c + e; v[e] = k < 96 ? P.w2[(size_t)k * 1024 + n] : 0.f; }
        *(v4u*)(WL + (size_t)n * 128 + 8 * c) = (v4u){pk2(v[0], v[1]), pk2(v[2], v[3]), pk2(v[4], v[5]), pk2(v[6], v[7])}; }
    for (int idx = gt; idx < 16384; idx += NGT) { const int n = idx & 1023, c = idx >> 10; float v[8];
#pragma unroll
        for (int e = 0; e < 8; ++e) { const int k = 8 * c + e; v[e] = k < 96 ? P.a2[(size_t)k * 1024 + n] : 0.f; }
        *(v4u*)(WL + 131072 + (size_t)n * 128 + 8 * c) = (v4u){pk2(v[0], v[1]), pk2(v[2], v[3]), pk2(v[4], v[5]), pk2(v[6], v[7])}; }
    for (int idx = gt; idx < 32768; idx += NGT) { const int n = idx & 1023, c = idx >> 10; float v[8];
#pragma unroll
        for (int e = 0; e < 8; ++e) { const int k = 8 * c + e; v[e] = P.g2[(size_t)k * 1024 + n]; }
        *(v4u*)(WL + 262144 + (size_t)n * 256 + 8 * c) = (v4u){pk2(v[0], v[1]), pk2(v[2], v[3]), pk2(v[4], v[5]), pk2(v[6], v[7])}; }
    for (int idx = gt; idx < 48 * 256; idx += NGT) *(v4u*)(WIN + (size_t)(3536 + idx / 256) * 2048 + 8 * (idx % 256)) = (v4u){0u, 0u, 0u, 0u};
}

__device__ __forceinline__ void p2a_prep(const Ptrs& P, int tid) {
    const int lane = tid & 63, wave = tid >> 6;
    const int gw = blockIdx.x * NWAVES + wave, NGW = gridDim.x * NWAVES;
    const bf16* ZR = (const bf16*)(P.ws + WS_ZR); bf16* U = (bf16*)(P.ws + WS_U); bf16* Q = (bf16*)(P.ws + WS_Q); bf16* K = (bf16*)(P.ws + WS_K);
    float* LOGF = (float*)(P.ws + WS_LOGF);
    for (int t = gw; t < TP; t += NGW) {
        bf16* u1 = U + (size_t)t * 128; bf16* u2 = U + (size_t)TP * 128 + (size_t)t * 128; bf16* u3 = U + (size_t)TP * 256 + (size_t)t * 256;
        if (t >= TV) { if (lane < 16) { *(v4u*)(u1 + 8 * lane) = (v4u){0u, 0u, 0u, 0u}; *(v4u*)(u2 + 8 * lane) = (v4u){0u, 0u, 0u, 0u}; } if (lane < 32) *(v4u*)(u3 + 8 * lane) = (v4u){0u, 0u, 0u, 0u}; continue; }
        const int tp = (t < TR) ? ((t & (SEQ - 1)) ? t - 1 : TV - 1) : (t > TR ? t - 1 : -1);
        const bf16* z = ZR + (size_t)t * ZRW; const bf16* zp = ZR + (size_t)(tp < 0 ? 0 : tp) * ZRW;
        if (lane < 56) {
            const int c8 = 8 * lane; float zc[8], zq[8], o[8];
            { const v4u a = *(const v4u*)(z + 3072 + c8); const v4u b_ = tp < 0 ? (v4u){0u, 0u, 0u, 0u} : *(const v4u*)(zp + 3072 + c8);
#pragma unroll
              for (int e = 0; e < 4; ++e) { zc[2 * e] = bflo(a[e]); zc[2 * e + 1] = bfhi(a[e]); zq[2 * e] = bflo(b_[e]); zq[2 * e + 1] = bfhi(b_[e]); } }
            const f4 m0 = *(const f4*)(P.mu + 3072 + c8), m1 = *(const f4*)(P.mu + 3072 + c8 + 4); const float mu8[8] = {m0.x, m0.y, m0.z, m0.w, m1.x, m1.y, m1.z, m1.w};
#pragma unroll
            for (int e = 0; e < 8; ++e) { const float zs = zc[e] + (zq[e] - zc[e]) * mu8[e];
                if (c8 < 96) { const float ex = __builtin_amdgcn_exp2f(2.f * LOG2E * zs); o[e] = 1.f - 2.f * __builtin_amdgcn_rcpf(ex + 1.f); }
                else if (c8 < 192) o[e] = zs;
                else o[e] = sigmoidf_(zs); }
            bf16* dst = c8 < 96 ? u1 + c8 : (c8 < 192 ? u2 + (c8 - 96) : u3 + (c8 - 192));
            *(v4u*)dst = (v4u){pk2(o[0], o[1]), pk2(o[2], o[3]), pk2(o[4], o[5]), pk2(o[6], o[7])};
        } else { bf16* dst = (lane < 60 ? u1 : u2) + 96 + 8 * (lane & 3); *(v4u*)dst = (v4u){0u, 0u, 0u, 0u}; }
        if (lane < 16) { const float xx = bf2f(z[3520 + lane]) + P.f_bias[lane];
            LOGF[(size_t)t * 16 + lane] = fminf(xx, 0.f) - log1pf(__expf(-fabsf(xx))); }
    }
}

__device__ __forceinline__ v4u split3(float x) { const unsigned h = f2bf(x); const float r1 = x - bf2f(h); const unsigned m = f2bf(r1); const float r2 = r1 - bf2f(m); const unsigned l = f2bf(r2);
    return (v4u){h | (m << 16), l, 0u, 0u}; }
__device__ __forceinline__ void p2b_cumsum(const Ptrs& P, int bh, LAS unsigned char* lds, int tid) {
    const int b = bh >> 4, h = bh & 15;
    const float* LOGF = (const float*)(P.ws + WS_LOGF); bf16* KE = (bf16*)(P.ws + WS_KE) + (size_t)bh * KEROWS * 16;
    LAS float* sc = (LAS float*)lds;
    float v[8]; float s = 0.f;
#pragma unroll
    for (int j = 0; j < 8; ++j) { s += LOGF[((size_t)b * SEQ + 8 * tid + j) * 16 + h]; v[j] = s; }
    sc[tid] = s; __syncthreads();
    for (int o = 1; o < NTHR; o <<= 1) { const float add = tid >= o ? sc[tid - o] : 0.f; __syncthreads(); sc[tid] += add; __syncthreads(); }
    const float off = sc[tid] - s;
#pragma unroll
    for (int j = 0; j < 8; ++j) { bf16* e = KE + (size_t)(64 + 8 * tid + j) * 16; *(v4u*)e = split3(-(off + v[j]) * LOG2E); *(v4u*)(e + 8) = (v4u){0u, 0u, 0u, 0u}; }
    if (tid < 64) { float kb = -30000.f;
        if (tid < 16) { float c15 = 0.f, cj = 0.f; for (int m = 0; m < 16; ++m) { const float lf = LOGF[(size_t)(TR + m) * 16 + h]; c15 += lf; if (m <= tid) cj += lf; } kb = (c15 - cj) * LOG2E; }
        bf16* e = KE + (size_t)tid * 16; *(v4u*)e = split3(kb); *(v4u*)(e + 8) = (v4u){0u, 0u, 0u, 0u}; }
    __syncthreads();
}

template <int CTRL> __device__ __forceinline__ float dppf(float v) { return __uint_as_float((unsigned)__builtin_amdgcn_update_dpp(0, (int)__float_as_uint(v), CTRL, 0xF, 0xF, true)); }
__device__ __forceinline__ float red8(float v) { v += dppf<0xB1>(v); v += dppf<0x4E>(v); v += dppf<0x141>(v); return v; }
__device__ __forceinline__ float red16(float v) { v += dppf<0xB1>(v); v += dppf<0x4E>(v); v += dppf<0x141>(v); v += dppf<0x140>(v); return v; }
constexpr int SC_T = 32, SC_ARR = SC_T * 64, SC_BUF = 6 * SC_ARR;
__device__ __forceinline__ void unpk8(const v4u w, float (&o)[8]) {
#pragma unroll
    for (int e = 0; e < 4; ++e) { o[2 * e] = bflo(w[e]); o[2 * e + 1] = bfhi(w[e]); }
}
#define SC_BAR() do { asm volatile("s_waitcnt lgkmcnt(0)" ::: "memory"); __builtin_amdgcn_s_barrier(); asm volatile("" ::: "memory"); } while (0)
constexpr int CS_XA = 0, CS_XB = 4608, CS_XK = 9216, CS_XR = 13824;
constexpr int CS_TB = 18432, CS_TK = 23552, CS_TV = 28672;
constexpr int CS_DEC = 33792, CS_WT = 41984, CS_GL = 42240;
constexpr int CS_GA = 46336, CS_GB = 48896, CS_GK = 51456;
constexpr int CS_SS = 54016, CS_RH = 63232, CS_UT = 72448, CS_YS = 77568;
constexpr int CS_FLG = 43008;
constexpr int CS_GSV = 137216;
constexpr int CS_RKS = 136960;
constexpr int CS_PRM = 134912;
constexpr int CS_OP2 = 101120;
constexpr int CS_LP = 85760, CS_LT = 98560;
__device__ __forceinline__ f32x16 mfma32(bf16x8 a, bf16x8 b, f32x16 c) { return __builtin_amdgcn_mfma_f32_32x32x16_bf16(a, b, c, 0, 0, 0); }
__device__ __forceinline__ int crow(int r, int hi) { return (r & 3) + 8 * (r >> 2) + 4 * hi; }
__device__ __forceinline__ void p3_scanc(const Ptrs& P, int bh, LAS unsigned char* lds, int tid) {
    const int lane = tid & 63, wid = __builtin_amdgcn_readfirstlane(tid >> 6), b = bh >> 4, h = bh & 15, n = lane & 31, hi = lane >> 5;
    const bf16* ZR = (const bf16*)(P.ws + WS_ZR); const float* LW = (const float*)(P.ws + WS_LW); const bf16* LA = (const bf16*)(P.ws + WS_LA); const bf16* LG = (const bf16*)(P.ws + WS_LG);
    bf16* YA = (bf16*)(P.ws + WS_YA);
    constexpr int NSTEP = 16 + SEQ, NCH = (NSTEP + 31) / 32;
    constexpr int OPB = 33792;
    const bool prep = wid >= 4;
    const int t2 = tid & 255, sl = t2 >> 3, cgp = t2 & 7, c0 = h * 64 + 8 * cgp, pw = (wid & 3), q8 = lane >> 3;
    { const int kind = tid >> 6, ch = tid & 63; const float* srcp = kind == 0 ? P.mu : kind == 1 ? P.mu + 1024 : kind == 2 ? P.mu + 2048 : kind == 3 ? P.k_k : kind == 4 ? P.k_a : kind == 5 ? P.r_k : kind == 6 ? P.gn_w : P.gn_b;
      ((LAS float*)(lds + CS_PRM))[kind * 64 + ch] = srcp[h * 64 + ch]; }
    if (tid == 0) *(LAS unsigned*)(lds + CS_FLG) = 0u;
#define CS_PRM8(kind, arr) float arr[8]; { const f4 p0_ = *(const LAS f4*)(lds + CS_PRM + (kind) * 256 + cgp * 32), p1_ = *(const LAS f4*)(lds + CS_PRM + (kind) * 256 + cgp * 32 + 16); \
        arr[0] = p0_.x; arr[1] = p0_.y; arr[2] = p0_.z; arr[3] = p0_.w; arr[4] = p1_.x; arr[5] = p1_.y; arr[6] = p1_.z; arr[7] = p1_.w; }
    for (int i = tid; i < 9216 / 4; i += NTHR) ((LAS unsigned*)(lds + CS_SS))[i] = 0u;
    SC_BAR();
    f32x16 ST = {};
    v4u q_zr, q_zk, q_zv, q_pr, q_pk, q_pv, q_la, q_g; f4 q_d0, q_d1;
#define CS_FETCH(chunk) do { const int s_ = (chunk) * 32 + sl; const v4u z0_ = (v4u){0u, 0u, 0u, 0u}; \
        q_zr = z0_; q_zk = z0_; q_zv = z0_; q_pr = z0_; q_pk = z0_; q_pv = z0_; q_la = z0_; q_g = z0_; q_d0 = (f4){1.f, 1.f, 1.f, 1.f}; q_d1 = q_d0; \
        if (s_ < NSTEP) { const int row_ = s_ < 16 ? TR + s_ : b * SEQ + s_ - 16; const int prow_ = s_ == 0 ? -1 : (s_ <= 16 ? TR + s_ - 1 : row_ - 1); \
            const bf16* z_ = ZR + (size_t)row_ * ZRW + c0; q_zr = *(const v4u*)z_; q_zk = *(const v4u*)(z_ + 1024); q_zv = *(const v4u*)(z_ + 2048); \
            if (prow_ >= 0) { const bf16* zp_ = ZR + (size_t)prow_ * ZRW + c0; q_pr = *(const v4u*)zp_; q_pk = *(const v4u*)(zp_ + 1024); q_pv = *(const v4u*)(zp_ + 2048); } \
            q_d0 = *(const f4*)(LW + (size_t)row_ * 1024 + c0); q_d1 = *(const f4*)(LW + (size_t)row_ * 1024 + c0 + 4); q_la = *(const v4u*)(LA + (size_t)row_ * 1024 + c0); \
            if (s_ >= 16) q_g = *(const v4u*)(LG + (size_t)row_ * 1024 + c0); } } while (0)
#define CS_W16(base, o, val) (*(LAS unsigned short*)(ob_ + (base) + (o)) = (unsigned short)(val))
#define CS_ALPHA_A(bufsel) do { LAS unsigned char* ob_ = lds + ((bufsel) ? CS_OP2 : 0); \
        *(LAS f4*)(lds + CS_DEC + sl * 256 + cgp * 32) = q_d0; *(LAS f4*)(lds + CS_DEC + sl * 256 + cgp * 32 + 16) = q_d1; \
        asm volatile("s_waitcnt lgkmcnt(0)" ::: "memory"); if (lane == 0) __hip_atomic_fetch_add((LAS unsigned*)(lds + CS_FLG), 1u, __ATOMIC_RELAXED, __HIP_MEMORY_SCOPE_WORKGROUP);     \
        float r_[8], k_[8], v_[8], a_[8], pr_[8], pk_[8], pv_[8]; CS_PRM8(0, mu_r) CS_PRM8(1, mu_k) CS_PRM8(2, mu_v) CS_PRM8(3, kkw) CS_PRM8(4, kaw) CS_PRM8(5, rkw) \
        unpk8(q_zr, r_); unpk8(q_zk, k_); unpk8(q_zv, v_); unpk8(q_pr, pr_); unpk8(q_pk, pk_); unpk8(q_pv, pv_); unpk8(q_la, a_); \
        *(LAS v4u*)(lds + CS_GSV + (bufsel) * 4096 + sl * 128 + cgp * 16) = q_g; \
        float kkv_[8], kf_[8], ss_ = 0.f, rk_ = 0.f; \
        _Pragma("unroll") for (int j = 0; j < 8; ++j) { r_[j] = r_[j] + (pr_[j] - r_[j]) * mu_r[j]; const float kk_ = k_[j] + (pk_[j] - k_[j]) * mu_k[j]; v_[j] = v_[j] + (pv_[j] - v_[j]) * mu_v[j]; \
            kkv_[j] = kk_ * kkw[j]; ss_ += kkv_[j] * kkv_[j]; kf_[j] = kk_ * (1.f + (a_[j] - 1.f) * kaw[j]); rk_ += r_[j] * kf_[j] * rkw[j]; } \
        ss_ = red8(ss_); rk_ = red8(rk_); \
        const float inv_ = __builtin_amdgcn_rcpf(fmaxf(__builtin_amdgcn_sqrtf(ss_), 1e-12f)); \
        float kn_[8], bv_[8]; \
        _Pragma("unroll") for (int j = 0; j < 8; ++j) { kn_[j] = kkv_[j] * inv_; bv_[j] = kn_[j] * a_[j]; } \
        const int ro_ = sl * 144 + cgp * 16; \
        *(LAS v4u*)(ob_ + CS_XR + ro_) = (v4u){pk2(r_[0], r_[1]), pk2(r_[2], r_[3]), pk2(r_[4], r_[5]), pk2(r_[6], r_[7])}; \
        *(LAS v4u*)(ob_ + CS_XK + ro_) = (v4u){pk2(kf_[0], kf_[1]), pk2(kf_[2], kf_[3]), pk2(kf_[4], kf_[5]), pk2(kf_[6], kf_[7])}; \
        *(LAS v4u*)(ob_ + CS_XA + ro_) = (v4u){pk2(kn_[0], kn_[1]), pk2(kn_[2], kn_[3]), pk2(kn_[4], kn_[5]), pk2(kn_[6], kn_[7])}; \
        *(LAS v4u*)(ob_ + CS_XB + ro_) = (v4u){pk2(bv_[0], bv_[1]), pk2(bv_[2], bv_[3]), pk2(bv_[4], bv_[5]), pk2(bv_[6], bv_[7])}; \
        { const v4u pv_2 = (v4u){pk2(v_[0], v_[1]), pk2(v_[2], v_[3]), pk2(v_[4], v_[5]), pk2(v_[6], v_[7])}; const int to_ = (8 * cgp) * 80 + sl * 2; \
          _Pragma("unroll") for (int e_ = 0; e_ < 4; ++e_) { CS_W16(CS_TV, to_ + (2 * e_) * 80, pv_2[e_] & 0xffffu); CS_W16(CS_TV, to_ + (2 * e_ + 1) * 80, pv_2[e_] >> 16); } } \
        if (cgp == 0) ((LAS float*)(lds + CS_RKS))[(bufsel) * 32 + sl] = rk_; \
        } while (0)
#define CS_ALPHA_B(bufsel) do { LAS unsigned char* ob_ = lds + ((bufsel) ? CS_OP2 : 0); \
        const int ro_ = sl * 144 + cgp * 16; \
        float xa_[8], xb_[8], xk_[8], xr_[8], wt_[8], wm_[8]; \
        { const f4 w0_ = *(const LAS f4*)(lds + CS_DEC + sl * 256 + cgp * 32), w1_ = *(const LAS f4*)(lds + CS_DEC + sl * 256 + cgp * 32 + 16); \
          const int slm_ = sl > 0 ? sl - 1 : 0; const f4 m0_ = *(const LAS f4*)(lds + CS_DEC + slm_ * 256 + cgp * 32), m1_ = *(const LAS f4*)(lds + CS_DEC + slm_ * 256 + cgp * 32 + 16); \
          wt_[0] = w0_.x; wt_[1] = w0_.y; wt_[2] = w0_.z; wt_[3] = w0_.w; wt_[4] = w1_.x; wt_[5] = w1_.y; wt_[6] = w1_.z; wt_[7] = w1_.w; \
          wm_[0] = m0_.x; wm_[1] = m0_.y; wm_[2] = m0_.z; wm_[3] = m0_.w; wm_[4] = m1_.x; wm_[5] = m1_.y; wm_[6] = m1_.z; wm_[7] = m1_.w; \
          if (sl == 0) { _Pragma("unroll") for (int j = 0; j < 8; ++j) wm_[j] = 1.f; } } \
        unpk8(*(const LAS v4u*)(ob_ + CS_XA + ro_), xa_); unpk8(*(const LAS v4u*)(ob_ + CS_XB + ro_), xb_); unpk8(*(const LAS v4u*)(ob_ + CS_XK + ro_), xk_); unpk8(*(const LAS v4u*)(ob_ + CS_XR + ro_), xr_); \
        _Pragma("unroll") for (int j = 0; j < 8; ++j) { const float W_ = wt_[j], iw_ = __builtin_amdgcn_rcpf(W_); \
            xa_[j] = -xa_[j] * wm_[j]; xb_[j] = xb_[j] * iw_; xk_[j] = xk_[j] * iw_; xr_[j] = xr_[j] * W_; } \
        const v4u pa_ = (v4u){pk2(xa_[0], xa_[1]), pk2(xa_[2], xa_[3]), pk2(xa_[4], xa_[5]), pk2(xa_[6], xa_[7])}, pb_ = (v4u){pk2(xb_[0], xb_[1]), pk2(xb_[2], xb_[3]), pk2(xb_[4], xb_[5]), pk2(xb_[6], xb_[7])}; \
        const v4u pk_2 = (v4u){pk2(xk_[0], xk_[1]), pk2(xk_[2], xk_[3]), pk2(xk_[4], xk_[5]), pk2(xk_[6], xk_[7])}, pr_2 = (v4u){pk2(xr_[0], xr_[1]), pk2(xr_[2], xr_[3]), pk2(xr_[4], xr_[5]), pk2(xr_[6], xr_[7])}; \
        *(LAS v4u*)(ob_ + CS_XA + ro_) = pa_; *(LAS v4u*)(ob_ + CS_XB + ro_) = pb_; *(LAS v4u*)(ob_ + CS_XK + ro_) = pk_2; *(LAS v4u*)(ob_ + CS_XR + ro_) = pr_2; \
        const int to_ = (8 * cgp) * 80 + sl * 2; \
        _Pragma("unroll") for (int e_ = 0; e_ < 4; ++e_) { CS_W16(CS_TB, to_ + (2 * e_) * 80, pb_[e_] & 0xffffu); CS_W16(CS_TB, to_ + (2 * e_ + 1) * 80, pb_[e_] >> 16); \
            CS_W16(CS_TK, to_ + (2 * e_) * 80, pk_2[e_] & 0xffffu); CS_W16(CS_TK, to_ + (2 * e_ + 1) * 80, pk_2[e_] >> 16); } \
        if (sl == 31) { *(LAS f4*)(lds + CS_WT + (bufsel) * 256 + cgp * 32) = (f4){wt_[0], wt_[1], wt_[2], wt_[3]}; *(LAS f4*)(lds + CS_WT + (bufsel) * 256 + cgp * 32 + 16) = (f4){wt_[4], wt_[5], wt_[6], wt_[7]}; } } while (0)
#define CS_POST(chunk) do { const int s_ = (chunk) * 32 + sl; const f4 y0_ = *(const LAS f4*)(lds + CS_YS + sl * 256 + cgp * 32), y1_ = *(const LAS f4*)(lds + CS_YS + sl * 256 + cgp * 32 + 16); \
        float y_[8] = {y0_.x, y0_.y, y0_.z, y0_.w, y1_.x, y1_.y, y1_.z, y1_.w}, g_[8], o_[8], vv_[8]; unpk8(*(const LAS v4u*)(lds + CS_GSV + ((chunk) & 1) * 4096 + sl * 128 + cgp * 16), g_); CS_PRM8(6, gnw) CS_PRM8(7, gnb) \
        { const LAS unsigned char* tv_ = lds + (((chunk) & 1) ? CS_OP2 : 0) + CS_TV + (8 * cgp) * 80 + sl * 2; _Pragma("unroll") for (int j = 0; j < 8; ++j) vv_[j] = bf2f(*(const LAS unsigned short*)(tv_ + j * 80)); } \
        const float rkp_ = ((const LAS float*)(lds + CS_RKS))[((chunk) & 1) * 32 + sl]; \
        float sum_ = 0.f; _Pragma("unroll") for (int j = 0; j < 8; ++j) sum_ += y_[j]; \
        const float mean_ = red8(sum_) * (1.f / 64.f); float m2_ = 0.f; \
        _Pragma("unroll") for (int j = 0; j < 8; ++j) { y_[j] -= mean_; m2_ += y_[j] * y_[j]; } \
        const float rstd_ = __builtin_amdgcn_rsqf(red8(m2_) * (1.f / 64.f) + 64e-5f); \
        _Pragma("unroll") for (int j = 0; j < 8; ++j) o_[j] = (y_[j] * rstd_ * gnw[j] + gnb[j] + rkp_ * vv_[j]) * g_[j]; \
        if (s_ >= 16 && s_ < NSTEP) *(v4u*)(YA + (size_t)(b * SEQ + s_ - 16) * 1024 + c0) = (v4u){pk2(o_[0], o_[1]), pk2(o_[2], o_[3]), pk2(o_[4], o_[5]), pk2(o_[6], o_[7])}; } while (0)
#define CS_KEEP_ROT() do { } while (0)
#define CS_CUMPROD(want) do { while (__hip_atomic_load((LAS unsigned*)(lds + CS_FLG), __ATOMIC_RELAXED, __HIP_MEMORY_SCOPE_WORKGROUP) < (want)) __builtin_amdgcn_s_sleep(1); \
        asm volatile("" ::: "memory"); LAS float* dcol_ = (LAS float*)(lds + CS_DEC) + lane; float d_[32]; \
        _Pragma("unroll") for (int t_ = 0; t_ < 32; ++t_) d_[t_] = dcol_[t_ * 64]; \
        _Pragma("unroll") for (int t_ = 1; t_ < 32; ++t_) d_[t_] *= d_[t_ - 1]; \
        _Pragma("unroll") for (int t_ = 1; t_ < 32; ++t_) dcol_[t_ * 64] = d_[t_]; } while (0)
    if (prep) { CS_FETCH(0); CS_ALPHA_A(0); CS_FETCH(1); }
    SC_BAR();
    if (wid == 1) CS_CUMPROD(4u);
    SC_BAR();
    if (prep) { CS_ALPHA_B(0); CS_KEEP_ROT(); }
    SC_BAR();
    for (int c = 0; c < NCH; ++c) {
        const LAS unsigned char* ob = lds + ((c & 1) ? CS_OP2 : 0);
        if (!prep) {
            const LAS unsigned char* As = ob + (wid < 2 ? CS_XA : CS_XR) + n * 144 + hi * 16; const LAS unsigned char* Bs = ob + ((wid & 1) ? CS_XK : CS_XB) + n * 144 + hi * 16;
            f32x16 g = {};
#pragma unroll
            for (int ks = 0; ks < 4; ++ks) g = mfma32(*(const LAS bf16x8*)(As + ks * 32), *(const LAS bf16x8*)(Bs + ks * 32), g);
            if (wid == 0) {
#pragma unroll
                for (int r = 0; r < 16; ++r) if (n >= crow(r, hi)) g[r] = 0.f;
                for (int i = 0; i < 5; ++i) {
                    LAS unsigned short* lp = (LAS unsigned short*)(lds + CS_LP + i * 2560);
#pragma unroll
                    for (int r = 0; r < 16; ++r) lp[crow(r, hi) * 40 + n] = (unsigned short)(pk2(g[r], 0.f) & 0xffffu);
                    if (i == 4) break;
                    const bf16x8 b0 = __builtin_bit_cast(bf16x8, (v4u){pk2(g[0], g[1]), pk2(g[2], g[3]), pk2(g[4], g[5]), pk2(g[6], g[7])});
                    const bf16x8 b1 = __builtin_bit_cast(bf16x8, (v4u){pk2(g[8], g[9]), pk2(g[10], g[11]), pk2(g[12], g[13]), pk2(g[14], g[15])});
                    asm volatile("s_waitcnt lgkmcnt(0)" ::: "memory");
                    const LAS unsigned char* Ap = lds + CS_LP + i * 2560 + n * 80 + hi * 8;
                    const v2u a00 = *(const LAS v2u*)Ap, a01 = *(const LAS v2u*)(Ap + 16), a10 = *(const LAS v2u*)(Ap + 32), a11 = *(const LAS v2u*)(Ap + 48);
                    asm volatile("s_waitcnt lgkmcnt(0)" ::: "memory");
                    f32x16 g2 = {}; g2 = mfma32(__builtin_bit_cast(bf16x8, (v4u){a00[0], a00[1], a01[0], a01[1]}), b0, g2); g2 = mfma32(__builtin_bit_cast(bf16x8, (v4u){a10[0], a10[1], a11[0], a11[1]}), b1, g2);
                    asm volatile("s_nop 15\n\ts_nop 7" : "+v"(g2)); g = g2;
                }
            } else {
                LAS unsigned short* G = (LAS unsigned short*)(lds + (wid == 1 ? CS_GA : (wid == 2 ? CS_GB : CS_GK)));
#pragma unroll
                for (int r = 0; r < 16; ++r) { const int t = crow(r, hi); const bool keep = wid == 1 ? (n < t) : (n <= t); G[t * 40 + n] = (unsigned short)(pk2(keep ? g[r] : 0.f, 0.f) & 0xffffu); }
            }
            if (wid == 1 && c + 1 < NCH) CS_CUMPROD(4u * (unsigned)(c + 2));
        } else {
            if (c >= 1) CS_POST(c - 1);
            if (c + 1 < NCH) { CS_ALPHA_A((c + 1) & 1); if (c + 2 < NCH) CS_FETCH(c + 2); }
        }
        SC_BAR();
        if (!prep) {
            const int vb = wid & 1;
            const LAS unsigned char* As = ob + (wid < 2 ? CS_XA : CS_XR) + n * 144 + hi * 16; const LAS unsigned char* Bs = lds + CS_SS + (32 * vb + n) * 144 + hi * 16;
            f32x16 acc = {};
#pragma unroll
            for (int ks = 0; ks < 4; ++ks) acc = mfma32(*(const LAS bf16x8*)(As + ks * 32), *(const LAS bf16x8*)(Bs + ks * 32), acc);
            if (wid < 2) {
                const LAS unsigned char* Ga = lds + CS_GA + n * 80 + hi * 16; const LAS unsigned char* Tv = ob + CS_TV + (32 * vb + n) * 80 + hi * 16;
#pragma unroll
                for (int js = 0; js < 2; ++js) acc = mfma32(*(const LAS bf16x8*)(Ga + js * 32), *(const LAS bf16x8*)(Tv + js * 32), acc);
                LAS unsigned char* xt = lds + CS_UT + (32 * vb + n) * 80; asm volatile("s_nop 15\n\ts_nop 7" : "+v"(acc));
#pragma unroll 1
                for (int i = 0; i < 5; ++i) {
                    const LAS unsigned char* Ap = lds + CS_LP + i * 2560 + n * 80 + hi * 8;
                    const v2u a00 = *(const LAS v2u*)Ap, a01 = *(const LAS v2u*)(Ap + 16), a10 = *(const LAS v2u*)(Ap + 32), a11 = *(const LAS v2u*)(Ap + 48);
                    const bf16x8 b0 = __builtin_bit_cast(bf16x8, (v4u){pk2(acc[0], acc[1]), pk2(acc[2], acc[3]), pk2(acc[4], acc[5]), pk2(acc[6], acc[7])});
                    const bf16x8 b1 = __builtin_bit_cast(bf16x8, (v4u){pk2(acc[8], acc[9]), pk2(acc[10], acc[11]), pk2(acc[12], acc[13]), pk2(acc[14], acc[15])});
                    asm volatile("s_waitcnt lgkmcnt(0)" ::: "memory");
                    acc = mfma32(__builtin_bit_cast(bf16x8, (v4u){a00[0], a00[1], a01[0], a01[1]}), b0, acc); acc = mfma32(__builtin_bit_cast(bf16x8, (v4u){a10[0], a10[1], a11[0], a11[1]}), b1, acc);
                    asm volatile("s_nop 15\n\ts_nop 7" : "+v"(acc));
                }
#pragma unroll
                for (int r4 = 0; r4 < 4; ++r4) *(LAS v2u*)(xt + (8 * r4 + 4 * hi) * 2) = (v2u){pk2(acc[4 * r4], acc[4 * r4 + 1]), pk2(acc[4 * r4 + 2], acc[4 * r4 + 3])};
            } else { LAS float* ys = (LAS float*)(lds + CS_YS) + 32 * vb + n; asm volatile("s_nop 15\n\ts_nop 7" : "+v"(acc));
#pragma unroll
                for (int r = 0; r < 16; ++r) ys[crow(r, hi) * 64] = acc[r]; }
        } else if (c + 1 < NCH) { CS_ALPHA_B((c + 1) & 1); CS_KEEP_ROT(); }
        else { CS_KEEP_ROT(); }
        SC_BAR();
        if (!prep) {
            const int vb = wid & 1, kb = wid >> 1;
            const LAS unsigned char* Ut = lds + CS_UT + (32 * vb + n) * 80 + hi * 16; const LAS unsigned char* Tv = ob + CS_TV + (32 * vb + n) * 80 + hi * 16;
            if (wid >= 2) {
                f32x16 acc; { const LAS float* ys0 = (const LAS float*)(lds + CS_YS) + 32 * vb + n;
#pragma unroll
                  for (int r = 0; r < 16; ++r) acc[r] = ys0[crow(r, hi) * 64]; }
                const LAS unsigned char* Gb = lds + CS_GB + n * 80 + hi * 16; const LAS unsigned char* Gk = lds + CS_GK + n * 80 + hi * 16;
#pragma unroll
                for (int js = 0; js < 2; ++js) { acc = mfma32(*(const LAS bf16x8*)(Gb + js * 32), *(const LAS bf16x8*)(Ut + js * 32), acc); acc = mfma32(*(const LAS bf16x8*)(Gk + js * 32), *(const LAS bf16x8*)(Tv + js * 32), acc); }
                LAS float* ys = (LAS float*)(lds + CS_YS) + 32 * vb + n;
#pragma unroll
                for (int r = 0; r < 16; ++r) ys[crow(r, hi) * 64] = acc[r];
            }
            const LAS unsigned char* Tb = ob + CS_TB + (32 * kb + n) * 80 + hi * 16; const LAS unsigned char* Tk = ob + CS_TK + (32 * kb + n) * 80 + hi * 16;
#pragma unroll
            for (int js = 0; js < 2; ++js) { ST = mfma32(*(const LAS bf16x8*)(Tb + js * 32), *(const LAS bf16x8*)(Ut + js * 32), ST); ST = mfma32(*(const LAS bf16x8*)(Tk + js * 32), *(const LAS bf16x8*)(Tv + js * 32), ST); }
            const LAS float* wt = (const LAS float*)(lds + CS_WT + (c & 1) * 256) + 32 * kb + 4 * hi; LAS unsigned char* ss = lds + CS_SS + (32 * vb + n) * 144 + (32 * kb + 4 * hi) * 2;
#pragma unroll
            for (int r4 = 0; r4 < 4; ++r4) { const f4 w = *(const LAS f4*)(wt + 8 * r4);
                ST[4 * r4] *= w.x; ST[4 * r4 + 1] *= w.y; ST[4 * r4 + 2] *= w.z; ST[4 * r4 + 3] *= w.w;
                *(LAS v2u*)(ss + 16 * r4) = (v2u){pk2(ST[4 * r4], ST[4 * r4 + 1]), pk2(ST[4 * r4 + 2], ST[4 * r4 + 3])}; }
        }
        SC_BAR();
    }
    if (prep) CS_POST(NCH - 1);
#undef CS_FETCH
#undef CS_ALPHA_A
#undef CS_ALPHA_B
#undef CS_W16
#undef CS_POST
#undef CS_KEEP_ROT
#undef CS_PRM8
#undef CS_CUMPROD
    __syncthreads();
}

constexpr int AT_KROW = 176, AT_VROW = 144, AT_KBYTES = 64 * AT_KROW, AT_BUF = AT_KBYTES + 64 * AT_VROW;
__device__ __forceinline__ void attn_unit(const Ptrs& P, int bh, int qb, LAS unsigned char* lds, int tid) {
    const int lane = tid & 63, wid = tid >> 6, n = lane & 31, hi = lane >> 5, b = bh >> 4, h = bh & 15;
    bf16* Qb = (bf16*)(P.ws + WS_Q); const bf16* Kb = (const bf16*)(P.ws + WS_K); const bf16* Vb = (const bf16*)(P.ws + WS_V);
    const bf16* KE = (const bf16*)(P.ws + WS_KE) + (size_t)bh * KEROWS * 16;
    const int NTL = 4 * (qb + 1) + 1; const size_t rowb = (size_t)b * SEQ; const int qrow = 256 * qb + 32 * wid + n, qw0 = 256 * qb + 32 * wid;
    bf16x8 qf[5];
    { const bf16* qp = Qb + (rowb + qrow) * 1024 + h * 64 + hi * 8;
#pragma unroll
      for (int d0 = 0; d0 < 4; ++d0) qf[d0] = *(const bf16x8*)(qp + d0 * 16);
      const short one = hi == 0 ? (short)0x3F80 : (short)0; qf[4] = (bf16x8){one, one, one, 0, 0, 0, 0, 0}; }
    const int sj = tid >> 3, sc = tid & 7;
    const int slot = ((sj >> 5) * 32) + (((sj >> 4) & 1) * 16) + (((sj >> 2) & 1) * 8) + (((sj >> 3) & 1) * 4) + (sj & 3);
    const int vgrp = (slot >> 3) ^ sc, vpos = vgrp * 16 + (slot & 7) * 2;
    const int ej = tid >> 1, eh = tid & 1;
    v4u kreg, vreg, ereg = (v4u){0u, 0u, 0u, 0u};
#define AT_LOAD(t) do { const bool val_ = (t) > 0 || sj < 16; const size_t row_ = (t) == 0 ? (size_t)(TR + (sj & 15)) : rowb + 64 * ((t) - 1) + sj; \
        kreg = *(const v4u*)(Kb + row_ * 1024 + h * 64 + sc * 8); vreg = *(const v4u*)(Vb + row_ * 1024 + h * 64 + sc * 8); \
        if (!val_) { kreg = (v4u){0u, 0u, 0u, 0u}; vreg = (v4u){0u, 0u, 0u, 0u}; } \
        if (tid < 128) ereg = *(const v4u*)(KE + (size_t)(64 * (t) + ej) * 16 + eh * 8); } while (0)
#define AT_STORE(bufo) do { LAS unsigned char* kt_ = lds + (bufo); LAS unsigned char* vt_ = kt_ + AT_KBYTES; \
        *(LAS v4u*)(kt_ + sj * AT_KROW + sc * 16) = kreg; if (tid < 128) *(LAS v4u*)(kt_ + ej * AT_KROW + 128 + eh * 16) = ereg; \
        _Pragma("unroll") for (int i_ = 0; i_ < 8; ++i_) { const unsigned w_ = vreg[i_ >> 1]; *(LAS unsigned short*)(vt_ + (8 * sc + i_) * AT_VROW + vpos) = (unsigned short)((i_ & 1) ? (w_ >> 16) : (w_ & 0xffffu)); } } while (0)
    AT_LOAD(0); AT_STORE(0); __syncthreads();
    f32x16 o0 = {}, o1 = {}; float m = -INFINITY, l = 0.f;
    for (int t = 0; t < NTL; ++t) {
        if (t + 1 < NTL) AT_LOAD(t + 1);
        const int bufo = (t & 1) * AT_BUF; const int key0 = 64 * (t - 1);
        const bool skip = t >= 1 && key0 > qw0 + 31;
        if (!skip) {
            const LAS unsigned char* Kt = lds + bufo; const LAS unsigned char* Vt = Kt + AT_KBYTES;
            f32x16 s0 = {}, s1 = {};
#pragma unroll
            for (int d0 = 0; d0 < 5; ++d0) { const int off = d0 < 4 ? d0 * 32 + hi * 16 : 128 + hi * 16;
                const bf16x8 k0 = *(const LAS bf16x8*)(Kt + n * AT_KROW + off), k1 = *(const LAS bf16x8*)(Kt + (32 + n) * AT_KROW + off);
                s0 = __builtin_amdgcn_mfma_f32_32x32x16_bf16(k0, qf[d0], s0, 0, 0, 0); s1 = __builtin_amdgcn_mfma_f32_32x32x16_bf16(k1, qf[d0], s1, 0, 0, 0); }
            if (t >= 1 && key0 + 63 > qw0) {
#pragma unroll
                for (int r = 0; r < 16; ++r) { const int key = key0 + crow(r, hi); if (key > qrow) s0[r] = -INFINITY; if (key + 32 > qrow) s1[r] = -INFINITY; } }
            float mx = fmaxf(s0[0], s1[0]);
#pragma unroll
            for (int r = 1; r < 16; ++r) mx = fmaxf(mx, fmaxf(s0[r], s1[r]));
            mx = fmaxf(mx, __shfl_xor(mx, 32));
            const float mn = fmaxf(m, mx), f = __builtin_amdgcn_exp2f(m - mn); m = mn; l *= f;
#pragma unroll
            for (int r = 0; r < 16; ++r) { o0[r] *= f; o1[r] *= f; }
            float ls = 0.f;
#pragma unroll
            for (int r = 0; r < 16; ++r) { s0[r] = __builtin_amdgcn_exp2f(s0[r] - mn); s1[r] = __builtin_amdgcn_exp2f(s1[r] - mn); ls += s0[r] + s1[r]; }
            l += ls;
            v4u pa[4];
#pragma unroll
            for (int e = 0; e < 4; ++e) { pa[0][e] = pk2(s0[2 * e], s0[2 * e + 1]); pa[1][e] = pk2(s0[8 + 2 * e], s0[8 + 2 * e + 1]); pa[2][e] = pk2(s1[2 * e], s1[2 * e + 1]); pa[3][e] = pk2(s1[8 + 2 * e], s1[8 + 2 * e + 1]); }
#pragma unroll
            for (int sl = 0; sl < 4; ++sl) { const int grp = sl * 2 + hi; const bf16x8 pb = __builtin_bit_cast(bf16x8, pa[sl]);
                const bf16x8 v0 = *(const LAS bf16x8*)(Vt + n * AT_VROW + ((grp ^ ((n >> 3) & 7)) * 16));
                const bf16x8 v1 = *(const LAS bf16x8*)(Vt + (32 + n) * AT_VROW + ((grp ^ (((32 + n) >> 3) & 7)) * 16));
                o0 = __builtin_amdgcn_mfma_f32_32x32x16_bf16(v0, pb, o0, 0, 0, 0); o1 = __builtin_amdgcn_mfma_f32_32x32x16_bf16(v1, pb, o1, 0, 0, 0); }
        }
        if (t + 1 < NTL) AT_STORE(((t + 1) & 1) * AT_BUF);
        __syncthreads();
    }
#undef AT_LOAD
#undef AT_STORE
    l += __shfl_xor(l, 32); const float inv = 1.0f / l;
    bf16* op = Qb + (rowb + qrow) * 1024 + h * 64;
#pragma unroll
    for (int r4 = 0; r4 < 4; ++r4) {
        __hip_atomic_store((unsigned long long*)(op + 8 * r4 + 4 * hi), (unsigned long long)pk2(o0[4 * r4] * inv, o0[4 * r4 + 1] * inv) | ((unsigned long long)pk2(o0[4 * r4 + 2] * inv, o0[4 * r4 + 3] * inv) << 32), __ATOMIC_RELAXED, __HIP_MEMORY_SCOPE_AGENT);
        __hip_atomic_store((unsigned long long*)(op + 32 + 8 * r4 + 4 * hi), (unsigned long long)pk2(o1[4 * r4] * inv, o1[4 * r4 + 1] * inv) | ((unsigned long long)pk2(o1[4 * r4 + 2] * inv, o1[4 * r4 + 3] * inv) << 32), __ATOMIC_RELAXED, __HIP_MEMORY_SCOPE_AGENT); }
}

#define XB_TMO      128
#define XB_XCNT(j)  (256  + 64 * (j))
#define XB_XSUB(j)  (1280 + 64 * (j))
#define XB_XGEN(j)  (2304 + 64 * (j))
#define XB_TOP      3328
#define XB_TOPGEN   3392
#define XCD_BAR_WORDS 3456
#define XB_SPIN_CAP (1u << 18)

__device__ __forceinline__ unsigned xb_ld(unsigned* p)              { return __hip_atomic_load(p, __ATOMIC_RELAXED, __HIP_MEMORY_SCOPE_AGENT); }
__device__ __forceinline__ unsigned xb_add(unsigned* p, unsigned v) { return __hip_atomic_fetch_add(p, v, __ATOMIC_RELAXED, __HIP_MEMORY_SCOPE_AGENT); }
__device__ __forceinline__ unsigned xb_xcc_id() { return (unsigned)__builtin_amdgcn_s_getreg((3 << 11) | 20) & 0xFu; }
#define XB_SPIN(cond, bar) do { unsigned _sp = 0; while (cond) { __builtin_amdgcn_s_sleep(1); \
    if ((++_sp & 255u) == 0u) { if (xb_ld(&(bar)[XB_TMO])) break; if (_sp > XB_SPIN_CAP) { atomicAdd(&(bar)[XB_TMO], 1u); break; } } } } while (0)

struct XcdBarrier {
    unsigned* bar; unsigned x;
    volatile LAS unsigned* st;
};

__device__ __forceinline__ XcdBarrier xcd_barrier_post(unsigned* bar, volatile LAS unsigned* st) {
    XcdBarrier b; b.bar = bar; b.x = xb_xcc_id(); b.st = st;
    if (threadIdx.x == 0) (void)xb_add(&bar[XB_XCNT(b.x)], 1u);
    return b;
}
__device__ __forceinline__ void xcd_barrier_complete(unsigned* bar, unsigned x, unsigned& nloc, unsigned& nx) {
    const unsigned G = gridDim.x * gridDim.y * gridDim.z;
    unsigned sum, cnt, mine, sp = 0u;
    for (;;) {
        sum = 0u; cnt = 0u; mine = 0u;
#pragma unroll
        for (unsigned j = 0; j < 16; ++j) { const unsigned c = xb_ld(&bar[XB_XCNT(j)]); sum += c; cnt += (c > 0u) ? 1u : 0u; mine = (j == x) ? c : mine; }
        if (sum == G) break;
        __builtin_amdgcn_s_sleep(1);
        if ((++sp & 255u) == 0u) { if (xb_ld(&bar[XB_TMO])) break; if (sp > XB_SPIN_CAP) { atomicAdd(&bar[XB_TMO], 1u); break; } }
    }
    nloc = mine > 0u ? mine : 1u; nx = cnt > 0u ? cnt : 1u;
}

__device__ __forceinline__ void xcd_barrier(const XcdBarrier& b) {
    asm volatile("s_waitcnt vmcnt(0)" ::: "memory");
    __syncthreads();
    if (threadIdx.x == 0) {
        unsigned* bar = b.bar;
        __builtin_amdgcn_s_waitcnt(0);
        unsigned nloc = b.st[0], nx = b.st[1];
        if (nloc == 0u) { xcd_barrier_complete(bar, b.x, nloc, nx); b.st[0] = nloc; b.st[1] = nx; }
        const unsigned old = xb_add(&bar[XB_XSUB(b.x)], 1u);
        const unsigned gen = old / nloc;
        if (old + 1u == (gen + 1u) * nloc) {
            __builtin_amdgcn_fence(__ATOMIC_RELEASE, "agent");
            asm volatile("s_waitcnt vmcnt(0)" ::: "memory");
            const unsigned og = xb_add(&bar[XB_TOP], 1u);
            const unsigned tg = og / nx;
            if (og + 1u == (tg + 1u) * nx) xb_add(&bar[XB_TOPGEN], 1u);
            else XB_SPIN(xb_ld(&bar[XB_TOPGEN]) == tg, bar);
            __builtin_amdgcn_fence(__ATOMIC_ACQUIRE, "agent");
            xb_add(&bar[XB_XGEN(b.x)], 1u);
            asm volatile("s_waitcnt vmcnt(0)" ::: "memory");
        } else {
            XB_SPIN(xb_ld(&bar[XB_XGEN(b.x)]) == gen, bar);
            __builtin_amdgcn_fence(__ATOMIC_ACQUIRE, "agent");
            asm volatile("s_waitcnt vmcnt(0)" ::: "memory");
        }
    }
    __syncthreads();
}

struct Args { const float* in[24]; float* out; unsigned char* ws; };
__global__ void __launch_bounds__(NTHR, 2) fwd_megakernel(Args args) {
    extern __shared__ __attribute__((aligned(16))) unsigned char lds_raw[];
    cg::grid_group grid = cg::this_grid();
    LAS unsigned char* lds = (LAS unsigned char*)lds_raw;
    const int tid = threadIdx.x, G = gridDim.x;
    Ptrs P;
    P.x = args.in[0]; P.meta = args.in[1]; P.n1 = args.in[2]; P.w_in = args.in[3]; P.mu = args.in[4]; P.w0 = args.in[5]; P.w2 = args.in[6]; P.a0 = args.in[7]; P.a2 = args.in[8];
    P.g2 = args.in[9]; P.k_k = args.in[10]; P.k_a = args.in[11]; P.r_k = args.in[12]; P.gn_w = args.in[13]; P.gn_b = args.in[14]; P.q_g = args.in[15]; P.k_g = args.in[16];
    P.f_bias = args.in[17]; P.w_a = args.in[18]; P.w_b = args.in[19]; P.w_o = args.in[20]; P.n2 = args.in[21]; P.w_gu = args.in[22]; P.w_dn = args.in[23];
    P.out = args.out; P.ws = args.ws;
    unsigned char* ws = args.ws;
    typedef pg8::bf16_t pb;
    volatile LAS unsigned* bst = (volatile LAS unsigned*)(lds + LDS_BYTES - 64);
    if (tid < 2) bst[tid] = 0u;
    __syncthreads();
    const XcdBarrier xbar = xcd_barrier_post((unsigned*)(ws + WS_CTL) + 1024, bst);
    p0_prologue<false>(P, lds, tid, (int)blockIdx.x, G);
    xcd_barrier(xbar);
    if (G == 0x7fffffff) grid.sync();
    { pg8::Gemm g{(const pb*)(ws + WS_XN), (const pb*)(ws + WS_WIN), TP, N1, DM}; pg8::StaticOrder S; S.init(TP, N1, G, (int)blockIdx.x);
      pg8::Epi1 E{(pb*)(ws + WS_ZR), (pb*)(ws + WS_Q), (pb*)args.out, P.q_g, P.k_g};
      pg8::gemm_phase<pg8::Epi1, pg8::StaticOrder, true, true>(lds, g, S, E); }
    xcd_barrier(xbar);
    p2a_prep(P, tid);
    xcd_barrier(xbar);
#pragma unroll 1
    for (int j = 0; j < 3; ++j) {
      pg8::Gemm g{(const pb*)(ws + WS_U) + (size_t)TP * 128 * j, (const pb*)(ws + WS_WLORA) + 131072 * j, TP, 1024, j == 2 ? 256 : 128}; pg8::StaticOrder S; S.init(TP, 1024, G, (int)((blockIdx.x + 64u * j) % (unsigned)G));
      pg8::EpiLora E{P.w0, P.a0, (float*)(ws + WS_LW), (pb*)(ws + WS_LA), (pb*)(ws + WS_LG), j};
      pg8::gemm_phase<pg8::EpiLora, pg8::StaticOrder, true, true>(lds, g, S, E);
      __syncthreads(); }
    if (G == 256) { if (blockIdx.x >= 192) p2b_cumsum(P, (int)blockIdx.x - 192, lds, tid); }
    else for (int bh = blockIdx.x; bh < 64; bh += G) p2b_cumsum(P, bh, lds, tid);
    xcd_barrier(xbar);
    for (int bh = blockIdx.x; bh < 64; bh += G) p3_scanc(P, bh, lds, tid);
    unsigned* ctr = (unsigned*)(ws + WS_CTL); unsigned* adone = ctr + 8192; unsigned* efail = ctr + 8256;
    { LAS unsigned* slot = (LAS unsigned*)(lds + 2 * AT_BUF); unsigned nprev = 0u;
      for (;;) {
          if (tid == 0) { if (nprev) __hip_atomic_fetch_add(adone, nprev, __ATOMIC_RELAXED, __HIP_MEMORY_SCOPE_AGENT); *slot = atomicAdd(ctr, 1u); }
          __syncthreads();
          const unsigned u = *slot;
          __syncthreads();
          if (u >= 1024u) break;
          attn_unit(P, (int)(u & 63u), 15 - (int)(u >> 6), lds, tid);
          asm volatile("s_waitcnt vmcnt(0)" ::: "memory"); __syncthreads();
          nprev = 1u;
      } }
    if (G <= 64) p0_prologue<true>(P, lds, tid, (int)blockIdx.x, G);
    else if (blockIdx.x >= 64) p0_prologue<true>(P, lds, tid, (int)blockIdx.x - 64, G - 64);
    if (G == 256 && blockIdx.x >= 64) {
        LAS unsigned* okw = (LAS unsigned*)(lds + 2 * AT_BUF);
        __syncthreads();
        if (tid == 0) { unsigned ok = 0u;
            for (int it = 0; it < 4000; ++it) { if (__hip_atomic_load(adone, __ATOMIC_RELAXED, __HIP_MEMORY_SCOPE_AGENT) >= 1024u) { ok = 1u; break; } __builtin_amdgcn_s_sleep(16); }
            if (!ok) __hip_atomic_fetch_add(efail, 1u, __ATOMIC_RELAXED, __HIP_MEMORY_SCOPE_AGENT);
            *okw = ok; }
        __syncthreads();
        const unsigned ok = *okw;
        __syncthreads();
        if (ok) {
            __builtin_amdgcn_fence(__ATOMIC_ACQUIRE, "agent");
            pg8::Gemm g{(const pb*)(ws + WS_Q), (const pb*)(ws + WS_WB), TR, DM, 1024}; pg8::StaticOrder S; S.init(TR, DM, 192, (int)blockIdx.x - 64);
            pg8::EpiB E{(const pb*)args.out, (pb*)(ws + WS_K)};
            pg8::gemm_phase<pg8::EpiB, pg8::StaticOrder, true, true>(lds, g, S, E);
        }
    }
    xcd_barrier(xbar);
    if (G != 256 || __hip_atomic_load(efail, __ATOMIC_RELAXED, __HIP_MEMORY_SCOPE_AGENT) != 0u) {
      pg8::Gemm g{(const pb*)(ws + WS_Q), (const pb*)(ws + WS_WB), TR, DM, 1024}; pg8::StaticOrder S; S.init(TR, DM, G, (int)blockIdx.x);
      pg8::EpiB E{(const pb*)args.out, (pb*)(ws + WS_K)};
      pg8::gemm_phase<pg8::EpiB, pg8::StaticOrder, true, true>(lds, g, S, E);
      xcd_barrier(xbar); }
    { pg8::Gemm g{(const pb*)(ws + WS_YA), (const pb*)(ws + WS_WA), TR, DM, 1024}; pg8::StaticOrder S; S.init(TR, DM, G, (int)blockIdx.x);
      pg8::EpiA E{(const pb*)args.out, (const pb*)(ws + WS_K), (pb*)(ws + WS_MG)};
      pg8::gemm_phase<pg8::EpiA, pg8::StaticOrder, true, true>(lds, g, S, E); }
    xcd_barrier(xbar);
    { pg8::Gemm g{(const pb*)(ws + WS_MG), (const pb*)(ws + WS_WO), TR, DM, DM}; pg8::StaticOrder S; S.init(TR, DM, G, (int)blockIdx.x);
      pg8::EpiO E{P.x, P.n2, args.out, (pb*)(ws + WS_XN2), (float*)(ws + WS_CTL + CTL_SSQ)};
      pg8::gemm_phase<pg8::EpiO, pg8::StaticOrder, true, true>(lds, g, S, E); }
    xcd_barrier(xbar);
    { pg8::Gemm g{(const pb*)(ws + WS_XN2), (const pb*)(ws + WS_WGU), TR, NGU, DM}; pg8::StaticOrder S; S.init(TR, NGU, G, (int)blockIdx.x);
      pg8::EpiGU E{(const float*)(ws + WS_CTL + CTL_SSQ), (pb*)(ws + WS_ACT)};
      pg8::gemm_phase<pg8::EpiGU, pg8::StaticOrder, true, true>(lds, g, S, E); }
    xcd_barrier(xbar);
    { pg8::Gemm g{(const pb*)(ws + WS_ACT), (const pb*)(ws + WS_WDN), TR, DM, DFF}; pg8::StaticOrder S; S.init(TR, DM, G, (int)blockIdx.x);
      pg8::EpiDN E{args.out};
      pg8::gemm_phase<pg8::EpiDN, pg8::StaticOrder, true, true>(lds, g, S, E); }
}

extern "C" void kernel_launch(void* const* d_in, const int* in_sizes, int n_in, void* d_out, int out_size, void* d_ws, size_t ws_size, hipStream_t stream) {
    static int grid = 0;
    if (grid == 0) {
        if (n_in != 24 || out_size != TR * DM || ws_size < WS_END) { fprintf(stderr, "kernel_launch: unexpected shapes (n_in %d, out %d, ws %zu < %zu)\n", n_in, out_size, ws_size, (size_t)WS_END); grid = -1; return; }
        int dev = 0, cus = 0, per_cu = 0;
        hipGetDevice(&dev); hipDeviceGetAttribute(&cus, hipDeviceAttributeMultiprocessorCount, dev);
        if (hipFuncSetAttribute((const void*)fwd_megakernel, hipFuncAttributeMaxDynamicSharedMemorySize, LDS_BYTES) != hipSuccess) { fprintf(stderr, "kernel_launch: hipFuncSetAttribute failed\n"); grid = -1; return; }
        if (hipOccupancyMaxActiveBlocksPerMultiprocessor(&per_cu, (const void*)fwd_megakernel, NTHR, LDS_BYTES) != hipSuccess || per_cu < 1) { fprintf(stderr, "kernel_launch: occupancy query says %d\n", per_cu); per_cu = 1; }
        (void)hipGetLastError();
        grid = cus;
    }
    if (grid < 0) return;
    (void)hipMemsetAsync((char*)d_ws + WS_CTL, 0, CTL_ZERO_BYTES, stream);
    Args a{};
    for (int i = 0; i < 24; ++i) a.in[i] = (const float*)d_in[i];
    a.out = (float*)d_out; a.ws = (unsigned char*)d_ws;
    void* kargs[] = {&a};
    hipError_t e = hipLaunchCooperativeKernel((const void*)fwd_megakernel, dim3(grid), dim3(NTHR), kargs, LDS_BYTES, stream);
    if (e != hipSuccess) fprintf(stderr, "kernel_launch: cooperative launch failed: %s (grid %d)\n", hipGetErrorString(e), grid);
}
```

```cpp
#include <hip/hip_runtime.h>
#include <hip/hip_cooperative_groups.h>
#include <cstdio>
#include <cstdint>
namespace cg = cooperative_groups;
namespace pg8 {
#define PG8_LAS __attribute__((address_space(3)))
typedef unsigned short bf16_t;
typedef short bf16x8 __attribute__((ext_vector_type(8)));
typedef float f32x4 __attribute__((ext_vector_type(4)));
typedef unsigned u32x4 __attribute__((ext_vector_type(4)));
constexpr int BM = 256, BK = 64, HALF = 128, HTB = HALF * BK * 2  , STAGE_BYTES = 8 * HTB, NXCD = 8, WGM = 8;

__host__ __device__ __forceinline__ int lds_byte(int r, int c) { const int st = (r >> 4) * 2 + (c >> 5), rr = r & 15, cc = c & 31, ob = rr * 64 + cc * 2; return st * 1024 + (ob ^ (((ob >> 9) & 1) << 5)); }
__host__ __device__ __forceinline__ void stage_rc(int b, int& R, int& C) { const int st = b / 1024, sb = b % 1024, swz = sb ^ (((sb >> 9) & 1) << 5); R = (st >> 1) * 16 + swz / 64; C = (st & 1) * 32 + (swz % 64) / 2; }
__host__ __device__ __forceinline__ int perm32(int rho) { const int n = rho >> 4, i = rho & 15; return 8 * (i >> 2) + 4 * n + (i & 3); }

struct Unit { int pm, pn; };
struct Gemm { const bf16_t* A; const bf16_t* Bt; int M, N, K; };

struct StaticOrder {
    int nM, nN, nwg, G, c;
    __host__ __device__ void init(int M, int N, int G_, int c_) { nM = M / BM; nN = N / BM; nwg = nM * nN; G = G_; c = c_; }
    __host__ __device__ bool next(int i, Unit& u) const {
        const long L = (long)i * G + c; if (L >= nwg) return false;
        int wgid = (int)L; { const int q = nwg / NXCD, r = nwg % NXCD, xcd = wgid % NXCD, off = wgid / NXCD; wgid = (xcd < r ? xcd * (q + 1) : r * (q + 1) + (xcd - r) * q) + off; }
        const int nig = WGM * nN, gid = wgid / nig, fm = gid * WGM, gsz = (nM - fm) < WGM ? (nM - fm) : WGM;
        u.pm = fm + ((wgid % nig) % gsz); u.pn = (wgid % nig) / gsz; return true;
    }
    __device__ __forceinline__ void a_ready(const Unit&) const {}
    __device__ __forceinline__ void done(const Unit&) const {}
};

__device__ __forceinline__ unsigned cvt_pk_bf16(float lo, float hi) { unsigned r; asm volatile("v_cvt_pk_bf16_f32 %0, %1, %2" : "=v"(r) : "v"(lo), "v"(hi)); return r; }

template <class Epi, class Sched, bool ALIGN_EPI = false, bool SP2 = false>
__device__ __forceinline__ void gemm_phase(PG8_LAS unsigned char* lds, const Gemm g, const Sched& S, const Epi& E) {
    int tid_ = threadIdx.x; asm volatile("" : "+v"(tid_));
    const int tid = tid_, wid = __builtin_amdgcn_readfirstlane(tid >> 6), lane = tid & 63, wr = wid >> 2, wc = wid & 3, fr = lane & 15, fq = lane >> 4;
    const int K = g.K, nt = K / BK;
    unsigned voffA[2], voffB[2];
#pragma unroll
    for (int i = 0; i < 2; ++i) { int R, C; stage_rc(tid * 16 + i * 8192, R, C); const int Rb = Epi::PERM ? ((R & ~31) + perm32(R & 31)) : R;
        voffA[i] = (unsigned)(R * K + C) * 2u; voffB[i] = (unsigned)(Rb * K + C) * 2u; }
    const size_t kstep = (size_t)(BK * 2);
    const size_t hstep = (size_t)HALF * K * 2;
    const size_t tstep = 2 * hstep;
    const unsigned ldsw = (unsigned)wid * 1024u;
    const int aoff = lds_byte(wr * 64 + fr, fq * 8), boff = lds_byte(wc * 32 + fr, fq * 8);
#define PG8_SA(b, h) (((b) * 2 + (h)) * HTB)
#define PG8_SB(b, h) ((4 + (b) * 2 + (h)) * HTB)
#define PG8_STAGE(bufoff, gbase, voff) do { _Pragma("unroll") for (int _i = 0; _i < 2; ++_i) \
        __builtin_amdgcn_global_load_lds((const unsigned*)((const char*)(gbase) + (voff)[_i]), (PG8_LAS unsigned*)(lds + (bufoff) + ldsw + _i * 8192), 16, 0, 0); } while (0)
#define PG8_LDA(dst, b, h) do { _Pragma("unroll") for (int m = 0; m < 4; ++m) _Pragma("unroll") for (int k = 0; k < 2; ++k) dst[m][k] = *(const PG8_LAS bf16x8*)(lds + PG8_SA(b, h) + aoff + m * 2048 + k * 1024); } while (0)
#define PG8_LDB(dst, b, h) do { _Pragma("unroll") for (int n = 0; n < 2; ++n) _Pragma("unroll") for (int k = 0; k < 2; ++k) dst[n][k] = *(const PG8_LAS bf16x8*)(lds + PG8_SB(b, h) + boff + n * 2048 + k * 1024); } while (0)
#define PG8_MMA(ai, bj, At, Bt) do { __builtin_amdgcn_s_setprio(1); _Pragma("unroll") for (int m = 0; m < 4; ++m) _Pragma("unroll") for (int n = 0; n < 2; ++n) _Pragma("unroll") for (int k = 0; k < 2; ++k) \
        acc[ai][bj][m][n] = __builtin_amdgcn_mfma_f32_16x16x32_bf16(Bt[n][k], At[m][k], acc[ai][bj][m][n], 0, 0, 0); __builtin_amdgcn_s_setprio(0); } while (0)
#define PG8_WAIT_V(n) asm volatile("s_waitcnt vmcnt(" #n ")" ::: "memory")
#define PG8_WAIT_L(n) asm volatile("s_waitcnt lgkmcnt(" #n ")" ::: "memory")
#define PG8_BAR __builtin_amdgcn_s_barrier()
#define PG8_SCHED __builtin_amdgcn_sched_barrier(0)
    Unit cur, nxt; int ui = 0;
    if (!S.next(0, cur)) return;
    f32x4 acc[2][2][4][2];
#pragma unroll
    for (int a = 0; a < 2; ++a)
#pragma unroll
        for (int b = 0; b < 2; ++b)
#pragma unroll
            for (int m = 0; m < 4; ++m)
#pragma unroll
                for (int n = 0; n < 2; ++n) acc[a][b][m][n] = (f32x4){0.f, 0.f, 0.f, 0.f};
    bf16x8 At[4][2], B0[2][2], B1[2][2];
    const char* cA = (const char*)g.A + (size_t)cur.pm * tstep; const char* cB = (const char*)g.Bt + (size_t)cur.pn * tstep;
    S.a_ready(cur);
    if constexpr (SP2) {
        PG8_STAGE(PG8_SB(0, 0), cB, voffB); PG8_STAGE(PG8_SB(0, 1), cB + hstep, voffB); PG8_STAGE(PG8_SA(0, 0), cA, voffA); PG8_STAGE(PG8_SA(0, 1), cA + hstep, voffA);
        if (wr == 1) PG8_BAR;
        PG8_WAIT_V(2); PG8_BAR;
        PG8_STAGE(PG8_SB(1, 0), cB + kstep, voffB); PG8_STAGE(PG8_SA(1, 0), cA + kstep, voffA); PG8_STAGE(PG8_SB(1, 1), cB + hstep + kstep, voffB);
        PG8_WAIT_V(6); PG8_BAR;
    } else {
        PG8_STAGE(PG8_SB(0, 0), cB, voffB); PG8_STAGE(PG8_SA(0, 0), cA, voffA); PG8_STAGE(PG8_SB(0, 1), cB + hstep, voffB); PG8_STAGE(PG8_SA(0, 1), cA + hstep, voffA);
        if (wr == 1) PG8_BAR;
        PG8_WAIT_V(4); PG8_BAR;
        PG8_STAGE(PG8_SB(1, 0), cB + kstep, voffB); PG8_STAGE(PG8_SA(1, 0), cA + kstep, voffA); PG8_STAGE(PG8_SB(1, 1), cB + hstep + kstep, voffB);
        PG8_WAIT_V(6); PG8_BAR;
    }
    for (;;) {
        const bool has_next = S.next(ui + 1, nxt);
        const char* nA = has_next ? (const char*)g.A + (size_t)nxt.pm * tstep : cA; const char* nB = has_next ? (const char*)g.Bt + (size_t)nxt.pn * tstep : cB;
        for (int t = 0; t < nt; t += 2) {
            const bool last = (t == nt - 2);
            const char* a1 = cA + (size_t)(t + 1) * kstep;
            const char* a2 = last ? nA : cA + (size_t)(t + 2) * kstep; const char* b2 = last ? nB : cB + (size_t)(t + 2) * kstep;
            const char* a3 = a2 + kstep; const char* b3 = b2 + kstep;
            if (last && has_next) S.a_ready(nxt);
            if constexpr (SP2) {
            PG8_LDB(B0, 0, 0); PG8_LDB(B1, 0, 1); PG8_SCHED; PG8_LDA(At, 0, 0); PG8_STAGE(PG8_SA(1, 1), a1 + hstep, voffA);
            PG8_WAIT_V(8); PG8_WAIT_L(0); PG8_BAR; PG8_MMA(0, 0, At, B0); PG8_MMA(0, 1, At, B1); PG8_BAR; PG8_SCHED;
            PG8_LDA(At, 0, 1); PG8_STAGE(PG8_SB(0, 0), b2, voffB); PG8_STAGE(PG8_SB(0, 1), b2 + hstep, voffB); PG8_STAGE(PG8_SA(0, 0), a2, voffA);
            PG8_WAIT_V(8); PG8_WAIT_L(0); PG8_BAR; PG8_MMA(1, 0, At, B0); PG8_MMA(1, 1, At, B1); PG8_BAR; PG8_SCHED;
            PG8_LDB(B0, 1, 0); PG8_LDB(B1, 1, 1); PG8_SCHED; PG8_LDA(At, 1, 0); PG8_STAGE(PG8_SA(0, 1), a2 + hstep, voffA);
            PG8_WAIT_V(8); PG8_WAIT_L(0); PG8_BAR; PG8_MMA(0, 0, At, B0); PG8_MMA(0, 1, At, B1); PG8_BAR; PG8_SCHED;
            PG8_LDA(At, 1, 1); PG8_STAGE(PG8_SB(1, 0), b3, voffB); PG8_STAGE(PG8_SB(1, 1), b3 + hstep, voffB); PG8_STAGE(PG8_SA(1, 0), a3, voffA);
            PG8_WAIT_V(8); PG8_WAIT_L(0); PG8_BAR; PG8_MMA(1, 0, At, B0); PG8_MMA(1, 1, At, B1); PG8_BAR; PG8_SCHED;
            } else {
            PG8_LDB(B0, 0, 0); PG8_SCHED; PG8_LDA(At, 0, 0); PG8_STAGE(PG8_SA(1, 1), a1 + hstep, voffA);
            PG8_WAIT_L(8); PG8_BAR; PG8_WAIT_L(0); PG8_MMA(0, 0, At, B0); PG8_BAR; PG8_SCHED;
            PG8_LDB(B1, 0, 1); PG8_STAGE(PG8_SB(0, 0), b2, voffB);
            PG8_BAR; PG8_WAIT_L(0); PG8_MMA(0, 1, At, B1); PG8_BAR;
            PG8_LDA(At, 0, 1); PG8_STAGE(PG8_SA(0, 0), a2, voffA);
            PG8_BAR; PG8_WAIT_L(0); PG8_MMA(1, 0, At, B0); PG8_BAR; PG8_SCHED;
            PG8_STAGE(PG8_SB(0, 1), b2 + hstep, voffB);
            PG8_WAIT_V(6); PG8_BAR; PG8_MMA(1, 1, At, B1); PG8_BAR;
            PG8_LDB(B0, 1, 0); PG8_SCHED; PG8_LDA(At, 1, 0); PG8_STAGE(PG8_SA(0, 1), a2 + hstep, voffA);
            PG8_WAIT_L(8); PG8_BAR; PG8_WAIT_L(0); PG8_MMA(0, 0, At, B0); PG8_BAR; PG8_SCHED;
            PG8_LDB(B1, 1, 1); PG8_STAGE(PG8_SB(1, 0), b3, voffB);
            PG8_BAR; PG8_WAIT_L(0); PG8_MMA(0, 1, At, B1); PG8_BAR;
            PG8_LDA(At, 1, 1); PG8_STAGE(PG8_SA(1, 0), a3, voffA);
            PG8_BAR; PG8_WAIT_L(0); PG8_MMA(1, 0, At, B0); PG8_BAR; PG8_SCHED;
            PG8_STAGE(PG8_SB(1, 1), b3 + hstep, voffB);
            PG8_WAIT_V(6); PG8_BAR; PG8_MMA(1, 1, At, B1); PG8_BAR;
            }
        }
        if constexpr (ALIGN_EPI) { if (wr == 0) PG8_BAR; }
        if constexpr (!Epi::AFTER_DRAIN) { E(acc, cur, wr, wc, fr, fq); S.done(cur); }
        if (!has_next) break;
#pragma unroll
        for (int a = 0; a < 2; ++a)
#pragma unroll
            for (int b = 0; b < 2; ++b)
#pragma unroll
                for (int m = 0; m < 4; ++m)
#pragma unroll
                    for (int n = 0; n < 2; ++n) acc[a][b][m][n] = (f32x4){0.f, 0.f, 0.f, 0.f};
        cur = nxt; cA = nA; cB = nB; ++ui;
        if constexpr (ALIGN_EPI) { if (wr == 1) PG8_BAR; }
    }
    PG8_WAIT_V(0);
    if constexpr (!ALIGN_EPI) { if (wr == 0) PG8_BAR; }
    PG8_BAR;
    if constexpr (Epi::AFTER_DRAIN) { E.fused(acc, cur, wr, wc, fr, fq, lds, wid, lane); S.done(cur); }
#undef PG8_SA
#undef PG8_SB
#undef PG8_STAGE
#undef PG8_LDA
#undef PG8_LDB
#undef PG8_MMA
#undef PG8_WAIT_V
#undef PG8_WAIT_L
#undef PG8_BAR
#undef PG8_SCHED
}
}

#define GAS __attribute__((address_space(1)))
#define LAS __attribute__((address_space(3)))
typedef unsigned short bf16;
typedef unsigned v4u __attribute__((ext_vector_type(4)));
typedef unsigned v2u __attribute__((ext_vector_type(2)));
typedef float f4 __attribute__((ext_vector_type(4)));
typedef float f2 __attribute__((ext_vector_type(2)));
typedef short bf16x8 __attribute__((ext_vector_type(8)));
typedef float f32x16 __attribute__((ext_vector_type(16)));
#define LDS_WAIT() asm volatile("s_waitcnt lgkmcnt(0)" ::: "memory")
__device__ __forceinline__ unsigned f2bf(float f) { unsigned u = __builtin_bit_cast(unsigned, f); return (u + 0x7fffu + ((u >> 16) & 1u)) >> 16; }
__device__ __forceinline__ unsigned pk2(float lo, float hi) { unsigned r; asm("v_cvt_pk_bf16_f32 %0, %1, %2" : "=v"(r) : "v"(lo), "v"(hi)); return r; }
__device__ __forceinline__ float bf2f(unsigned h) { return __uint_as_float(h << 16); }
__device__ __forceinline__ float bflo(unsigned w) { return __uint_as_float(w << 16); }
__device__ __forceinline__ float bfhi(unsigned w) { return __uint_as_float(w & 0xffff0000u); }
__device__ __forceinline__ float sigmoidf_(float x) { return __builtin_amdgcn_rcpf(1.f + __builtin_amdgcn_exp2f(-1.4426950408889634f * x)); }
__device__ __forceinline__ float wave_sum(float v) {
#pragma unroll
    for (int o = 1; o < 64; o <<= 1) v += __shfl_xor(v, o);
    return v;
}

constexpr int NWAVES = 8, NTHR = 512;
constexpr int DM = 2048, TR = 16384, TV = 16400, TP = 16640, SEQ = 4096, NBATCH = 4, NH = 16;
constexpr int N1 = 10752, ZRW = 3584, NLORA = 3072, KLORA = 512, DFF = 5632, NGU = 11264, NIN = 10704;
constexpr int KEROWS = 4160;
constexpr float C2 = 0.125f * 1.4426950408889634f;
constexpr float LOG2E = 1.4426950408889634f;
constexpr size_t MiB = (size_t)1 << 20;
constexpr size_t WS_CTL = 0, CTL_ZERO_BYTES = 192 * 1024, CTL_SSQ = 65536;
constexpr size_t WS_WIN = 1 * MiB, WS_WLORA = 43 * MiB, WS_WA = 46 * MiB, WS_WB = 50 * MiB, WS_WO = 54 * MiB, WS_WGU = 62 * MiB, WS_WDN = 106 * MiB;
constexpr size_t WS_XN = 128 * MiB, WS_U = 128 * MiB, WS_YA = 128 * MiB, WS_LA = 160 * MiB;
constexpr size_t WS_ZR = 193 * MiB, WS_MG = 193 * MiB, WS_XN2 = 257 * MiB;
constexpr size_t WS_Q = 307 * MiB, QKV_STRIDE_B = (size_t)TP * 1024 * 2, WS_K = WS_Q + QKV_STRIDE_B, WS_V = WS_K + QKV_STRIDE_B;
constexpr size_t WS_LW = WS_V + QKV_STRIDE_B;
constexpr size_t WS_LG = WS_LW + (size_t)TP * 1024 * 4;
constexpr size_t WS_LOGF = 502 * MiB;
constexpr size_t WS_KE = WS_LOGF + 5 * MiB / 4;
constexpr size_t WS_T1 = WS_K;
constexpr size_t WS_ACT = 321 * MiB;
constexpr size_t WS_END = WS_KE + (size_t)64 * KEROWS * 32;
static_assert(WS_END <= 512 * MiB && WS_LG + (size_t)TP * 1024 * 2 <= WS_LOGF && WS_T1 + (size_t)TR * 2048 * 4 <= WS_LOGF && WS_ACT + (size_t)TR * DFF * 2 <= WS_LOGF && WS_XN2 + (size_t)TR * 2048 * 2 <= WS_ACT, "ws map");
constexpr int LDS_BYTES = 147456;

namespace pg8 {
#define EPI_PACK8(v0, v1) ((u32x4){cvt_pk_bf16((v0)[0], (v0)[1]), cvt_pk_bf16((v0)[2], (v0)[3]), cvt_pk_bf16((v1)[0], (v1)[1]), cvt_pk_bf16((v1)[2], (v1)[3])})
__device__ __forceinline__ float sigm(float x) { return __builtin_amdgcn_rcpf(1.f + __builtin_amdgcn_exp2f(-1.4426950408889634f * x)); }
struct Epi1 { static constexpr bool PERM = true, AFTER_DRAIN = false;
    bf16_t* ZR; bf16_t* Q; bf16_t* G; const float* q_g; const float* k_g;
    __device__ __forceinline__ void operator()(const f32x4 (&acc)[2][2][4][2], const Unit& u, int wr, int wc, int fr, int fq) const {
        const int pn = u.pn; bf16_t* base; int ldc, colt; bool sig = false;
        if (pn >= 14 && pn < 22) {
            const int t = (pn - 14) >> 2; bf16_t* b0 = Q + (size_t)t * ((size_t)16640 * 1024) + ((pn - 14) & 3) * 256 + 64 * wc + 8 * fq; const float* gp = (t ? k_g : q_g) + 8 * fq;
            const f32x4 g00 = *(const f32x4*)gp, g01 = *(const f32x4*)(gp + 4), g10 = *(const f32x4*)(gp + 32), g11 = *(const f32x4*)(gp + 36);
            const int row0 = u.pm * BM + wr * 64 + fr;
#pragma unroll
            for (int ai = 0; ai < 2; ++ai)
#pragma unroll
                for (int m = 0; m < 4; ++m) { float ss = 0.f;
#pragma unroll
                    for (int bj = 0; bj < 2; ++bj)
#pragma unroll
                        for (int n = 0; n < 2; ++n) { const f32x4 x = acc[ai][bj][m][n]; ss += (x[0] * x[0] + x[1] * x[1]) + (x[2] * x[2] + x[3] * x[3]); }
                    { auto r16 = __builtin_amdgcn_permlane16_swap(__float_as_uint(ss), __float_as_uint(ss), false, false); ss = __uint_as_float(r16[0]) + __uint_as_float(r16[1]);
                      auto r32 = __builtin_amdgcn_permlane32_swap(__float_as_uint(ss), __float_as_uint(ss), false, false); ss = __uint_as_float(r32[0]) + __uint_as_float(r32[1]); }
                    const float rs = (1.0f / sqrtf(ss * (1.0f / 64.0f) + 1e-6f)) * (t ? 1.0f : ::C2);
                    bf16_t* rowp = b0 + (size_t)(row0 + ai * HALF + m * 16) * 1024;
                    const f32x4 a0 = acc[ai][0][m][0] * rs * g00, a1 = acc[ai][0][m][1] * rs * g01, c0 = acc[ai][1][m][0] * rs * g10, c1 = acc[ai][1][m][1] * rs * g11;
                    *(u32x4*)rowp = EPI_PACK8(a0, a1); *(u32x4*)(rowp + 32) = EPI_PACK8(c0, c1); }
            return; }
        if (pn < 14) { base = ZR; ldc = 3584; colt = pn * 256; }
        else if (pn < 26) { const int t = (pn - 14) >> 2; base = Q + (size_t)t * ((size_t)16640 * 1024); ldc = 1024; colt = ((pn - 14) & 3) * 256; }
        else { if (u.pm >= 64) return; base = G; ldc = 4096; colt = (pn - 26) * 256; sig = true; }
        const int row0 = u.pm * BM + wr * 64 + fr, col0 = colt + wc * 32 + 8 * fq;
#pragma unroll
        for (int ai = 0; ai < 2; ++ai)
#pragma unroll
            for (int m = 0; m < 4; ++m) { bf16_t* rowp = base + (size_t)(row0 + ai * HALF + m * 16) * ldc + col0;
#pragma unroll
                for (int bj = 0; bj < 2; ++bj) { f32x4 v0 = acc[ai][bj][m][0], v1 = acc[ai][bj][m][1];
                    if (sig) {
#pragma unroll
                        for (int e = 0; e < 4; ++e) { v0[e] = sigm(v0[e]); v1[e] = sigm(v1[e]); } }
                    *(u32x4*)(rowp + bj * HALF) = EPI_PACK8(v0, v1); } }
    }
};
struct EpiLora { static constexpr bool PERM = true, AFTER_DRAIN = false;
    const float* w0; const float* a0; float* LW; bf16_t* LA; bf16_t* LG; int mode;
    __device__ __forceinline__ void operator()(const f32x4 (&acc)[2][2][4][2], const Unit& u, int wr, int wc, int fr, int fq) const {
        const int colt = u.pn * 256;
        const int row0 = u.pm * BM + wr * 64 + fr, col0 = colt + wc * 32 + 8 * fq;
        f32x4 bv[2][2];
#pragma unroll
        for (int bj = 0; bj < 2; ++bj)
#pragma unroll
            for (int n = 0; n < 2; ++n) bv[bj][n] = mode == 0 ? *(const f32x4*)(w0 + col0 + bj * HALF + 4 * n) : (mode == 1 ? *(const f32x4*)(a0 + col0 + bj * HALF + 4 * n) : (f32x4){0.f, 0.f, 0.f, 0.f});
#pragma unroll
        for (int ai = 0; ai < 2; ++ai)
#pragma unroll
            for (int m = 0; m < 4; ++m) { const size_t ro = (size_t)(row0 + ai * HALF + m * 16) * 1024 + col0;
#pragma unroll
                for (int bj = 0; bj < 2; ++bj) { f32x4 v0 = acc[ai][bj][m][0] + bv[bj][0], v1 = acc[ai][bj][m][1] + bv[bj][1];
                    if (mode == 0) {
#pragma unroll
                        for (int e = 0; e < 4; ++e) { v0[e] = __builtin_amdgcn_exp2f(-0.60653066f * 1.4426950408889634f * sigm(v0[e])); v1[e] = __builtin_amdgcn_exp2f(-0.60653066f * 1.4426950408889634f * sigm(v1[e])); }
                        *(f32x4*)(LW + ro + bj * HALF) = v0; *(f32x4*)(LW + ro + bj * HALF + 4) = v1;
                    } else if (mode == 1) {
#pragma unroll
                        for (int e = 0; e < 4; ++e) { v0[e] = sigm(v0[e]); v1[e] = sigm(v1[e]); }
                        *(u32x4*)(LA + ro + bj * HALF) = EPI_PACK8(v0, v1);
                    } else { *(u32x4*)(LG + ro + bj * HALF) = EPI_PACK8(v0, v1); } } }
    }
};
__device__ __forceinline__ void unpack8(const u32x4 w, float (&g)[8]) {
#pragma unroll
    for (int e = 0; e < 4; ++e) { g[2 * e] = __uint_as_float(w[e] << 16); g[2 * e + 1] = __uint_as_float(w[e] & 0xffff0000u); }
}
struct EpiB { static constexpr bool PERM = true, AFTER_DRAIN = false;
    const bf16_t* G; bf16_t* T1;
    __device__ __forceinline__ void operator()(const f32x4 (&acc)[2][2][4][2], const Unit& u, int wr, int wc, int fr, int fq) const {
        const int row0 = u.pm * BM + wr * 64 + fr, col0 = u.pn * BM + wc * 32 + 8 * fq;
#pragma unroll
        for (int ai = 0; ai < 2; ++ai)
#pragma unroll
            for (int m = 0; m < 4; ++m) { const size_t r = (size_t)(row0 + ai * HALF + m * 16);
#pragma unroll
                for (int bj = 0; bj < 2; ++bj) { const int c = col0 + bj * HALF; float g[8]; unpack8(*(const u32x4*)(G + r * 4096 + 2048 + c), g);
                    f32x4 v0 = acc[ai][bj][m][0], v1 = acc[ai][bj][m][1];
#pragma unroll
                    for (int e = 0; e < 4; ++e) { v0[e] *= g[e]; v1[e] *= g[4 + e]; }
                    *(u32x4*)(T1 + r * 2048 + c) = EPI_PACK8(v0, v1); } }
    }
};
struct EpiA { static constexpr bool PERM = true, AFTER_DRAIN = false;
    const bf16_t* G; const bf16_t* T1; bf16_t* MG;
    __device__ __forceinline__ void operator()(const f32x4 (&acc)[2][2][4][2], const Unit& u, int wr, int wc, int fr, int fq) const {
        const int row0 = u.pm * BM + wr * 64 + fr, col0 = u.pn * BM + wc * 32 + 8 * fq;
#pragma unroll
        for (int ai = 0; ai < 2; ++ai)
#pragma unroll
            for (int m = 0; m < 4; ++m) { const size_t r = (size_t)(row0 + ai * HALF + m * 16);
#pragma unroll
                for (int bj = 0; bj < 2; ++bj) { const int c = col0 + bj * HALF; float g[8], t[8]; unpack8(*(const u32x4*)(G + r * 4096 + c), g); unpack8(*(const u32x4*)(T1 + r * 2048 + c), t);
                    f32x4 v0 = acc[ai][bj][m][0], v1 = acc[ai][bj][m][1];
#pragma unroll
                    for (int e = 0; e < 4; ++e) { v0[e] = t[e] + v0[e] * g[e]; v1[e] = t[4 + e] + v1[e] * g[4 + e]; }
                    *(u32x4*)(MG + r * 2048 + c) = EPI_PACK8(v0, v1); } }
    }
};
struct EpiO { static constexpr bool PERM = true, AFTER_DRAIN = false;
    const float* x; const float* n2; float* H1; bf16_t* XN2; float* ssq;
    __device__ __forceinline__ void operator()(const f32x4 (&acc)[2][2][4][2], const Unit& u, int wr, int wc, int fr, int fq) const {
        const int row0 = u.pm * BM + wr * 64 + fr, col0 = u.pn * BM + wc * 32 + 8 * fq;
        f32x4 nv[2][2];
#pragma unroll
        for (int bj = 0; bj < 2; ++bj)
#pragma unroll
            for (int n = 0; n < 2; ++n) nv[bj][n] = *(const f32x4*)(n2 + col0 + bj * HALF + 4 * n);
#pragma unroll
        for (int ai = 0; ai < 2; ++ai)
#pragma unroll
            for (int m = 0; m < 4; ++m) { const size_t r = (size_t)(row0 + ai * HALF + m * 16); float sq = 0.f;
#pragma unroll
                for (int bj = 0; bj < 2; ++bj) { const int c = col0 + bj * HALF;
                    const f32x4 h0 = acc[ai][bj][m][0] + *(const f32x4*)(x + r * 2048 + c), h1 = acc[ai][bj][m][1] + *(const f32x4*)(x + r * 2048 + c + 4);
                    *(f32x4*)(H1 + r * 2048 + c) = h0; *(f32x4*)(H1 + r * 2048 + c + 4) = h1;
                    sq += (h0[0] * h0[0] + h0[1] * h0[1]) + (h0[2] * h0[2] + h0[3] * h0[3]) + (h1[0] * h1[0] + h1[1] * h1[1]) + (h1[2] * h1[2] + h1[3] * h1[3]);
                    const f32x4 a0 = h0 * nv[bj][0], a1 = h1 * nv[bj][1];
                    *(u32x4*)(XN2 + r * 2048 + c) = EPI_PACK8(a0, a1); }
                { auto r16 = __builtin_amdgcn_permlane16_swap(__float_as_uint(sq), __float_as_uint(sq), false, false); sq = __uint_as_float(r16[0]) + __uint_as_float(r16[1]);
                  auto r32 = __builtin_amdgcn_permlane32_swap(__float_as_uint(sq), __float_as_uint(sq), false, false); sq = __uint_as_float(r32[0]) + __uint_as_float(r32[1]); }
                if (fq == 0) atomicAdd(ssq + r, sq); }
    }
};
struct EpiGU { static constexpr bool PERM = true, AFTER_DRAIN = false;
    const float* ssq; bf16_t* ACT;
    __device__ __forceinline__ void operator()(const f32x4 (&acc)[2][2][4][2], const Unit& u, int wr, int wc, int fr, int fq) const {
        const int row0 = u.pm * BM + wr * 64 + fr, col0 = u.pn * HALF + wc * 32 + 8 * fq;
#pragma unroll
        for (int ai = 0; ai < 2; ++ai)
#pragma unroll
            for (int m = 0; m < 4; ++m) { const size_t r = (size_t)(row0 + ai * HALF + m * 16);
                const float rstd = 1.0f / sqrtf(ssq[r] * (1.0f / 2048.0f) + 1e-6f);
                f32x4 o0, o1;
#pragma unroll
                for (int e = 0; e < 4; ++e) { const float g0 = acc[ai][0][m][0][e] * rstd, u0 = acc[ai][1][m][0][e] * rstd, g1 = acc[ai][0][m][1][e] * rstd, u1 = acc[ai][1][m][1][e] * rstd;
                    o0[e] = g0 * sigm(g0) * u0; o1[e] = g1 * sigm(g1) * u1; }
                *(u32x4*)(ACT + r * 5632 + col0) = EPI_PACK8(o0, o1); }
    }
};
struct EpiDN { static constexpr bool PERM = true, AFTER_DRAIN = false;
    float* out;
    __device__ __forceinline__ void operator()(const f32x4 (&acc)[2][2][4][2], const Unit& u, int wr, int wc, int fr, int fq) const {
        const int row0 = u.pm * BM + wr * 64 + fr, col0 = u.pn * BM + wc * 32 + 8 * fq;
#pragma unroll
        for (int ai = 0; ai < 2; ++ai)
#pragma unroll
            for (int m = 0; m < 4; ++m) { const size_t r = (size_t)(row0 + ai * HALF + m * 16);
#pragma unroll
                for (int bj = 0; bj < 2; ++bj) { float* p = out + r * 2048 + col0 + bj * HALF;
                    const f32x4 h0 = *(const f32x4*)p + acc[ai][bj][m][0], h1 = *(const f32x4*)(p + 4) + acc[ai][bj][m][1];
                    *(f32x4*)p = h0; *(f32x4*)(p + 4) = h1; } }
    }
};
}

__device__ __forceinline__ void transpose_item(const float* W, int N, int K, bf16* WT, int src_col0, int dst_row0, int ncols, int kb, int nb, LAS float* scr, int lane) {
    const int k0 = 64 * kb, n0 = 32 * nb, kr = lane >> 3, c4 = lane & 7; const bool nv = (n0 + 4 * c4) < ncols;
    const float* src = W + (size_t)(k0 + kr) * N + src_col0 + n0 + 4 * c4;
    f4 v[8];
#pragma unroll
    for (int i = 0; i < 8; ++i) v[i] = nv ? *(const f4*)(src + (size_t)(8 * i) * N) : (f4){0.f, 0.f, 0.f, 0.f};
#pragma unroll
    for (int i = 0; i < 8; ++i) { LAS float* d = scr + (8 * i + kr) * 33 + 4 * c4; d[0] = v[i].x; d[1] = v[i].y; d[2] = v[i].z; d[3] = v[i].w; }
    LDS_WAIT(); asm volatile("" ::: "memory");
    const int c = lane & 7;
#pragma unroll
    for (int j = 0; j < 4; ++j) { const int n = (lane >> 3) + 8 * j; const LAS float* s = scr + (8 * c) * 33 + n;
        v4u o; o.x = pk2(s[0 * 33], s[1 * 33]); o.y = pk2(s[2 * 33], s[3 * 33]); o.z = pk2(s[4 * 33], s[5 * 33]); o.w = pk2(s[6 * 33], s[7 * 33]);
        if (n0 + n < ncols) *(v4u*)(WT + (size_t)(dst_row0 + n0 + n) * K + k0 + 8 * c) = o; }
    LDS_WAIT(); asm volatile("" ::: "memory");
}

struct Ptrs {
    const float *x, *meta, *n1, *w_in, *mu, *w0, *w2, *a0, *a2, *g2, *k_k, *k_a, *r_k, *gn_w, *gn_b, *q_g, *k_g, *f_bias, *w_a, *w_b, *w_o, *n2, *w_gu, *w_dn;
    float* out; unsigned char* ws;
};

template <bool LATE> __device__ __forceinline__ void p0_prologue(const Ptrs& P, LAS unsigned char* lds, int tid, int bi, int nb) {
    const int lane = tid & 63, wave = tid >> 6;
    LAS float* scr = (LAS float*)(lds + wave * 16384);
    const int gw = bi * NWAVES + wave, NGW = nb * NWAVES;
    bf16* WIN = (bf16*)(P.ws + WS_WIN); bf16* WA = (bf16*)(P.ws + WS_WA); bf16* WB = (bf16*)(P.ws + WS_WB); bf16* WO = (bf16*)(P.ws + WS_WO);
    bf16* WGU = (bf16*)(P.ws + WS_WGU); bf16* WDN = (bf16*)(P.ws + WS_WDN); bf16* WL = (bf16*)(P.ws + WS_WLORA); bf16* XN = (bf16*)(P.ws + WS_XN);
    constexpr int I0 = 32 * 110, I1 = 32 * 1, I2 = 32 * 96, I3 = 32 * 128, I4 = 16 * 64, I5 = 16 * 64, I6 = 32 * 64, I7 = 88 * 128, I8 = 88 * 64;
    constexpr int NITEMS = I0 + I1 + I2 + I3 + I4 + I5 + I6 + I7 + I8;
    constexpr int NEARLY = I0 + I1 + I2 + I3;
    for (int it = (LATE ? NEARLY : 0) + gw; it < (LATE ? NITEMS : NEARLY); it += NGW) {
        int r = it;
        if (r < I0) { transpose_item(P.w_in, NIN, 2048, WIN, 0, 0, 3520, r / 110, r % 110, scr, lane); continue; } r -= I0;
        if (r < I1) { transpose_item(P.w_in, NIN, 2048, WIN, 6592, 3520, 16, r, 0, scr, lane); continue; } r -= I1;
        if (r < I2) { const int kb_ = r / 96, nb_ = r % 96; int dnb_ = nb_;
            if (nb_ < 64) { const int w_ = nb_ & 7; dnb_ = (nb_ & ~7) + 4 * (w_ & 1) + (w_ >> 1); }
            transpose_item(P.w_in, NIN, 2048, WIN, 3520 + 32 * nb_, 3584 + 32 * dnb_, 32, kb_, 0, scr, lane); continue; } r -= I2;
        if (r < I3) { transpose_item(P.w_in, NIN, 2048, WIN, 6608, 6656, 4096, r / 128, r % 128, scr, lane); continue; } r -= I3;
        if (r < I4) { transpose_item(P.w_a, 2048, 1024, WA, 0, 0, 2048, r / 64, r % 64, scr, lane); continue; } r -= I4;
        if (r < I5) { transpose_item(P.w_b, 2048, 1024, WB, 0, 0, 2048, r / 64, r % 64, scr, lane); continue; } r -= I5;
        if (r < I6) { transpose_item(P.w_o, 2048, 2048, WO, 0, 0, 2048, r / 64, r % 64, scr, lane); continue; } r -= I6;
        if (r < I7) { const int seg = r / 128, rem = r % 128, q = seg >> 1, bj = seg & 1;
            transpose_item(P.w_gu, NGU, 2048, WGU, bj * DFF + 128 * q, 256 * q + 128 * bj, 128, rem / 4, rem % 4, scr, lane); continue; } r -= I7;
        transpose_item(P.w_dn, 2048, DFF, WDN, 0, 0, 2048, r / 64, r % 64, scr, lane);
    }
    if (LATE) return;
    for (int t = gw; t < TP; t += NGW) {
        bf16* orow = XN + (size_t)t * DM;
        if (t >= TV) {
#pragma unroll
            for (int j = 0; j < 4; ++j) *(v4u*)(orow + 8 * (lane + 64 * j)) = (v4u){0u, 0u, 0u, 0u};
            continue; }
        const float* src = (t < TR) ? P.x + (size_t)t * DM : P.meta + (size_t)(t - TR) * DM;
        f4 v[8]; float ss = 0.f;
#pragma unroll
        for (int j = 0; j < 8; ++j) { v[j] = *(const f4*)(src + 4 * (lane + 64 * j)); ss += (v[j].x * v[j].x + v[j].y * v[j].y) + (v[j].z * v[j].z + v[j].w * v[j].w); }
        const float rstd = 1.0f / sqrtf(wave_sum(ss) * (1.0f / DM) + 1e-6f);
#pragma unroll
        for (int j = 0; j < 8; ++j) { const f4 g = *(const f4*)(P.n1 + 4 * (lane + 64 * j));
            *(v2u*)(orow + 4 * (lane + 64 * j)) = (v2u){pk2(v[j].x * rstd * g.x, v[j].y * rstd * g.y), pk2(v[j].z * rstd * g.z, v[j].w * rstd * g.w)}; }
    }
    const int gt = blockIdx.x * NTHR + tid, NGT = gridDim.x * NTHR;
    for (int idx = gt; idx < 16384; idx += NGT) { const int n = idx & 1023, c = idx >> 10; float v[8];
#pragma unroll
        for (int e = 0; e < 8; ++e) { const int k = 8 * c + e; v[e] = k < 96 ? P.w2[(size_t)k * 1024 + n] : 0.f; }
        *(v4u*)(WL + (size_t)n * 128 + 8 * c) = (v4u){pk2(v[0], v[1]), pk2(v[2], v[3]), pk2(v[4], v[5]), pk2(v[6], v[7])}; }
    for (int idx = gt; idx < 16384; idx += NGT) { const int n = idx & 1023, c = idx >> 10; float v[8];
#pragma unroll
        for (int e = 0; e < 8; ++e) { const int k = 8 * c + e; v[e] = k < 96 ? P.a2[(size_t)k * 1024 + n] : 0.f; }
        *(v4u*)(WL + 131072 + (size_t)n * 128 + 8 * c) = (v4u){pk2(v[0], v[1]), pk2(v[2], v[3]), pk2(v[4], v[5]), pk2(v[6], v[7])}; }
    for (int idx = gt; idx < 32768; idx += NGT) { const int n = idx & 1023, c = idx >> 10; float v[8];
#pragma unroll
        for (int e = 0; e < 8; ++e) { const int k = 8 * c + e; v[e] = P.g2[(size_t)k * 1024 + n]; }
        *(v4u*)(WL + 262144 + (size_t)n * 256 + 8 * c) = (v4u){pk2(v[0], v[1]), pk2(v[2], v[3]), pk2(v[4], v[5]), pk2(v[6], v[7])}; }
    for (int idx = gt; idx < 48 * 256; idx += NGT) *(v4u*)(WIN + (size_t)(3536 + idx / 256) * 2048 + 8 * (idx % 256)) = (v4u){0u, 0u, 0u, 0u};
}

__device__ __forceinline__ void p2a_prep(const Ptrs& P, int tid) {
    const int lane = tid & 63, wave = tid >> 6;
    const int gw = blockIdx.x * NWAVES + wave, NGW = gridDim.x * NWAVES;
    const bf16* ZR = (const bf16*)(P.ws + WS_ZR); bf16* U = (bf16*)(P.ws + WS_U); bf16* Q = (bf16*)(P.ws + WS_Q); bf16* K = (bf16*)(P.ws + WS_K);
    float* LOGF = (float*)(P.ws + WS_LOGF);
    for (int t = gw; t < TP; t += NGW) {
        bf16* u1 = U + (size_t)t * 128; bf16* u2 = U + (size_t)TP * 128 + (size_t)t * 128; bf16* u3 = U + (size_t)TP * 256 + (size_t)t * 256;
        if (t >= TV) { if (lane < 16) { *(v4u*)(u1 + 8 * lane) = (v4u){0u, 0u, 0u, 0u}; *(v4u*)(u2 + 8 * lane) = (v4u){0u, 0u, 0u, 0u}; } if (lane < 32) *(v4u*)(u3 + 8 * lane) = (v4u){0u, 0u, 0u, 0u}; continue; }
        const int tp = (t < TR) ? ((t & (SEQ - 1)) ? t - 1 : TV - 1) : (t > TR ? t - 1 : -1);
        const bf16* z = ZR + (size_t)t * ZRW; const bf16* zp = ZR + (size_t)(tp < 0 ? 0 : tp) * ZRW;
        if (lane < 56) {
            const int c8 = 8 * lane; float zc[8], zq[8], o[8];
            { const v4u a = *(const v4u*)(z + 3072 + c8); const v4u b_ = tp < 0 ? (v4u){0u, 0u, 0u, 0u} : *(const v4u*)(zp + 3072 + c8);
#pragma unroll
              for (int e = 0; e < 4; ++e) { zc[2 * e] = bflo(a[e]); zc[2 * e + 1] = bfhi(a[e]); zq[2 * e] = bflo(b_[e]); zq[2 * e + 1] = bfhi(b_[e]); } }
            const f4 m0 = *(const f4*)(P.mu + 3072 + c8), m1 = *(const f4*)(P.mu + 3072 + c8 + 4); const float mu8[8] = {m0.x, m0.y, m0.z, m0.w, m1.x, m1.y, m1.z, m1.w};
#pragma unroll
            for (int e = 0; e < 8; ++e) { const float zs = zc[e] + (zq[e] - zc[e]) * mu8[e];
                if (c8 < 96) { const float ex = __builtin_amdgcn_exp2f(2.f * LOG2E * zs); o[e] = 1.f - 2.f * __builtin_amdgcn_rcpf(ex + 1.f); }
                else if (c8 < 192) o[e] = zs;
                else o[e] = sigmoidf_(zs); }
            bf16* dst = c8 < 96 ? u1 + c8 : (c8 < 192 ? u2 + (c8 - 96) : u3 + (c8 - 192));
            *(v4u*)dst = (v4u){pk2(o[0], o[1]), pk2(o[2], o[3]), pk2(o[4], o[5]), pk2(o[6], o[7])};
        } else { bf16* dst = (lane < 60 ? u1 : u2) + 96 + 8 * (lane & 3); *(v4u*)dst = (v4u){0u, 0u, 0u, 0u}; }
        if (lane < 16) { const float xx = bf2f(z[3520 + lane]) + P.f_bias[lane];
            LOGF[(size_t)t * 16 + lane] = fminf(xx, 0.f) - log1pf(__expf(-fabsf(xx))); }
    }
}

__device__ __forceinline__ v4u split3(float x) { const unsigned h = f2bf(x); const float r1 = x - bf2f(h); const unsigned m = f2bf(r1); const float r2 = r1 - bf2f(m); const unsigned l = f2bf(r2);
    return (v4u){h | (m << 16), l, 0u, 0u}; }
__device__ __forceinline__ void p2b_cumsum(const Ptrs& P, int bh, LAS unsigned char* lds, int tid) {
    const int b = bh >> 4, h = bh & 15;
    const float* LOGF = (const float*)(P.ws + WS_LOGF); bf16* KE = (bf16*)(P.ws + WS_KE) + (size_t)bh * KEROWS * 16;
    LAS float* sc = (LAS float*)lds;
    float v[8]; float s = 0.f;
#pragma unroll
    for (int j = 0; j < 8; ++j) { s += LOGF[((size_t)b * SEQ + 8 * tid + j) * 16 + h]; v[j] = s; }
    sc[tid] = s; __syncthreads();
    for (int o = 1; o < NTHR; o <<= 1) { const float add = tid >= o ? sc[tid - o] : 0.f; __syncthreads(); sc[tid] += add; __syncthreads(); }
    const float off = sc[tid] - s;
#pragma unroll
    for (int j = 0; j < 8; ++j) { bf16* e = KE + (size_t)(64 + 8 * tid + j) * 16; *(v4u*)e = split3(-(off + v[j]) * LOG2E); *(v4u*)(e + 8) = (v4u){0u, 0u, 0u, 0u}; }
    if (tid < 64) { float kb = -30000.f;
        if (tid < 16) { float c15 = 0.f, cj = 0.f; for (int m = 0; m < 16; ++m) { const float lf = LOGF[(size_t)(TR + m) * 16 + h]; c15 += lf; if (m <= tid) cj += lf; } kb = (c15 - cj) * LOG2E; }
        bf16* e = KE + (size_t)tid * 16; *(v4u*)e = split3(kb); *(v4u*)(e + 8) = (v4u){0u, 0u, 0u, 0u}; }
    __syncthreads();
}

template <int CTRL> __device__ __forceinline__ float dppf(float v) { return __uint_as_float((unsigned)__builtin_amdgcn_update_dpp(0, (int)__float_as_uint(v), CTRL, 0xF, 0xF, true)); }
__device__ __forceinline__ float red8(float v) { v += dppf<0xB1>(v); v += dppf<0x4E>(v); v += dppf<0x141>(v); return v; }
__device__ __forceinline__ float red16(float v) { v += dppf<0xB1>(v); v += dppf<0x4E>(v); v += dppf<0x141>(v); v += dppf<0x140>(v); return v; }
constexpr int SC_T = 32, SC_ARR = SC_T * 64, SC_BUF = 6 * SC_ARR;
__device__ __forceinline__ void unpk8(const v4u w, float (&o)[8]) {
#pragma unroll
    for (int e = 0; e < 4; ++e) { o[2 * e] = bflo(w[e]); o[2 * e + 1] = bfhi(w[e]); }
}
#define SC_BAR() do { asm volatile("s_waitcnt lgkmcnt(0)" ::: "memory"); __builtin_amdgcn_s_barrier(); asm volatile("" ::: "memory"); } while (0)
constexpr int CS_XA = 0, CS_XB = 4608, CS_XK = 9216, CS_XR = 13824;
constexpr int CS_TB = 18432, CS_TK = 23552, CS_TV = 28672;
constexpr int CS_DEC = 33792, CS_WT = 41984, CS_GL = 42240;
constexpr int CS_GA = 46336, CS_GB = 48896, CS_GK = 51456;
constexpr int CS_SS = 54016, CS_RH = 63232, CS_UT = 72448, CS_YS = 77568;
constexpr int CS_FLG = 43008;
constexpr int CS_GSV = 137216;
constexpr int CS_RKS = 136960;
constexpr int CS_PRM = 134912;
constexpr int CS_OP2 = 101120;
constexpr int CS_LP = 85760, CS_LT = 98560;
__device__ __forceinline__ f32x16 mfma32(bf16x8 a, bf16x8 b, f32x16 c) { return __builtin_amdgcn_mfma_f32_32x32x16_bf16(a, b, c, 0, 0, 0); }
__device__ __forceinline__ int crow(int r, int hi) { return (r & 3) + 8 * (r >> 2) + 4 * hi; }
#define CS_TOFF(js) ((((2 * (js) + hi) ^ ((n >> 3) & 3))) << 4)
__device__ __forceinline__ void p3_scanc(const Ptrs& P, int bh, LAS unsigned char* lds, int tid) {
    const int lane = tid & 63, wid = __builtin_amdgcn_readfirstlane(tid >> 6), b = bh >> 4, h = bh & 15, n = lane & 31, hi = lane >> 5;
    const bf16* ZR = (const bf16*)(P.ws + WS_ZR); const float* LW = (const float*)(P.ws + WS_LW); const bf16* LA = (const bf16*)(P.ws + WS_LA); const bf16* LG = (const bf16*)(P.ws + WS_LG);
    bf16* YA = (bf16*)(P.ws + WS_YA);
    constexpr int NSTEP = 16 + SEQ, NCH = (NSTEP + 31) / 32;
    constexpr int OPB = 33792;
    const bool prep = wid >= 4;
    const int t2 = tid & 255, sl = t2 >> 3, cgp = t2 & 7, c0 = h * 64 + 8 * cgp, pw = (wid & 3), q8 = lane >> 3;
    { const int kind = tid >> 6, ch = tid & 63; const float* srcp = kind == 0 ? P.mu : kind == 1 ? P.mu + 1024 : kind == 2 ? P.mu + 2048 : kind == 3 ? P.k_k : kind == 4 ? P.k_a : kind == 5 ? P.r_k : kind == 6 ? P.gn_w : P.gn_b;
      ((LAS float*)(lds + CS_PRM))[kind * 64 + ch] = srcp[h * 64 + ch]; }
    if (tid == 0) *(LAS unsigned*)(lds + CS_FLG) = 0u;
#define CS_PRM8(kind, arr) float arr[8]; { const f4 p0_ = *(const LAS f4*)(lds + CS_PRM + (kind) * 256 + cgp * 32), p1_ = *(const LAS f4*)(lds + CS_PRM + (kind) * 256 + cgp * 32 + 16); \
        arr[0] = p0_.x; arr[1] = p0_.y; arr[2] = p0_.z; arr[3] = p0_.w; arr[4] = p1_.x; arr[5] = p1_.y; arr[6] = p1_.z; arr[7] = p1_.w; }
    for (int i = tid; i < 9216 / 4; i += NTHR) ((LAS unsigned*)(lds + CS_SS))[i] = 0u;
    SC_BAR();
    f32x16 ST = {};
    v4u q_zr, q_zk, q_zv, q_pr, q_pk, q_pv, q_la, q_g; f4 q_d0, q_d1;
#define CS_FETCH(chunk) do { const int s_ = (chunk) * 32 + sl; const v4u z0_ = (v4u){0u, 0u, 0u, 0u}; \
        q_zr = z0_; q_zk = z0_; q_zv = z0_; q_pr = z0_; q_pk = z0_; q_pv = z0_; q_la = z0_; q_g = z0_; q_d0 = (f4){1.f, 1.f, 1.f, 1.f}; q_d1 = q_d0; \
        if (s_ < NSTEP) { const int row_ = s_ < 16 ? TR + s_ : b * SEQ + s_ - 16; const int prow_ = s_ == 0 ? -1 : (s_ <= 16 ? TR + s_ - 1 : row_ - 1); \
            const bf16* z_ = ZR + (size_t)row_ * ZRW + c0; q_zr = *(const v4u*)z_; q_zk = *(const v4u*)(z_ + 1024); q_zv = *(const v4u*)(z_ + 2048); \
            if (prow_ >= 0) { const bf16* zp_ = ZR + (size_t)prow_ * ZRW + c0; q_pr = *(const v4u*)zp_; q_pk = *(const v4u*)(zp_ + 1024); q_pv = *(const v4u*)(zp_ + 2048); } \
            q_d0 = *(const f4*)(LW + (size_t)row_ * 1024 + c0); q_d1 = *(const f4*)(LW + (size_t)row_ * 1024 + c0 + 4); q_la = *(const v4u*)(LA + (size_t)row_ * 1024 + c0); \
            if (s_ >= 16) q_g = *(const v4u*)(LG + (size_t)row_ * 1024 + c0); } } while (0)
#define CS_W16(base, o, val) (*(LAS unsigned short*)(ob_ + (base) + (o)) = (unsigned short)(val))
#define CS_ALPHA_A(bufsel) do { LAS unsigned char* ob_ = lds + ((bufsel) ? CS_OP2 : 0); \
        *(LAS f4*)(lds + CS_DEC + sl * 256 + cgp * 32) = q_d0; *(LAS f4*)(lds + CS_DEC + sl * 256 + cgp * 32 + 16) = q_d1; \
        asm volatile("s_waitcnt lgkmcnt(0)" ::: "memory"); if (lane == 0) __hip_atomic_fetch_add((LAS unsigned*)(lds + CS_FLG), 1u, __ATOMIC_RELAXED, __HIP_MEMORY_SCOPE_WORKGROUP);     \
        float r_[8], k_[8], v_[8], a_[8], pr_[8], pk_[8], pv_[8]; CS_PRM8(0, mu_r) CS_PRM8(1, mu_k) CS_PRM8(2, mu_v) CS_PRM8(3, kkw) CS_PRM8(4, kaw) CS_PRM8(5, rkw) \
        unpk8(q_zr, r_); unpk8(q_zk, k_); unpk8(q_zv, v_); unpk8(q_pr, pr_); unpk8(q_pk, pk_); unpk8(q_pv, pv_); unpk8(q_la, a_); \
        *(LAS v4u*)(lds + CS_GSV + (bufsel) * 4096 + sl * 128 + cgp * 16) = q_g; \
        float kkv_[8], kf_[8], ss_ = 0.f, rk_ = 0.f; \
        _Pragma("unroll") for (int j = 0; j < 8; ++j) { r_[j] = r_[j] + (pr_[j] - r_[j]) * mu_r[j]; const float kk_ = k_[j] + (pk_[j] - k_[j]) * mu_k[j]; v_[j] = v_[j] + (pv_[j] - v_[j]) * mu_v[j]; \
            kkv_[j] = kk_ * kkw[j]; ss_ += kkv_[j] * kkv_[j]; kf_[j] = kk_ * (1.f + (a_[j] - 1.f) * kaw[j]); rk_ += r_[j] * kf_[j] * rkw[j]; } \
        ss_ = red8(ss_); rk_ = red8(rk_); \
        const float inv_ = __builtin_amdgcn_rcpf(fmaxf(__builtin_amdgcn_sqrtf(ss_), 1e-12f)); \
        float kn_[8], bv_[8]; \
        _Pragma("unroll") for (int j = 0; j < 8; ++j) { kn_[j] = kkv_[j] * inv_; bv_[j] = kn_[j] * a_[j]; } \
        const int ro_ = sl * 144 + cgp * 16; \
        *(LAS v4u*)(ob_ + CS_XR + ro_) = (v4u){pk2(r_[0], r_[1]), pk2(r_[2], r_[3]), pk2(r_[4], r_[5]), pk2(r_[6], r_[7])}; \
        *(LAS v4u*)(ob_ + CS_XK + ro_) = (v4u){pk2(kf_[0], kf_[1]), pk2(kf_[2], kf_[3]), pk2(kf_[4], kf_[5]), pk2(kf_[6], kf_[7])}; \
        *(LAS v4u*)(ob_ + CS_XA + ro_) = (v4u){pk2(kn_[0], kn_[1]), pk2(kn_[2], kn_[3]), pk2(kn_[4], kn_[5]), pk2(kn_[6], kn_[7])}; \
        *(LAS v4u*)(ob_ + CS_XB + ro_) = (v4u){pk2(bv_[0], bv_[1]), pk2(bv_[2], bv_[3]), pk2(bv_[4], bv_[5]), pk2(bv_[6], bv_[7])}; \
        { const v4u pv_2 = (v4u){pk2(v_[0], v_[1]), pk2(v_[2], v_[3]), pk2(v_[4], v_[5]), pk2(v_[6], v_[7])}; const int to_ = (8 * cgp) * 80 + ((((sl >> 3) ^ (cgp & 3)) << 4) + ((sl & 7) << 1));     \
          _Pragma("unroll") for (int e_ = 0; e_ < 4; ++e_) { CS_W16(CS_TV, to_ + (2 * e_) * 80, pv_2[e_] & 0xffffu); CS_W16(CS_TV, to_ + (2 * e_ + 1) * 80, pv_2[e_] >> 16); } } \
        if (cgp == 0) ((LAS float*)(lds + CS_RKS))[(bufsel) * 32 + sl] = rk_; \
        } while (0)
#define CS_ALPHA_B(bufsel) do { LAS unsigned char* ob_ = lds + ((bufsel) ? CS_OP2 : 0); \
        const int ro_ = sl * 144 + cgp * 16; \
        float xa_[8], xb_[8], xk_[8], xr_[8], wt_[8], wm_[8]; \
        { const f4 w0_ = *(const LAS f4*)(lds + CS_DEC + sl * 256 + cgp * 32), w1_ = *(const LAS f4*)(lds + CS_DEC + sl * 256 + cgp * 32 + 16); \
          const int slm_ = sl > 0 ? sl - 1 : 0; const f4 m0_ = *(const LAS f4*)(lds + CS_DEC + slm_ * 256 + cgp * 32), m1_ = *(const LAS f4*)(lds + CS_DEC + slm_ * 256 + cgp * 32 + 16); \
          wt_[0] = w0_.x; wt_[1] = w0_.y; wt_[2] = w0_.z; wt_[3] = w0_.w; wt_[4] = w1_.x; wt_[5] = w1_.y; wt_[6] = w1_.z; wt_[7] = w1_.w; \
          wm_[0] = m0_.x; wm_[1] = m0_.y; wm_[2] = m0_.z; wm_[3] = m0_.w; wm_[4] = m1_.x; wm_[5] = m1_.y; wm_[6] = m1_.z; wm_[7] = m1_.w; \
          if (sl == 0) { _Pragma("unroll") for (int j = 0; j < 8; ++j) wm_[j] = 1.f; } } \
        unpk8(*(const LAS v4u*)(ob_ + CS_XA + ro_), xa_); unpk8(*(const LAS v4u*)(ob_ + CS_XB + ro_), xb_); unpk8(*(const LAS v4u*)(ob_ + CS_XK + ro_), xk_); unpk8(*(const LAS v4u*)(ob_ + CS_XR + ro_), xr_); \
        _Pragma("unroll") for (int j = 0; j < 8; ++j) { const float W_ = wt_[j], iw_ = __builtin_amdgcn_rcpf(W_); \
            xa_[j] = -xa_[j] * wm_[j]; xb_[j] = xb_[j] * iw_; xk_[j] = xk_[j] * iw_; xr_[j] = xr_[j] * W_; } \
        const v4u pa_ = (v4u){pk2(xa_[0], xa_[1]), pk2(xa_[2], xa_[3]), pk2(xa_[4], xa_[5]), pk2(xa_[6], xa_[7])}, pb_ = (v4u){pk2(xb_[0], xb_[1]), pk2(xb_[2], xb_[3]), pk2(xb_[4], xb_[5]), pk2(xb_[6], xb_[7])}; \
        const v4u pk_2 = (v4u){pk2(xk_[0], xk_[1]), pk2(xk_[2], xk_[3]), pk2(xk_[4], xk_[5]), pk2(xk_[6], xk_[7])}, pr_2 = (v4u){pk2(xr_[0], xr_[1]), pk2(xr_[2], xr_[3]), pk2(xr_[4], xr_[5]), pk2(xr_[6], xr_[7])}; \
        *(LAS v4u*)(ob_ + CS_XA + ro_) = pa_; *(LAS v4u*)(ob_ + CS_XB + ro_) = pb_; *(LAS v4u*)(ob_ + CS_XK + ro_) = pk_2; *(LAS v4u*)(ob_ + CS_XR + ro_) = pr_2; \
        const int to_ = (8 * cgp) * 80 + ((((sl >> 3) ^ (cgp & 3)) << 4) + ((sl & 7) << 1));     \
        _Pragma("unroll") for (int e_ = 0; e_ < 4; ++e_) { CS_W16(CS_TB, to_ + (2 * e_) * 80, pb_[e_] & 0xffffu); CS_W16(CS_TB, to_ + (2 * e_ + 1) * 80, pb_[e_] >> 16); \
            CS_W16(CS_TK, to_ + (2 * e_) * 80, pk_2[e_] & 0xffffu); CS_W16(CS_TK, to_ + (2 * e_ + 1) * 80, pk_2[e_] >> 16); } \
        if (sl == 31) { *(LAS f4*)(lds + CS_WT + (bufsel) * 256 + cgp * 32) = (f4){wt_[0], wt_[1], wt_[2], wt_[3]}; *(LAS f4*)(lds + CS_WT + (bufsel) * 256 + cgp * 32 + 16) = (f4){wt_[4], wt_[5], wt_[6], wt_[7]}; } } while (0)
#define CS_POST(chunk) do { const int s_ = (chunk) * 32 + sl; const f4 y0_ = *(const LAS f4*)(lds + CS_YS + sl * 256 + cgp * 32), y1_ = *(const LAS f4*)(lds + CS_YS + sl * 256 + cgp * 32 + 16); \
        float y_[8] = {y0_.x, y0_.y, y0_.z, y0_.w, y1_.x, y1_.y, y1_.z, y1_.w}, g_[8], o_[8], vv_[8]; unpk8(*(const LAS v4u*)(lds + CS_GSV + ((chunk) & 1) * 4096 + sl * 128 + cgp * 16), g_); CS_PRM8(6, gnw) CS_PRM8(7, gnb) \
        { const LAS unsigned char* tv_ = lds + (((chunk) & 1) ? CS_OP2 : 0) + CS_TV + (8 * cgp) * 80 + ((((sl >> 3) ^ (cgp & 3)) << 4) + ((sl & 7) << 1)); _Pragma("unroll") for (int j = 0; j < 8; ++j) vv_[j] = bf2f(*(const LAS unsigned short*)(tv_ + j * 80)); } \
        const float rkp_ = ((const LAS float*)(lds + CS_RKS))[((chunk) & 1) * 32 + sl]; \
        float sum_ = 0.f; _Pragma("unroll") for (int j = 0; j < 8; ++j) sum_ += y_[j]; \
        const float mean_ = red8(sum_) * (1.f / 64.f); float m2_ = 0.f; \
        _Pragma("unroll") for (int j = 0; j < 8; ++j) { y_[j] -= mean_; m2_ += y_[j] * y_[j]; } \
        const float rstd_ = __builtin_amdgcn_rsqf(red8(m2_) * (1.f / 64.f) + 64e-5f); \
        _Pragma("unroll") for (int j = 0; j < 8; ++j) o_[j] = (y_[j] * rstd_ * gnw[j] + gnb[j] + rkp_ * vv_[j]) * g_[j]; \
        if (s_ >= 16 && s_ < NSTEP) *(v4u*)(YA + (size_t)(b * SEQ + s_ - 16) * 1024 + c0) = (v4u){pk2(o_[0], o_[1]), pk2(o_[2], o_[3]), pk2(o_[4], o_[5]), pk2(o_[6], o_[7])}; } while (0)
#define CS_KEEP_ROT() do { } while (0)
#define CS_CUMPROD(want) do { while (__hip_atomic_load((LAS unsigned*)(lds + CS_FLG), __ATOMIC_RELAXED, __HIP_MEMORY_SCOPE_WORKGROUP) < (want)) __builtin_amdgcn_s_sleep(1); \
        asm volatile("" ::: "memory"); LAS float* dcol_ = (LAS float*)(lds + CS_DEC) + lane; float d_[32]; \
        _Pragma("unroll") for (int t_ = 0; t_ < 32; ++t_) d_[t_] = dcol_[t_ * 64]; \
        _Pragma("unroll") for (int t_ = 1; t_ < 32; ++t_) d_[t_] *= d_[t_ - 1]; \
        _Pragma("unroll") for (int t_ = 1; t_ < 32; ++t_) dcol_[t_ * 64] = d_[t_]; } while (0)
    if (prep) { CS_FETCH(0); CS_ALPHA_A(0); CS_FETCH(1); }
    SC_BAR();
    if (wid == 1) CS_CUMPROD(4u);
    SC_BAR();
    if (prep) { CS_ALPHA_B(0); CS_KEEP_ROT(); }
    SC_BAR();
    for (int c = 0; c < NCH; ++c) {
        const LAS unsigned char* ob = lds + ((c & 1) ? CS_OP2 : 0);
        if (!prep) {
            const LAS unsigned char* As = ob + (wid < 2 ? CS_XA : CS_XR) + n * 144 + hi * 16; const LAS unsigned char* Bs = ob + ((wid & 1) ? CS_XK : CS_XB) + n * 144 + hi * 16;
            f32x16 g = {};
#pragma unroll
            for (int ks = 0; ks < 4; ++ks) g = mfma32(*(const LAS bf16x8*)(As + ks * 32), *(const LAS bf16x8*)(Bs + ks * 32), g);
            if (wid == 0) {
#pragma unroll
                for (int r = 0; r < 16; ++r) if (n >= crow(r, hi)) g[r] = 0.f;
                for (int i = 0; i < 5; ++i) {
                    LAS unsigned short* lp = (LAS unsigned short*)(lds + CS_LP + i * 2560);
#pragma unroll
                    for (int r = 0; r < 16; ++r) lp[crow(r, hi) * 40 + n] = (unsigned short)(pk2(g[r], 0.f) & 0xffffu);
                    if (i == 4) break;
                    const bf16x8 b0 = __builtin_bit_cast(bf16x8, (v4u){pk2(g[0], g[1]), pk2(g[2], g[3]), pk2(g[4], g[5]), pk2(g[6], g[7])});
                    const bf16x8 b1 = __builtin_bit_cast(bf16x8, (v4u){pk2(g[8], g[9]), pk2(g[10], g[11]), pk2(g[12], g[13]), pk2(g[14], g[15])});
                    asm volatile("s_waitcnt lgkmcnt(0)" ::: "memory");
                    const LAS unsigned char* Ap = lds + CS_LP + i * 2560 + n * 80 + hi * 8;
                    const v2u a00 = *(const LAS v2u*)Ap, a01 = *(const LAS v2u*)(Ap + 16), a10 = *(const LAS v2u*)(Ap + 32), a11 = *(const LAS v2u*)(Ap + 48);
                    asm volatile("s_waitcnt lgkmcnt(0)" ::: "memory");
                    f32x16 g2 = {}; g2 = mfma32(__builtin_bit_cast(bf16x8, (v4u){a00[0], a00[1], a01[0], a01[1]}), b0, g2); g2 = mfma32(__builtin_bit_cast(bf16x8, (v4u){a10[0], a10[1], a11[0], a11[1]}), b1, g2);
                    asm volatile("s_nop 15\n\ts_nop 7" : "+v"(g2)); g = g2;
                }
            } else {
                LAS unsigned short* G = (LAS unsigned short*)(lds + (wid == 1 ? CS_GA : (wid == 2 ? CS_GB : CS_GK)));
#pragma unroll
                for (int r = 0; r < 16; ++r) { const int t = crow(r, hi); const bool keep = wid == 1 ? (n < t) : (n <= t); G[t * 40 + n] = (unsigned short)(pk2(keep ? g[r] : 0.f, 0.f) & 0xffffu); }
            }
            if (wid == 1 && c + 1 < NCH) CS_CUMPROD(4u * (unsigned)(c + 2));
        } else {
            if (c >= 1) CS_POST(c - 1);
            if (c + 1 < NCH) { CS_ALPHA_A((c + 1) & 1); if (c + 2 < NCH) CS_FETCH(c + 2); }
        }
        SC_BAR();
        if (!prep) {
            const int vb = wid & 1;
            const LAS unsigned char* As = ob + (wid < 2 ? CS_XA : CS_XR) + n * 144 + hi * 16; const LAS unsigned char* Bs = lds + CS_SS + (32 * vb + n) * 144 + hi * 16;
            f32x16 acc = {};
#pragma unroll
            for (int ks = 0; ks < 4; ++ks) acc = mfma32(*(const LAS bf16x8*)(As + ks * 32), *(const LAS bf16x8*)(Bs + ks * 32), acc);
            if (wid < 2) {
                const LAS unsigned char* Ga = lds + CS_GA + n * 80 + hi * 16; const LAS unsigned char* Tv = ob + CS_TV + (32 * vb + n) * 80;
#pragma unroll
                for (int js = 0; js < 2; ++js) acc = mfma32(*(const LAS bf16x8*)(Ga + js * 32), *(const LAS bf16x8*)(Tv + CS_TOFF(js)), acc);
                LAS unsigned char* xt = lds + CS_UT + (32 * vb + n) * 80; asm volatile("s_nop 15\n\ts_nop 7" : "+v"(acc));
#pragma unroll 1
                for (int i = 0; i < 5; ++i) {
                    const LAS unsigned char* Ap = lds + CS_LP + i * 2560 + n * 80 + hi * 8;
                    const v2u a00 = *(const LAS v2u*)Ap, a01 = *(const LAS v2u*)(Ap + 16), a10 = *(const LAS v2u*)(Ap + 32), a11 = *(const LAS v2u*)(Ap + 48);
                    const bf16x8 b0 = __builtin_bit_cast(bf16x8, (v4u){pk2(acc[0], acc[1]), pk2(acc[2], acc[3]), pk2(acc[4], acc[5]), pk2(acc[6], acc[7])});
                    const bf16x8 b1 = __builtin_bit_cast(bf16x8, (v4u){pk2(acc[8], acc[9]), pk2(acc[10], acc[11]), pk2(acc[12], acc[13]), pk2(acc[14], acc[15])});
                    asm volatile("s_waitcnt lgkmcnt(0)" ::: "memory");
                    acc = mfma32(__builtin_bit_cast(bf16x8, (v4u){a00[0], a00[1], a01[0], a01[1]}), b0, acc); acc = mfma32(__builtin_bit_cast(bf16x8, (v4u){a10[0], a10[1], a11[0], a11[1]}), b1, acc);
                    asm volatile("s_nop 15\n\ts_nop 7" : "+v"(acc));
                }
#pragma unroll
                for (int r4 = 0; r4 < 4; ++r4) *(LAS v2u*)(xt + (8 * r4 + 4 * hi) * 2) = (v2u){pk2(acc[4 * r4], acc[4 * r4 + 1]), pk2(acc[4 * r4 + 2], acc[4 * r4 + 3])};
            } else { LAS float* ys = (LAS float*)(lds + CS_YS) + 32 * vb + n; asm volatile("s_nop 15\n\ts_nop 7" : "+v"(acc));
#pragma unroll
                for (int r = 0; r < 16; ++r) ys[crow(r, hi) * 64] = acc[r]; }
        } else if (c + 1 < NCH) { CS_ALPHA_B((c + 1) & 1); CS_KEEP_ROT(); }
        else { CS_KEEP_ROT(); }
        SC_BAR();
        if (!prep) {
            const int vb = wid & 1, kb = wid >> 1;
            const LAS unsigned char* Ut = lds + CS_UT + (32 * vb + n) * 80 + hi * 16; const LAS unsigned char* Tv = ob + CS_TV + (32 * vb + n) * 80;
            if (wid >= 2) {
                f32x16 acc; { const LAS float* ys0 = (const LAS float*)(lds + CS_YS) + 32 * vb + n;
#pragma unroll
                  for (int r = 0; r < 16; ++r) acc[r] = ys0[crow(r, hi) * 64]; }
                const LAS unsigned char* Gb = lds + CS_GB + n * 80 + hi * 16; const LAS unsigned char* Gk = lds + CS_GK + n * 80 + hi * 16;
#pragma unroll
                for (int js = 0; js < 2; ++js) { acc = mfma32(*(const LAS bf16x8*)(Gb + js * 32), *(const LAS bf16x8*)(Ut + js * 32), acc); acc = mfma32(*(const LAS bf16x8*)(Gk + js * 32), *(const LAS bf16x8*)(Tv + CS_TOFF(js)), acc); }
                LAS float* ys = (LAS float*)(lds + CS_YS) + 32 * vb + n;
#pragma unroll
                for (int r = 0; r < 16; ++r) ys[crow(r, hi) * 64] = acc[r];
            }
            const LAS unsigned char* Tb = ob + CS_TB + (32 * kb + n) * 80; const LAS unsigned char* Tk = ob + CS_TK + (32 * kb + n) * 80;
#pragma unroll
            for (int js = 0; js < 2; ++js) { ST = mfma32(*(const LAS bf16x8*)(Tb + CS_TOFF(js)), *(const LAS bf16x8*)(Ut + js * 32), ST); ST = mfma32(*(const LAS bf16x8*)(Tk + CS_TOFF(js)), *(const LAS bf16x8*)(Tv + CS_TOFF(js)), ST); }
            const LAS float* wt = (const LAS float*)(lds + CS_WT + (c & 1) * 256) + 32 * kb + 4 * hi; LAS unsigned char* ss = lds + CS_SS + (32 * vb + n) * 144 + (32 * kb + 4 * hi) * 2;
#pragma unroll
            for (int r4 = 0; r4 < 4; ++r4) { const f4 w = *(const LAS f4*)(wt + 8 * r4);
                ST[4 * r4] *= w.x; ST[4 * r4 + 1] *= w.y; ST[4 * r4 + 2] *= w.z; ST[4 * r4 + 3] *= w.w;
                *(LAS v2u*)(ss + 16 * r4) = (v2u){pk2(ST[4 * r4], ST[4 * r4 + 1]), pk2(ST[4 * r4 + 2], ST[4 * r4 + 3])}; }
        }
        SC_BAR();
    }
    if (prep) CS_POST(NCH - 1);
#undef CS_FETCH
#undef CS_ALPHA_A
#undef CS_ALPHA_B
#undef CS_W16
#undef CS_POST
#undef CS_KEEP_ROT
#undef CS_PRM8
#undef CS_CUMPROD
    __syncthreads();
}

constexpr int AT_KROW = 176, AT_VROW = 144, AT_KBYTES = 64 * AT_KROW, AT_BUF = AT_KBYTES + 64 * AT_VROW;
__device__ __forceinline__ void attn_unit(const Ptrs& P, int bh, int qb, LAS unsigned char* lds, int tid) {
    const int lane = tid & 63, wid = tid >> 6, n = lane & 31, hi = lane >> 5, b = bh >> 4, h = bh & 15;
    bf16* Qb = (bf16*)(P.ws + WS_Q); const bf16* Kb = (const bf16*)(P.ws + WS_K); const bf16* Vb = (const bf16*)(P.ws + WS_V);
    const bf16* KE = (const bf16*)(P.ws + WS_KE) + (size_t)bh * KEROWS * 16;
    const int NTL = 4 * (qb + 1) + 1; const size_t rowb = (size_t)b * SEQ; const int qrow = 256 * qb + 32 * wid + n, qw0 = 256 * qb + 32 * wid;
    bf16x8 qf[5];
    { const bf16* qp = Qb + (rowb + qrow) * 1024 + h * 64 + hi * 8;
#pragma unroll
      for (int d0 = 0; d0 < 4; ++d0) qf[d0] = *(const bf16x8*)(qp + d0 * 16);
      const short one = hi == 0 ? (short)0x3F80 : (short)0; qf[4] = (bf16x8){one, one, one, 0, 0, 0, 0, 0}; }
    const int sj = tid >> 3, sc = tid & 7;
    const int slot = ((sj >> 5) * 32) + (((sj >> 4) & 1) * 16) + (((sj >> 2) & 1) * 8) + (((sj >> 3) & 1) * 4) + (sj & 3);
    const int vgrp = (slot >> 3) ^ sc, vpos = vgrp * 16 + (slot & 7) * 2;
    const int ej = tid >> 1, eh = tid & 1;
    v4u kreg, vreg, ereg = (v4u){0u, 0u, 0u, 0u};
#define AT_LOAD(t) do { const bool val_ = (t) > 0 || sj < 16; const size_t row_ = (t) == 0 ? (size_t)(TR + (sj & 15)) : rowb + 64 * ((t) - 1) + sj; \
        kreg = *(const v4u*)(Kb + row_ * 1024 + h * 64 + sc * 8); vreg = *(const v4u*)(Vb + row_ * 1024 + h * 64 + sc * 8); \
        if (!val_) { kreg = (v4u){0u, 0u, 0u, 0u}; vreg = (v4u){0u, 0u, 0u, 0u}; } \
        if (tid < 128) ereg = *(const v4u*)(KE + (size_t)(64 * (t) + ej) * 16 + eh * 8); } while (0)
#define AT_STORE(bufo) do { LAS unsigned char* kt_ = lds + (bufo); LAS unsigned char* vt_ = kt_ + AT_KBYTES; \
        *(LAS v4u*)(kt_ + sj * AT_KROW + sc * 16) = kreg; if (tid < 128) *(LAS v4u*)(kt_ + ej * AT_KROW + 128 + eh * 16) = ereg; \
        _Pragma("unroll") for (int i_ = 0; i_ < 8; ++i_) { const unsigned w_ = vreg[i_ >> 1]; *(LAS unsigned short*)(vt_ + (8 * sc + i_) * AT_VROW + vpos) = (unsigned short)((i_ & 1) ? (w_ >> 16) : (w_ & 0xffffu)); } } while (0)
    AT_LOAD(0); AT_STORE(0); __syncthreads();
    f32x16 o0 = {}, o1 = {}; float m = -INFINITY, l = 0.f;
    for (int t = 0; t < NTL; ++t) {
        if (t + 1 < NTL) AT_LOAD(t + 1);
        const int bufo = (t & 1) * AT_BUF; const int key0 = 64 * (t - 1);
        const bool skip = t >= 1 && key0 > qw0 + 31;
        if (!skip) {
            const LAS unsigned char* Kt = lds + bufo; const LAS unsigned char* Vt = Kt + AT_KBYTES;
            f32x16 s0 = {}, s1 = {};
#pragma unroll
            for (int d0 = 0; d0 < 5; ++d0) { const int off = d0 < 4 ? d0 * 32 + hi * 16 : 128 + hi * 16;
                const bf16x8 k0 = *(const LAS bf16x8*)(Kt + n * AT_KROW + off), k1 = *(const LAS bf16x8*)(Kt + (32 + n) * AT_KROW + off);
                s0 = __builtin_amdgcn_mfma_f32_32x32x16_bf16(k0, qf[d0], s0, 0, 0, 0); s1 = __builtin_amdgcn_mfma_f32_32x32x16_bf16(k1, qf[d0], s1, 0, 0, 0); }
            if (t >= 1 && key0 + 63 > qw0) {
#pragma unroll
                for (int r = 0; r < 16; ++r) { const int key = key0 + crow(r, hi); if (key > qrow) s0[r] = -INFINITY; if (key + 32 > qrow) s1[r] = -INFINITY; } }
            float mx = fmaxf(s0[0], s1[0]);
#pragma unroll
            for (int r = 1; r < 16; ++r) mx = fmaxf(mx, fmaxf(s0[r], s1[r]));
            mx = fmaxf(mx, __shfl_xor(mx, 32));
            const float mn = fmaxf(m, mx), f = __builtin_amdgcn_exp2f(m - mn); m = mn; l *= f;
#pragma unroll
            for (int r = 0; r < 16; ++r) { o0[r] *= f; o1[r] *= f; }
            float ls = 0.f;
#pragma unroll
            for (int r = 0; r < 16; ++r) { s0[r] = __builtin_amdgcn_exp2f(s0[r] - mn); s1[r] = __builtin_amdgcn_exp2f(s1[r] - mn); ls += s0[r] + s1[r]; }
            l += ls;
            v4u pa[4];
#pragma unroll
            for (int e = 0; e < 4; ++e) { pa[0][e] = pk2(s0[2 * e], s0[2 * e + 1]); pa[1][e] = pk2(s0[8 + 2 * e], s0[8 + 2 * e + 1]); pa[2][e] = pk2(s1[2 * e], s1[2 * e + 1]); pa[3][e] = pk2(s1[8 + 2 * e], s1[8 + 2 * e + 1]); }
#pragma unroll
            for (int sl = 0; sl < 4; ++sl) { const int grp = sl * 2 + hi; const bf16x8 pb = __builtin_bit_cast(bf16x8, pa[sl]);
                const bf16x8 v0 = *(const LAS bf16x8*)(Vt + n * AT_VROW + ((grp ^ ((n >> 3) & 7)) * 16));
                const bf16x8 v1 = *(const LAS bf16x8*)(Vt + (32 + n) * AT_VROW + ((grp ^ (((32 + n) >> 3) & 7)) * 16));
                o0 = __builtin_amdgcn_mfma_f32_32x32x16_bf16(v0, pb, o0, 0, 0, 0); o1 = __builtin_amdgcn_mfma_f32_32x32x16_bf16(v1, pb, o1, 0, 0, 0); }
        }
        if (t + 1 < NTL) AT_STORE(((t + 1) & 1) * AT_BUF);
        __syncthreads();
    }
#undef AT_LOAD
#undef AT_STORE
    l += __shfl_xor(l, 32); const float inv = 1.0f / l;
    bf16* op = Qb + (rowb + qrow) * 1024 + h * 64;
#pragma unroll
    for (int r4 = 0; r4 < 4; ++r4) {
        __hip_atomic_store((unsigned long long*)(op + 8 * r4 + 4 * hi), (unsigned long long)pk2(o0[4 * r4] * inv, o0[4 * r4 + 1] * inv) | ((unsigned long long)pk2(o0[4 * r4 + 2] * inv, o0[4 * r4 + 3] * inv) << 32), __ATOMIC_RELAXED, __HIP_MEMORY_SCOPE_AGENT);
        __hip_atomic_store((unsigned long long*)(op + 32 + 8 * r4 + 4 * hi), (unsigned long long)pk2(o1[4 * r4] * inv, o1[4 * r4 + 1] * inv) | ((unsigned long long)pk2(o1[4 * r4 + 2] * inv, o1[4 * r4 + 3] * inv) << 32), __ATOMIC_RELAXED, __HIP_MEMORY_SCOPE_AGENT); }
}

#define XB_TMO      128
#define XB_XCNT(j)  (256  + 64 * (j))
#define XB_XSUB(j)  (1280 + 64 * (j))
#define XB_XGEN(j)  (2304 + 64 * (j))
#define XB_TOP      3328
#define XB_TOPGEN   3392
#define XCD_BAR_WORDS 3456
#define XB_SPIN_CAP (1u << 18)

__device__ __forceinline__ unsigned xb_ld(unsigned* p)              { return __hip_atomic_load(p, __ATOMIC_RELAXED, __HIP_MEMORY_SCOPE_AGENT); }
__device__ __forceinline__ unsigned xb_add(unsigned* p, unsigned v) { return __hip_atomic_fetch_add(p, v, __ATOMIC_RELAXED, __HIP_MEMORY_SCOPE_AGENT); }
__device__ __forceinline__ unsigned xb_xcc_id() { return (unsigned)__builtin_amdgcn_s_getreg((3 << 11) | 20) & 0xFu; }
#define XB_SPIN(cond, bar) do { unsigned _sp = 0; while (cond) { __builtin_amdgcn_s_sleep(1); \
    if ((++_sp & 255u) == 0u) { if (xb_ld(&(bar)[XB_TMO])) break; if (_sp > XB_SPIN_CAP) { atomicAdd(&(bar)[XB_TMO], 1u); break; } } } } while (0)

struct XcdBarrier {
    unsigned* bar; unsigned x;
    volatile LAS unsigned* st;
};

__device__ __forceinline__ XcdBarrier xcd_barrier_post(unsigned* bar, volatile LAS unsigned* st) {
    XcdBarrier b; b.bar = bar; b.x = xb_xcc_id(); b.st = st;
    if (threadIdx.x == 0) (void)xb_add(&bar[XB_XCNT(b.x)], 1u);
    return b;
}
__device__ __forceinline__ void xcd_barrier_complete(unsigned* bar, unsigned x, unsigned& nloc, unsigned& nx) {
    const unsigned G = gridDim.x * gridDim.y * gridDim.z;
    unsigned sum, cnt, mine, sp = 0u;
    for (;;) {
        sum = 0u; cnt = 0u; mine = 0u;
#pragma unroll
        for (unsigned j = 0; j < 16; ++j) { const unsigned c = xb_ld(&bar[XB_XCNT(j)]); sum += c; cnt += (c > 0u) ? 1u : 0u; mine = (j == x) ? c : mine; }
        if (sum == G) break;
        __builtin_amdgcn_s_sleep(1);
        if ((++sp & 255u) == 0u) { if (xb_ld(&bar[XB_TMO])) break; if (sp > XB_SPIN_CAP) { atomicAdd(&bar[XB_TMO], 1u); break; } }
    }
    nloc = mine > 0u ? mine : 1u; nx = cnt > 0u ? cnt : 1u;
}

__device__ __forceinline__ void xcd_barrier(const XcdBarrier& b) {
    asm volatile("s_waitcnt vmcnt(0)" ::: "memory");
    __syncthreads();
    if (threadIdx.x == 0) {
        unsigned* bar = b.bar;
        __builtin_amdgcn_s_waitcnt(0);
        unsigned nloc = b.st[0], nx = b.st[1];
        if (nloc == 0u) { xcd_barrier_complete(bar, b.x, nloc, nx); b.st[0] = nloc; b.st[1] = nx; }
        const unsigned old = xb_add(&bar[XB_XSUB(b.x)], 1u);
        const unsigned gen = old / nloc;
        if (old + 1u == (gen + 1u) * nloc) {
            __builtin_amdgcn_fence(__ATOMIC_RELEASE, "agent");
            asm volatile("s_waitcnt vmcnt(0)" ::: "memory");
            const unsigned og = xb_add(&bar[XB_TOP], 1u);
            const unsigned tg = og / nx;
            if (og + 1u == (tg + 1u) * nx) xb_add(&bar[XB_TOPGEN], 1u);
            else XB_SPIN(xb_ld(&bar[XB_TOPGEN]) == tg, bar);
            __builtin_amdgcn_fence(__ATOMIC_ACQUIRE, "agent");
            xb_add(&bar[XB_XGEN(b.x)], 1u);
            asm volatile("s_waitcnt vmcnt(0)" ::: "memory");
        } else {
            XB_SPIN(xb_ld(&bar[XB_XGEN(b.x)]) == gen, bar);
            __builtin_amdgcn_fence(__ATOMIC_ACQUIRE, "agent");
            asm volatile("s_waitcnt vmcnt(0)" ::: "memory");
        }
    }
    __syncthreads();
}

struct Args { const float* in[24]; float* out; unsigned char* ws; };
__global__ void __launch_bounds__(NTHR, 2) fwd_megakernel(Args args) {
    extern __shared__ __attribute__((aligned(16))) unsigned char lds_raw[];
    cg::grid_group grid = cg::this_grid();
    LAS unsigned char* lds = (LAS unsigned char*)lds_raw;
    const int tid = threadIdx.x, G = gridDim.x;
    Ptrs P;
    P.x = args.in[0]; P.meta = args.in[1]; P.n1 = args.in[2]; P.w_in = args.in[3]; P.mu = args.in[4]; P.w0 = args.in[5]; P.w2 = args.in[6]; P.a0 = args.in[7]; P.a2 = args.in[8];
    P.g2 = args.in[9]; P.k_k = args.in[10]; P.k_a = args.in[11]; P.r_k = args.in[12]; P.gn_w = args.in[13]; P.gn_b = args.in[14]; P.q_g = args.in[15]; P.k_g = args.in[16];
    P.f_bias = args.in[17]; P.w_a = args.in[18]; P.w_b = args.in[19]; P.w_o = args.in[20]; P.n2 = args.in[21]; P.w_gu = args.in[22]; P.w_dn = args.in[23];
    P.out = args.out; P.ws = args.ws;
    unsigned char* ws = args.ws;
    typedef pg8::bf16_t pb;
    volatile LAS unsigned* bst = (volatile LAS unsigned*)(lds + LDS_BYTES - 64);
    if (tid < 2) bst[tid] = 0u;
    __syncthreads();
    const XcdBarrier xbar = xcd_barrier_post((unsigned*)(ws + WS_CTL) + 1024, bst);
    p0_prologue<false>(P, lds, tid, (int)blockIdx.x, G);
    xcd_barrier(xbar);
    if (G == 0x7fffffff) grid.sync();
    { pg8::Gemm g{(const pb*)(ws + WS_XN), (const pb*)(ws + WS_WIN), TP, N1, DM}; pg8::StaticOrder S; S.init(TP, N1, G, (int)blockIdx.x);
      pg8::Epi1 E{(pb*)(ws + WS_ZR), (pb*)(ws + WS_Q), (pb*)args.out, P.q_g, P.k_g};
      pg8::gemm_phase<pg8::Epi1, pg8::StaticOrder, true, true>(lds, g, S, E); }
    xcd_barrier(xbar);
    p2a_prep(P, tid);
    xcd_barrier(xbar);
#pragma unroll 1
    for (int j = 0; j < 3; ++j) {
      pg8::Gemm g{(const pb*)(ws + WS_U) + (size_t)TP * 128 * j, (const pb*)(ws + WS_WLORA) + 131072 * j, TP, 1024, j == 2 ? 256 : 128}; pg8::StaticOrder S; S.init(TP, 1024, G, (int)((blockIdx.x + 64u * j) % (unsigned)G));
      pg8::EpiLora E{P.w0, P.a0, (float*)(ws + WS_LW), (pb*)(ws + WS_LA), (pb*)(ws + WS_LG), j};
      pg8::gemm_phase<pg8::EpiLora, pg8::StaticOrder, true, true>(lds, g, S, E);
      __syncthreads(); }
    if (G == 256) { if (blockIdx.x >= 192) p2b_cumsum(P, (int)blockIdx.x - 192, lds, tid); }
    else for (int bh = blockIdx.x; bh < 64; bh += G) p2b_cumsum(P, bh, lds, tid);
    xcd_barrier(xbar);
    for (int bh = blockIdx.x; bh < 64; bh += G) p3_scanc(P, bh, lds, tid);
    unsigned* ctr = (unsigned*)(ws + WS_CTL); unsigned* adone = ctr + 8192; unsigned* efail = ctr + 8256;
    { LAS unsigned* slot = (LAS unsigned*)(lds + 2 * AT_BUF); unsigned nprev = 0u;
      for (;;) {
          if (tid == 0) { if (nprev) __hip_atomic_fetch_add(adone, nprev, __ATOMIC_RELAXED, __HIP_MEMORY_SCOPE_AGENT); *slot = atomicAdd(ctr, 1u); }
          __syncthreads();
          const unsigned u = *slot;
          __syncthreads();
          if (u >= 1024u) break;
          attn_unit(P, (int)(u & 63u), 15 - (int)(u >> 6), lds, tid);
          asm volatile("s_waitcnt vmcnt(0)" ::: "memory"); __syncthreads();
          nprev = 1u;
      } }
    if (G <= 64) p0_prologue<true>(P, lds, tid, (int)blockIdx.x, G);
    else if (blockIdx.x >= 64) p0_prologue<true>(P, lds, tid, (int)blockIdx.x - 64, G - 64);
    if (G == 256 && blockIdx.x >= 64) {
        LAS unsigned* okw = (LAS unsigned*)(lds + 2 * AT_BUF);
        __syncthreads();
        if (tid == 0) { unsigned ok = 0u;
            for (int it = 0; it < 4000; ++it) { if (__hip_atomic_load(adone, __ATOMIC_RELAXED, __HIP_MEMORY_SCOPE_AGENT) >= 1024u) { ok = 1u; break; } __builtin_amdgcn_s_sleep(16); }
            if (!ok) __hip_atomic_fetch_add(efail, 1u, __ATOMIC_RELAXED, __HIP_MEMORY_SCOPE_AGENT);
            *okw = ok; }
        __syncthreads();
        const unsigned ok = *okw;
        __syncthreads();
        if (ok) {
            __builtin_amdgcn_fence(__ATOMIC_ACQUIRE, "agent");
            pg8::Gemm g{(const pb*)(ws + WS_Q), (const pb*)(ws + WS_WB), TR, DM, 1024}; pg8::StaticOrder S; S.init(TR, DM, 192, (int)blockIdx.x - 64);
            pg8::EpiB E{(const pb*)args.out, (pb*)(ws + WS_K)};
            pg8::gemm_phase<pg8::EpiB, pg8::StaticOrder, true, true>(lds, g, S, E);
        }
    }
    xcd_barrier(xbar);
    if (G != 256 || __hip_atomic_load(efail, __ATOMIC_RELAXED, __HIP_MEMORY_SCOPE_AGENT) != 0u) {
      pg8::Gemm g{(const pb*)(ws + WS_Q), (const pb*)(ws + WS_WB), TR, DM, 1024}; pg8::StaticOrder S; S.init(TR, DM, G, (int)blockIdx.x);
      pg8::EpiB E{(const pb*)args.out, (pb*)(ws + WS_K)};
      pg8::gemm_phase<pg8::EpiB, pg8::StaticOrder, true, true>(lds, g, S, E);
      xcd_barrier(xbar); }
    { pg8::Gemm g{(const pb*)(ws + WS_YA), (const pb*)(ws + WS_WA), TR, DM, 1024}; pg8::StaticOrder S; S.init(TR, DM, G, (int)blockIdx.x);
      pg8::EpiA E{(const pb*)args.out, (const pb*)(ws + WS_K), (pb*)(ws + WS_MG)};
      pg8::gemm_phase<pg8::EpiA, pg8::StaticOrder, true, true>(lds, g, S, E); }
    xcd_barrier(xbar);
    { pg8::Gemm g{(const pb*)(ws + WS_MG), (const pb*)(ws + WS_WO), TR, DM, DM}; pg8::StaticOrder S; S.init(TR, DM, G, (int)blockIdx.x);
      pg8::EpiO E{P.x, P.n2, args.out, (pb*)(ws + WS_XN2), (float*)(ws + WS_CTL + CTL_SSQ)};
      pg8::gemm_phase<pg8::EpiO, pg8::StaticOrder, true, true>(lds, g, S, E); }
    xcd_barrier(xbar);
    { pg8::Gemm g{(const pb*)(ws + WS_XN2), (const pb*)(ws + WS_WGU), TR, NGU, DM}; pg8::StaticOrder S; S.init(TR, NGU, G, (int)blockIdx.x);
      pg8::EpiGU E{(const float*)(ws + WS_CTL + CTL_SSQ), (pb*)(ws + WS_ACT)};
      pg8::gemm_phase<pg8::EpiGU, pg8::StaticOrder, true, true>(lds, g, S, E); }
    xcd_barrier(xbar);
    { pg8::Gemm g{(const pb*)(ws + WS_ACT), (const pb*)(ws + WS_WDN), TR, DM, DFF}; pg8::StaticOrder S; S.init(TR, DM, G, (int)blockIdx.x);
      pg8::EpiDN E{args.out};
      pg8::gemm_phase<pg8::EpiDN, pg8::StaticOrder, true, true>(lds, g, S, E); }
}

extern "C" void kernel_launch(void* const* d_in, const int* in_sizes, int n_in, void* d_out, int out_size, void* d_ws, size_t ws_size, hipStream_t stream) {
    static int grid = 0;
    if (grid == 0) {
        if (n_in != 24 || out_size != TR * DM || ws_size < WS_END) { fprintf(stderr, "kernel_launch: unexpected shapes (n_in %d, out %d, ws %zu < %zu)\n", n_in, out_size, ws_size, (size_t)WS_END); grid = -1; return; }
        int dev = 0, cus = 0, per_cu = 0;
        hipGetDevice(&dev); hipDeviceGetAttribute(&cus, hipDeviceAttributeMultiprocessorCount, dev);
        if (hipFuncSetAttribute((const void*)fwd_megakernel, hipFuncAttributeMaxDynamicSharedMemorySize, LDS_BYTES) != hipSuccess) { fprintf(stderr, "kernel_launch: hipFuncSetAttribute failed\n"); grid = -1; return; }
        if (hipOccupancyMaxActiveBlocksPerMultiprocessor(&per_cu, (const void*)fwd_megakernel, NTHR, LDS_BYTES) != hipSuccess || per_cu < 1) { fprintf(stderr, "kernel_launch: occupancy query says %d\n", per_cu); per_cu = 1; }
        (void)hipGetLastError();
        grid = cus;
    }
    if (grid < 0) return;
    (void)hipMemsetAsync((char*)d_ws + WS_CTL, 0, CTL_ZERO_BYTES, stream);
    Args a{};
    for (int i = 0; i < 24; ++i) a.in[i] = (const float*)d_in[i];
    a.out = (float*)d_out; a.ws = (unsigned char*)d_ws;
    void* kargs[] = {&a};
    hipError_t e = hipLaunchCooperativeKernel((const void*)fwd_megakernel, dim3(grid), dim3(NTHR), kargs, LDS_BYTES, stream);
    if (e != hipSuccess) fprintf(stderr, "kernel_launch: cooperative launch failed: %s (grid %d)\n", hipGetErrorString(e), grid);
}
```
